# Optimizing an MI355X kernel written in HIP

```python
import math
import jax, jax.numpy as jnp
from jax import lax
import numpy as np

D_MODEL = 2048
BATCH = 8
SEQ = 4096
DEPTH = 2

N_BRANCH = 4
BRANCH_W = D_MODEL // N_BRANCH
HEAD_DIM = 128
N_HEADS = BRANCH_W // HEAD_DIM
SG_CHUNK = 128
SG_GROUPS = N_HEADS
SG_GDIM = BRANCH_W // SG_GROUPS
CONV_W = 3
DIL_CFG = ((128, 1), (512, 4), (2048, 16))
N_DIL = len(DIL_CFG)
DIL_QBLOCK = 128
DIFF_DIM = HEAD_DIM // 2
DIFF_QBLOCK = 128
ROPE_THETA = 10000.0
W_A = 2 * BRANCH_W
W_B = 3 * BRANCH_W
W_C = 3 * N_DIL * BRANCH_W
W_D = 3 * BRANCH_W
W_IN = W_A + W_B + W_C + W_D
N_GROUPS = 4
EXP_PER_GROUP = 8
N_EXPERTS = N_GROUPS * EXP_PER_GROUP
TOP_K = 2
D_EXPERT = D_MODEL // 4
EPS = 1e-6

kernel_name = 'hybrid_gated_parallel_mixers_hmoe'


def rmsnorm(x, g):
    xf = x.astype(jnp.float32)
    y = xf * lax.rsqrt(jnp.mean(xf * xf, axis=-1, keepdims=True) + EPS)
    return (y * g.astype(jnp.float32)).astype(x.dtype)


def rope(x):
    s, hd = x.shape[1], x.shape[-1]
    half = hd // 2
    inv = ROPE_THETA ** (-jnp.arange(half, dtype=jnp.float32) / half)
    ang = jnp.arange(s, dtype=jnp.float32)[:, None] * inv[None, :]
    shape = (s,) + (1,) * (x.ndim - 3) + (half,)
    cos = jnp.cos(ang).reshape(shape)
    sin = jnp.sin(ang).reshape(shape)
    xf = x.astype(jnp.float32)
    x1, x2 = xf[..., :half], xf[..., half:]
    return jnp.concatenate([x1 * cos - x2 * sin, x2 * cos + x1 * sin], axis=-1).astype(x.dtype)


def spatial_gating(za, norm_g, w_s, b_s):
    b, s, _ = za.shape
    u, v = jnp.split(za, 2, axis=-1)
    v = rmsnorm(v, norm_g).reshape(b, s // SG_CHUNK, SG_CHUNK, SG_GROUPS, SG_GDIM)
    pos = jnp.arange(SG_CHUNK)
    causal = pos[:, None] >= pos[None, :]
    w = jnp.where(causal[None], w_s, 0.0)
    mixed = jnp.einsum('gij,bnjgc->bnigc', w, v) + b_s.T[None, None, :, :, None]
    return u * mixed.reshape(b, s, BRANCH_W)


def short_conv(zb, conv_w):
    bg, cg, hb = jnp.split(zb, 3, axis=-1)
    z = cg * hb
    y = lax.conv_general_dilated(
        z, conv_w[:, None, :].astype(z.dtype), window_strides=(1,),
        padding=[(CONV_W - 1, 0)], dimension_numbers=('NWC', 'WIO', 'NWC'),
        feature_group_count=BRANCH_W)
    return bg * y


def banded_dilated_attention(q, k, v, dilation, n_back):
    b, s, h, hd = q.shape
    L = s // dilation
    qb = min(DIL_QBLOCK, L)
    nblk = -(-L // qb)
    Lp = nblk * qb
    kb = qb + n_back

    def to_sub(t):
        return t.reshape(b, L, dilation, h, hd).transpose(0, 2, 3, 1, 4)

    qs = jnp.pad(to_sub(q), ((0, 0), (0, 0), (0, 0), (0, Lp - L), (0, 0)))
    qs = qs.reshape(b, dilation, h, nblk, qb, hd)
    pad_kv = ((0, 0), (0, 0), (0, 0), (n_back, Lp - L), (0, 0))
    ks = jnp.pad(to_sub(k), pad_kv)
    vs = jnp.pad(to_sub(v), pad_kv)
    kidx = jnp.arange(nblk)[:, None] * qb + jnp.arange(kb)[None, :]
    kg = ks[:, :, :, kidx]
    vg = vs[:, :, :, kidx]
    scores = jnp.einsum('brhnqd,brhnkd->brhnqk', qs, kg).astype(jnp.float32) * (hd ** -0.5)
    qpos = jnp.arange(nblk)[:, None] * qb + jnp.arange(qb)[None, :]
    kpos = kidx - n_back
    dist = qpos[:, :, None] - kpos[:, None, :]
    band = (dist >= 0) & (dist <= n_back) & (kpos[:, None, :] >= 0)
    scores = jnp.where(band, scores, -jnp.inf)
    mx = jnp.max(scores, axis=-1, keepdims=True)
    p = jnp.exp(scores - mx)
    denom = jnp.sum(p, axis=-1, keepdims=True)
    out = jnp.einsum('brhnqk,brhnkd->brhnqd', (p / denom).astype(v.dtype), vg)
    lse = (mx + jnp.log(denom))[..., 0]
    out = out.reshape(b, dilation, h, Lp, hd)[:, :, :, :L]
    out = out.transpose(0, 3, 1, 2, 4).reshape(b, s, h, hd)
    lse = lse.reshape(b, dilation, h, Lp)[..., :L].transpose(0, 3, 1, 2).reshape(b, s, h)
    return out, lse


def dilated_mixture(zc, qn, kn):
    b, s, _ = zc.shape
    zc = zc.reshape(b, s, 3, N_DIL, N_HEADS, HEAD_DIM)
    q = rope(rmsnorm(zc[:, :, 0], qn))
    k = rope(rmsnorm(zc[:, :, 1], kn))
    v = zc[:, :, 2]
    outs, lses = [], []
    for g, (window, dil) in enumerate(DIL_CFG):
        o, l = banded_dilated_attention(q[:, :, g], k[:, :, g], v[:, :, g], dil, window // dil)
        outs.append(o)
        lses.append(l)
    alpha = jax.nn.softmax(jnp.stack(lses, axis=-1), axis=-1)
    o = jnp.einsum('bshg,bshgd->bshd', alpha.astype(v.dtype), jnp.stack(outs, axis=-2))
    return o.reshape(b, s, BRANCH_W)


def diff_attention(zd, qn, kn, lq1, lk1, lq2, lk2, sub_g, lam_init):
    b, s, _ = zd.shape
    zq, zk, v = jnp.split(zd, 3, axis=-1)
    q = rope(rmsnorm(zq.reshape(b, s, N_HEADS, 2, DIFF_DIM), qn))
    k = rope(rmsnorm(zk.reshape(b, s, N_HEADS, 2, DIFF_DIM), kn))
    v = v.reshape(b, s, N_HEADS, 2 * DIFF_DIM)
    f32 = jnp.float32
    lam = (jnp.exp(jnp.sum(lq1.astype(f32) * lk1.astype(f32)))
           - jnp.exp(jnp.sum(lq2.astype(f32) * lk2.astype(f32))) + lam_init)
    qb = min(DIFF_QBLOCK, s)
    nblk = s // qb
    qblocks = q.reshape(b, nblk, qb, N_HEADS, 2, DIFF_DIM).transpose(1, 0, 2, 3, 4, 5)
    kpos = jnp.arange(s)
    scale = DIFF_DIM ** -0.5

    def block(args):
        qblk, n = args
        sc = jnp.einsum('bqhmd,bkhmd->bhmqk', qblk, k).astype(f32) * scale
        qpos = n * qb + jnp.arange(qb)
        sc = jnp.where(kpos[None, :] <= qpos[:, None], sc, -jnp.inf)
        p = jax.nn.softmax(sc, axis=-1)
        a = p[:, :, 0] - lam * p[:, :, 1]
        return jnp.einsum('bhqk,bkhd->bqhd', a.astype(v.dtype), v)

    out = lax.map(block, (qblocks, jnp.arange(nblk)))
    out = out.transpose(1, 0, 2, 3, 4).reshape(b, s, N_HEADS, 2 * DIFF_DIM)
    out = rmsnorm(out, sub_g) * (1.0 - lam_init)
    return out.reshape(b, s, BRANCH_W)


def hier_moe(h, w_rg, b_rg, w_re, b_re, w_up, w_down):
    b, s, d = h.shape
    t = h.reshape(b * s, d)
    g_prob = jax.nn.softmax((t @ w_rg + b_rg).astype(jnp.float32), axis=-1)
    g_p, g_idx = lax.top_k(g_prob, 1)
    e_logits = (t @ w_re + b_re).astype(jnp.float32).reshape(-1, N_GROUPS, EXP_PER_GROUP)
    in_group = jnp.take_along_axis(e_logits, g_idx[:, :, None], axis=1)[:, 0]
    top_v, top_i = lax.top_k(in_group, TOP_K)
    w = g_p * jax.nn.softmax(top_v, axis=-1)
    eid = g_idx * EXP_PER_GROUP + top_i
    gate = jnp.sum(jax.nn.one_hot(eid, N_EXPERTS, dtype=jnp.float32) * w[..., None], axis=1)
    gate = gate.astype(t.dtype)
    y = jnp.zeros_like(t)
    for e in range(N_EXPERTS):
        a, c = jnp.split(t @ w_up[e], 2, axis=-1)
        y = y + gate[:, e:e + 1] * ((jax.nn.silu(a) * c) @ w_down[e])
    return y.reshape(b, s, d)


def setup_inputs(seed: int = 0) -> dict:
    key = jax.random.key(seed)
    ks = jax.random.split(key, 32)
    f32 = jnp.float32
    L = DEPTH

    def nrm(k, shape, scale):
        return jax.random.normal(k, shape, f32) * scale

    def gain(k, shape):
        return 1.0 + 0.05 * jax.random.normal(k, shape, f32)

    return {
        'x': nrm(ks[0], (BATCH, SEQ, D_MODEL), 1.0),
        'norm_mix': gain(ks[1], (L, D_MODEL)),
        'w_in': nrm(ks[2], (L, D_MODEL, W_IN), D_MODEL ** -0.5),
        'sg_norm': gain(ks[3], (L, BRANCH_W)),
        'sg_w': nrm(ks[4], (L, SG_GROUPS, SG_CHUNK, SG_CHUNK), SG_CHUNK ** -0.5),
        'sg_b': gain(ks[5], (L, SG_GROUPS, SG_CHUNK)),
        'conv_w': nrm(ks[6], (L, CONV_W, BRANCH_W), CONV_W ** -0.5),
        'qn_c': gain(ks[7], (L, HEAD_DIM)),
        'kn_c': gain(ks[8], (L, HEAD_DIM)),
        'qn_d': gain(ks[9], (L, DIFF_DIM)),
        'kn_d': gain(ks[10], (L, DIFF_DIM)),
        'lam_q1': nrm(ks[11], (L, DIFF_DIM), 0.1),
        'lam_k1': nrm(ks[12], (L, DIFF_DIM), 0.1),
        'lam_q2': nrm(ks[13], (L, DIFF_DIM), 0.1),
        'lam_k2': nrm(ks[14], (L, DIFF_DIM), 0.1),
        'subln_d': gain(ks[15], (L, 2 * DIFF_DIM)),
        'w_gate': nrm(ks[16], (L, N_BRANCH, D_MODEL, D_MODEL), D_MODEL ** -0.5),
        'b_gate': nrm(ks[17], (L, N_BRANCH, D_MODEL), 0.02),
        'w_branch': nrm(ks[18], (L, N_BRANCH, BRANCH_W, D_MODEL), BRANCH_W ** -0.5),
        'w_out': nrm(ks[19], (L, D_MODEL, D_MODEL), D_MODEL ** -0.5),
        'norm_ffn': gain(ks[20], (L, D_MODEL)),
        'w_rg': nrm(ks[21], (L, D_MODEL, N_GROUPS), D_MODEL ** -0.5),
        'b_rg': nrm(ks[22], (L, N_GROUPS), 0.01),
        'w_re': nrm(ks[23], (L, D_MODEL, N_EXPERTS), D_MODEL ** -0.5),
        'b_re': nrm(ks[24], (L, N_EXPERTS), 0.01),
        'w_up': nrm(ks[25], (L, N_EXPERTS, D_MODEL, 2 * D_EXPERT), D_MODEL ** -0.5),
        'w_down': nrm(ks[26], (L, N_EXPERTS, D_EXPERT, D_MODEL), D_EXPERT ** -0.5),
    }


def reference(x, norm_mix, w_in, sg_norm, sg_w, sg_b, conv_w, qn_c, kn_c, qn_d, kn_d,
              lam_q1, lam_k1, lam_q2, lam_k2, subln_d, w_gate, b_gate, w_branch, w_out,
              norm_ffn, w_rg, b_rg, w_re, b_re, w_up, w_down):
    for l in range(DEPTH):
        lam_init = 0.8 - 0.6 * math.exp(-0.3 * l)
        h = rmsnorm(x, norm_mix[l])
        z = h @ w_in[l]
        za, zb, zc, zd = jnp.split(z, [W_A, W_A + W_B, W_A + W_B + W_C], axis=-1)
        y_a = spatial_gating(jax.nn.gelu(za), sg_norm[l], sg_w[l], sg_b[l])
        y_b = short_conv(zb, conv_w[l])
        y_c = dilated_mixture(zc, qn_c[l], kn_c[l])
        y_d = diff_attention(zd, qn_d[l], kn_d[l], lam_q1[l], lam_k1[l], lam_q2[l],
                             lam_k2[l], subln_d[l], lam_init)
        merged = jnp.zeros_like(x)
        for i, y in enumerate((y_a, y_b, y_c, y_d)):
            g = jax.nn.sigmoid(h @ w_gate[l, i] + b_gate[l, i])
            merged = merged + g * (y @ w_branch[l, i])
        x = x + merged @ w_out[l]
        x = x + hier_moe(rmsnorm(x, norm_ffn[l]), w_rg[l], b_rg[l], w_re[l], b_re[l],
                         w_up[l], w_down[l])
    return x
```

```cpp
#include <hip/hip_runtime.h>
#include <cstdio>
#include <cstdint>

#ifndef MK_XPROBE
#define MK_XPROBE 0
#define MK_XPROBE_W W_G
#define MK_XPROBE_K 2048
#define MK_XPROBE_N 8192
#endif
#ifndef MK_PROBE_MIX
#define MK_PROBE_MIX 15
#endif
#ifndef MK_PROBE_LO
#define MK_PROBE_LO -1
#define MK_PROBE_HI -1
#endif
#ifndef MK_MOE8
#define MK_MOE8 1
#endif
#ifndef MK_Z8
#define MK_Z8 2
#endif
#ifndef MK_WO8
#define MK_WO8 0
#endif
#ifndef MK_Y8
#define MK_Y8 1
#endif
#ifndef MK_FUSED
#define MK_FUSED 1
#endif
#ifndef MK_DEBUG
#define MK_DEBUG 0
#endif

#define LAS __attribute__((address_space(3)))
typedef unsigned short bf16_t;
typedef short bf16x8 __attribute__((ext_vector_type(8)));
typedef short s16x4 __attribute__((ext_vector_type(4)));
typedef float f32x4 __attribute__((ext_vector_type(4)));
typedef float f32x2 __attribute__((ext_vector_type(2)));
typedef float f32x16 __attribute__((ext_vector_type(16)));
typedef unsigned u32x4 __attribute__((ext_vector_type(4)));
typedef unsigned u32x2 __attribute__((ext_vector_type(2)));

constexpr int NB = 8, SEQ = 4096, T = NB * SEQ, D = 2048, WIN = 8704;
constexpr int ZA = 0, ZB = 1024, ZC = 2560, ZD = 7168;
constexpr int NEXP = 32;
constexpr float EPS = 1e-6f;
constexpr int NWAVES = 8, NTHR = 512;
constexpr int LDS_BYTES = 147456;

constexpr size_t MiB = 1u << 20;
constexpr size_t WS_CTL = 0, CTL_BYTES = 1 * MiB;
constexpr size_t WS_COSC = 1 * MiB, WS_SINC = 2 * MiB, WS_COSD = 3 * MiB, WS_SIND = 3 * MiB + 512 * 1024;
constexpr size_t WS_LIST = 8 * MiB;
constexpr size_t WS_ROUTE = 24 * MiB;
constexpr size_t WS_LSE = 25 * MiB;
constexpr size_t WS_W = 32 * MiB, W_LAYER = 276 * MiB;
constexpr size_t W_IN = 0, W_G = 34 * MiB, W_B = 66 * MiB, W_O = 74 * MiB, W_UP = 82 * MiB, W_DN = 210 * MiB, W_R = 274 * MiB;
constexpr size_t WS_H = 584 * MiB;
constexpr size_t WS_Z = 712 * MiB;
constexpr size_t WS_HID = WS_Z;
constexpr size_t WS_Y0 = WS_Z + 80 * MiB, WS_Y1 = WS_Z + 208 * MiB;
constexpr size_t WS_Y = 1256 * MiB;
constexpr size_t WS_CO = 1384 * MiB;
constexpr size_t WS_H8 = 1480 * MiB;
constexpr size_t WS_XB = 1544 * MiB;
constexpr size_t WS_END = 1672 * MiB;
constexpr int CW_CNT = 64;
constexpr int CW_DIAG = 256;
constexpr int CW_BAR = 4096;

__device__ __forceinline__ unsigned cvt_pk_bf16(float lo, float hi) { unsigned r; asm("v_cvt_pk_bf16_f32 %0, %1, %2" : "=v"(r) : "v"(lo), "v"(hi)); return r; }
__device__ __forceinline__ float bf_lo(unsigned w) { return __uint_as_float(w << 16); }
__device__ __forceinline__ float bf_hi(unsigned w) { return __uint_as_float(w & 0xffff0000u); }
__device__ __forceinline__ float bf2f(bf16_t b) { return __uint_as_float(((unsigned)b) << 16); }
__device__ __forceinline__ float fast_exp(float x) { return __builtin_amdgcn_exp2f(x * 1.4426950408889634f); }
__device__ __forceinline__ float sigmoidf_(float x) { return __builtin_amdgcn_rcpf(1.0f + fast_exp(-x)); }
__device__ __forceinline__ float gelu_tanh(float x) { const float u = 0.7978845608028654f * (x + 0.044715f * x * x * x); return x * sigmoidf_(2.0f * u); }
__device__ __forceinline__ float wave_sum(float v) {
#pragma unroll
    for (int o = 1; o < 64; o <<= 1) v += __shfl_xor(v, o);
    return v;
}
#define LDS_WAIT() asm volatile("s_waitcnt lgkmcnt(0)" ::: "memory")
#define VM_WAIT() asm volatile("s_waitcnt vmcnt(0)" ::: "memory")
__device__ __forceinline__ int opaque_tid() { int t = threadIdx.x; asm volatile("" : "+v"(t)); return t; }

namespace gm {
constexpr int BM = 256, BK = 64, HALF = 128, HTB = HALF * BK * 2, STAGE_BYTES = 8 * HTB;
constexpr int NXCD = 8, WGM = 8;
constexpr int XCH_OFF = STAGE_BYTES;
constexpr int TAB_OFF = STAGE_BYTES + 8192;
__host__ __device__ __forceinline__ int lds_byte(int r, int c) { const int st = (r >> 4) * 2 + (c >> 5), rr = r & 15, cc = c & 31, ob = rr * 64 + cc * 2; return st * 1024 + (ob ^ (((ob >> 9) & 1) << 5)); }
__host__ __device__ __forceinline__ void stage_rc(int b, int& R, int& C) { const int st = b / 1024, sb = b % 1024, swz = sb ^ (((sb >> 9) & 1) << 5); R = (st >> 1) * 16 + swz / 64; C = (st & 1) * 32 + (swz % 64) / 2; }
__host__ __device__ __forceinline__ int perm32(int rho) { const int n = rho >> 4, i = rho & 15; return 8 * (i >> 2) + 4 * n + (i & 3); }

struct Unit { int pm, pn, aux; };
typedef int v8i32 __attribute__((ext_vector_type(8)));
__device__ __forceinline__ void mfma8(f32x4& acc, v8i32 a, v8i32 b, int sa, int sb) {
    asm volatile("v_mfma_scale_f32_16x16x128_f8f6f4 %0, %1, %2, %0, %3, %4 op_sel_hi:[0,0,0]" : "+v"(acc) : "v"(a), "v"(b), "v"(sa), "v"(sb)); }
__device__ __forceinline__ v8i32 cat8(bf16x8 lo, bf16x8 hi) { const u32x4 a = __builtin_bit_cast(u32x4, lo), b = __builtin_bit_cast(u32x4, hi); return (v8i32){(int)a.x, (int)a.y, (int)a.z, (int)a.w, (int)b.x, (int)b.y, (int)b.z, (int)b.w}; }
struct Desc { const void* A; const void* Bt; int lda, ldb, K; int sw = 121, sa = 127; };

struct StaticOrder {
    static constexpr bool GATHER = false;
    int nM, nN, nwg, G, c;
    __device__ void init(int M, int N, int G_, int c_) { nM = M / BM; nN = N / BM; nwg = nM * nN; G = G_; c = c_; }
    __device__ __forceinline__ bool next(int i, Unit& u) const {
        const long L = (long)i * G + c; if (L >= nwg) return false;
        int wgid = (int)L; { const int q = nwg / NXCD, r = nwg % NXCD, xcd = wgid % NXCD, off = wgid / NXCD; wgid = (xcd < r ? xcd * (q + 1) : r * (q + 1) + (xcd - r) * q) + off; }
        const int nig = WGM * nN, gid = wgid / nig, fm = gid * WGM, gsz = (nM - fm) < WGM ? (nM - fm) : WGM;
        u.pm = fm + ((wgid % nig) % gsz); u.pn = (wgid % nig) / gsz; u.aux = 0; return true;
    }
    __device__ __forceinline__ const char* a_base(const Desc& g, const Unit& u) const { return (const char*)g.A + (size_t)u.pm * BM * g.lda; }
    __device__ __forceinline__ const char* b_base(const Desc& g, const Unit& u) const { return (const char*)g.Bt + (size_t)u.pn * BM * g.ldb; }
    __device__ __forceinline__ void a_off(const Desc& g, const Unit&, const int (&R)[2], const int (&C)[2], unsigned (&v)[2][2]) const {
#pragma unroll
        for (int h = 0; h < 2; ++h)
#pragma unroll
            for (int i = 0; i < 2; ++i) v[h][i] = (unsigned)((R[i] + HALF * h) * g.lda + C[i] * 2);
    }
};
struct BranchOrder : StaticOrder {
    __device__ __forceinline__ const char* a_base(const Desc& g, const Unit& u) const { return (const char*)g.A + (size_t)u.pm * BM * g.lda + (size_t)(u.pn >> 3) * 512 * 2; }
};

template <bool FP8 = false, class Epi, class Sched>
__device__ __forceinline__ void gemm_phase(LAS unsigned char* lds, const Desc g, const Sched& S, const Epi& E) {
    const int tid = opaque_tid(), wid = __builtin_amdgcn_readfirstlane(tid >> 6), lane = tid & 63, wr = wid >> 2, wc = wid & 3, fr = lane & 15, fq = lane >> 4;
    const int nt = g.K / (BK * 2);
    int Rr[2], Cc[2]; unsigned voffB[2];
#pragma unroll
    for (int i = 0; i < 2; ++i) { int R, C; stage_rc(tid * 16 + i * 8192, R, C); Rr[i] = R; Cc[i] = C; const int Rb = (R & ~31) + perm32(R & 31); voffB[i] = (unsigned)(Rb * g.ldb + C * 2); }
    const size_t kstep = (size_t)(BK * 2);
    const size_t hstepB = (size_t)HALF * g.ldb;
    const unsigned ldsw = (unsigned)wid * 1024u;
    const int aoff = lds_byte(wr * 64 + fr, FP8 ? fq * 16 : fq * 8), boff = lds_byte(wc * 32 + fr, FP8 ? fq * 16 : fq * 8);
    constexpr int KSTR = FP8 ? 16 : 1024;
#define GM_SA(b, h) (((b) * 2 + (h)) * HTB)
#define GM_SB(b, h) ((4 + (b) * 2 + (h)) * HTB)
#define GM_STAGE(bufoff, gbase, voff) do { _Pragma("unroll") for (int _i = 0; _i < 2; ++_i) \
        __builtin_amdgcn_global_load_lds((const unsigned*)((const char*)(gbase) + (voff)[_i]), (LAS unsigned*)(lds + (bufoff) + ldsw + _i * 8192), 16, 0, 0); } while (0)
#define GM_LDA(dst, b, h) do { _Pragma("unroll") for (int m = 0; m < 4; ++m) _Pragma("unroll") for (int k = 0; k < 2; ++k) dst[m][k] = *(const LAS bf16x8*)(lds + GM_SA(b, h) + aoff + m * 2048 + k * KSTR); } while (0)
#define GM_LDB(dst, b, h) do { _Pragma("unroll") for (int n = 0; n < 2; ++n) _Pragma("unroll") for (int k = 0; k < 2; ++k) dst[n][k] = *(const LAS bf16x8*)(lds + GM_SB(b, h) + boff + n * 2048 + k * KSTR); } while (0)
#define GM_MMA(ai, bj, At, Bt) do { __builtin_amdgcn_s_setprio(1); \
        if constexpr (FP8) { _Pragma("unroll") for (int m = 0; m < 4; ++m) _Pragma("unroll") for (int n = 0; n < 2; ++n) \
            mfma8(acc[ai][bj][m][n], cat8(Bt[n][0], Bt[n][1]), cat8(At[m][0], At[m][1]), sc_w, sc_1); } \
        else { _Pragma("unroll") for (int m = 0; m < 4; ++m) _Pragma("unroll") for (int n = 0; n < 2; ++n) _Pragma("unroll") for (int k = 0; k < 2; ++k) \
            acc[ai][bj][m][n] = __builtin_amdgcn_mfma_f32_16x16x32_bf16(Bt[n][k], At[m][k], acc[ai][bj][m][n], 0, 0, 0); } \
        __builtin_amdgcn_s_setprio(0); } while (0)
#define GM_WAIT_V(n) asm volatile("s_waitcnt vmcnt(" #n ")" ::: "memory")
#define GM_WAIT_L(n) asm volatile("s_waitcnt lgkmcnt(" #n ")" ::: "memory")
#define GM_BAR __builtin_amdgcn_s_barrier()
#define GM_SCHED __builtin_amdgcn_sched_barrier(0)
    Unit cur, nxt; int ui = 0;
    if (!S.next(0, cur)) return;
    int sc_w = g.sw, sc_1 = g.sa; asm volatile("" : "+v"(sc_w), "+v"(sc_1));
    f32x4 acc[2][2][4][2];
#pragma unroll
    for (int a = 0; a < 2; ++a)
#pragma unroll
        for (int b = 0; b < 2; ++b)
#pragma unroll
            for (int m = 0; m < 4; ++m)
#pragma unroll
                for (int n = 0; n < 2; ++n) acc[a][b][m][n] = (f32x4){0.f, 0.f, 0.f, 0.f};
    bf16x8 At[4][2], B0[2][2], B1[2][2];
    unsigned vc[2][2], vn[2][2];
    S.a_off(g, cur, Rr, Cc, vc);
    const char* cA = S.a_base(g, cur); const char* cB = S.b_base(g, cur);
    GM_STAGE(GM_SB(0, 0), cB, voffB); GM_STAGE(GM_SB(0, 1), cB + hstepB, voffB); GM_STAGE(GM_SA(0, 0), cA, vc[0]); GM_STAGE(GM_SA(0, 1), cA, vc[1]);
    if (wr == 1) GM_BAR;
    GM_WAIT_V(2); GM_BAR;
    GM_STAGE(GM_SB(1, 0), cB + kstep, voffB); GM_STAGE(GM_SA(1, 0), cA + kstep, vc[0]); GM_STAGE(GM_SB(1, 1), cB + hstepB + kstep, voffB);
    GM_WAIT_V(6); GM_BAR;
    for (;;) {
        const bool has_next = S.next(ui + 1, nxt);
        const char* nA = cA; const char* nB = cB;
#pragma unroll
        for (int h = 0; h < 2; ++h)
#pragma unroll
            for (int i = 0; i < 2; ++i) vn[h][i] = vc[h][i];
        if (has_next) { nA = S.a_base(g, nxt); nB = S.b_base(g, nxt); if constexpr (Sched::GATHER) S.a_off(g, nxt, Rr, Cc, vn); }
        for (int t = 0; t < nt; t += 2) {
            const bool last = (t == nt - 2);
            const char* a1 = cA + (size_t)(t + 1) * kstep;
            const char* a2 = last ? nA : cA + (size_t)(t + 2) * kstep; const char* b2 = last ? nB : cB + (size_t)(t + 2) * kstep;
            const char* a3 = a2 + kstep; const char* b3 = b2 + kstep;
            unsigned v2[2][2];
#pragma unroll
            for (int h = 0; h < 2; ++h)
#pragma unroll
                for (int i = 0; i < 2; ++i) v2[h][i] = (Sched::GATHER && last) ? vn[h][i] : vc[h][i];
            GM_LDB(B0, 0, 0); GM_LDB(B1, 0, 1); GM_SCHED; GM_LDA(At, 0, 0); GM_STAGE(GM_SA(1, 1), a1, vc[1]);
            GM_WAIT_V(8); GM_WAIT_L(0); GM_BAR; GM_MMA(0, 0, At, B0); GM_MMA(0, 1, At, B1); GM_BAR; GM_SCHED;
            GM_LDA(At, 0, 1); GM_STAGE(GM_SB(0, 0), b2, voffB); GM_STAGE(GM_SB(0, 1), b2 + hstepB, voffB); GM_STAGE(GM_SA(0, 0), a2, v2[0]);
            GM_WAIT_V(8); GM_WAIT_L(0); GM_BAR; GM_MMA(1, 0, At, B0); GM_MMA(1, 1, At, B1); GM_BAR; GM_SCHED;
            GM_LDB(B0, 1, 0); GM_LDB(B1, 1, 1); GM_SCHED; GM_LDA(At, 1, 0); GM_STAGE(GM_SA(0, 1), a2, v2[1]);
            GM_WAIT_V(8); GM_WAIT_L(0); GM_BAR; GM_MMA(0, 0, At, B0); GM_MMA(0, 1, At, B1); GM_BAR; GM_SCHED;
            GM_LDA(At, 1, 1); GM_STAGE(GM_SB(1, 0), b3, voffB); GM_STAGE(GM_SB(1, 1), b3 + hstepB, voffB); GM_STAGE(GM_SA(1, 0), a3, v2[0]);
            GM_WAIT_V(8); GM_WAIT_L(0); GM_BAR; GM_MMA(1, 0, At, B0); GM_MMA(1, 1, At, B1); GM_BAR; GM_SCHED;
        }
        if (wr == 0) GM_BAR;
        if constexpr (FP8) { asm volatile("s_nop 15\n\ts_nop 15\n\ts_nop 15" ::: "memory"); }
        { int fr_e = fr, fq_e = fq; asm volatile("" : "+v"(fr_e), "+v"(fq_e));
          E(acc, cur, lds, wr, wc, fr_e, fq_e); }
        if (!has_next) break;
#pragma unroll
        for (int a = 0; a < 2; ++a)
#pragma unroll
            for (int b = 0; b < 2; ++b)
#pragma unroll
                for (int m = 0; m < 4; ++m)
#pragma unroll
                    for (int n = 0; n < 2; ++n) acc[a][b][m][n] = (f32x4){0.f, 0.f, 0.f, 0.f};
        cur = nxt; cA = nA; cB = nB; ++ui;
#pragma unroll
        for (int h = 0; h < 2; ++h)
#pragma unroll
            for (int i = 0; i < 2; ++i) vc[h][i] = vn[h][i];
        if (wr == 1) GM_BAR;
    }
    GM_WAIT_V(0);
    GM_BAR;
#undef GM_SA
#undef GM_SB
#undef GM_STAGE
#undef GM_LDA
#undef GM_LDB
#undef GM_MMA
#undef GM_WAIT_V
#undef GM_WAIT_L
#undef GM_BAR
#undef GM_SCHED
}

struct EpiZ {
    bf16_t* Z; const float *qn_c, *kn_c, *qn_d, *kn_d; const float *cosC, *sinC, *cosD, *sinD;
    __device__ __forceinline__ void operator()(f32x4 (&acc)[2][2][4][2], const Unit& u, LAS unsigned char* lds, int wr, int wc, int fr, int fq) const {
        const int pn = u.pn; const int row0 = u.pm * BM + wr * 64 + fr;
        if (pn >= 10 && pn < 22) {
            LAS float* xch = (LAS float*)(lds + XCH_OFF);
            const int hh = 2 * (pn - 10) + (wc >> 1); const float* gn = (hh >= 12) ? kn_c : qn_c;
            const int i0 = 32 * (wc & 1) + 8 * fq;
#pragma unroll
            for (int ai = 0; ai < 2; ++ai)
#pragma unroll
                for (int m = 0; m < 4; ++m) { float ss = 0.f;
#pragma unroll
                    for (int bj = 0; bj < 2; ++bj)
#pragma unroll
                        for (int n = 0; n < 2; ++n) { const f32x4 x = acc[ai][bj][m][n]; ss += (x[0] * x[0] + x[1] * x[1]) + (x[2] * x[2] + x[3] * x[3]); }
                    ss += __shfl_xor(ss, 16); ss += __shfl_xor(ss, 32);
                    if (fq == 0) xch[(ai * HALF + wr * 64 + m * 16 + fr) * 4 + wc] = ss; }
            LDS_WAIT(); __builtin_amdgcn_s_barrier(); asm volatile("" ::: "memory");
            f32x4 ivr[2];
#pragma unroll
            for (int n = 0; n < 2; ++n) {
#pragma unroll
                for (int j = 0; j < 4; ++j) ivr[n][j] = __builtin_amdgcn_exp2f(-(float)(i0 + 4 * n + j) * (13.287712379549449f / 64.0f)) * 0.15915494309189535f; }
#pragma unroll
            for (int ai = 0; ai < 2; ++ai)
#pragma unroll
                for (int m = 0; m < 4; ++m) { const int rl = ai * HALF + wr * 64 + m * 16 + fr; const int row = u.pm * BM + rl;
                    const float tot = xch[rl * 4 + wc] + xch[rl * 4 + (wc ^ 1)];
                    const float rstd = 1.0f / sqrtf(tot * (1.0f / 128.0f) + EPS);
                    const float posf = (float)(row & (SEQ - 1));
                    u32x4 w0, w1;
#pragma unroll
                    for (int n = 0; n < 2; ++n) { f32x4 cs, sn;
#pragma unroll
                        for (int j = 0; j < 4; ++j) { const float xr = __builtin_amdgcn_fractf(posf * ivr[n][j]); cs[j] = __builtin_amdgcn_cosf(xr); sn[j] = __builtin_amdgcn_sinf(xr); }
                        const f32x4 g0 = *(const f32x4*)(gn + i0 + 4 * n), g1 = *(const f32x4*)(gn + 64 + i0 + 4 * n);
                        const f32x4 x1 = acc[ai][0][m][n] * rstd * g0, x2 = acc[ai][1][m][n] * rstd * g1;
                        const f32x4 o1 = x1 * cs - x2 * sn, o2 = x2 * cs + x1 * sn;
                        w0[2 * n] = cvt_pk_bf16(o1[0], o1[1]); w0[2 * n + 1] = cvt_pk_bf16(o1[2], o1[3]);
                        w1[2 * n] = cvt_pk_bf16(o2[0], o2[1]); w1[2 * n + 1] = cvt_pk_bf16(o2[2], o2[3]); }
                    bf16_t* rp = Z + (size_t)row * WIN + ZC + hh * 128 + i0;
                    *(u32x4*)rp = w0; *(u32x4*)(rp + 64) = w1; }
        } else if (pn >= 28 && pn < 32) {
            const float* gn = (pn >= 30) ? kn_d : qn_d;
            const int i0 = 8 * fq;
            f32x4 ivr[2];
#pragma unroll
            for (int n = 0; n < 2; ++n) {
#pragma unroll
                for (int j = 0; j < 4; ++j) ivr[n][j] = __builtin_amdgcn_exp2f(-(float)(i0 + 4 * n + j) * (13.287712379549449f / 32.0f)) * 0.15915494309189535f; }
#pragma unroll
            for (int ai = 0; ai < 2; ++ai)
#pragma unroll
                for (int m = 0; m < 4; ++m) { const int row = row0 + ai * HALF + m * 16; float ss = 0.f;
#pragma unroll
                    for (int bj = 0; bj < 2; ++bj)
#pragma unroll
                        for (int n = 0; n < 2; ++n) { const f32x4 x = acc[ai][bj][m][n]; ss += (x[0] * x[0] + x[1] * x[1]) + (x[2] * x[2] + x[3] * x[3]); }
                    ss += __shfl_xor(ss, 16); ss += __shfl_xor(ss, 32);
                    const float rstd = 1.0f / sqrtf(ss * (1.0f / 64.0f) + EPS);
                    const float posf = (float)(row & (SEQ - 1));
                    u32x4 w0, w1;
#pragma unroll
                    for (int n = 0; n < 2; ++n) { f32x4 cs, sn;
#pragma unroll
                        for (int j = 0; j < 4; ++j) { const float xr = __builtin_amdgcn_fractf(posf * ivr[n][j]); cs[j] = __builtin_amdgcn_cosf(xr); sn[j] = __builtin_amdgcn_sinf(xr); }
                        const f32x4 g0 = *(const f32x4*)(gn + i0 + 4 * n), g1 = *(const f32x4*)(gn + 32 + i0 + 4 * n);
                        const f32x4 x1 = acc[ai][0][m][n] * rstd * g0, x2 = acc[ai][1][m][n] * rstd * g1;
                        const f32x4 o1 = x1 * cs - x2 * sn, o2 = x2 * cs + x1 * sn;
                        w0[2 * n] = cvt_pk_bf16(o1[0], o1[1]); w0[2 * n + 1] = cvt_pk_bf16(o1[2], o1[3]);
                        w1[2 * n] = cvt_pk_bf16(o2[0], o2[1]); w1[2 * n + 1] = cvt_pk_bf16(o2[2], o2[3]); }
                    bf16_t* rp = Z + (size_t)row * WIN + ZD + (pn - 28) * 256 + wc * 64 + i0;
                    *(u32x4*)rp = w0; *(u32x4*)(rp + 32) = w1; }
        } else {
            const bool do_gelu = pn < 4;
#pragma unroll
            for (int ai = 0; ai < 2; ++ai)
#pragma unroll
                for (int m = 0; m < 4; ++m) { bf16_t* rp = Z + (size_t)(row0 + ai * HALF + m * 16) * WIN + pn * BM + wc * 32 + 8 * fq;
#pragma unroll
                    for (int bj = 0; bj < 2; ++bj) { f32x4 v0 = acc[ai][bj][m][0], v1 = acc[ai][bj][m][1];
                        if (do_gelu) {
#pragma unroll
                            for (int j = 0; j < 4; ++j) { v0[j] = gelu_tanh(v0[j]); v1[j] = gelu_tanh(v1[j]); } }
                        u32x4 w; w.x = cvt_pk_bf16(v0[0], v0[1]); w.y = cvt_pk_bf16(v0[2], v0[3]); w.z = cvt_pk_bf16(v1[0], v1[1]); w.w = cvt_pk_bf16(v1[2], v1[3]);
                        *(u32x4*)(rp + bj * HALF) = w; } }
        }
    }
};
struct EpiBf16 {
    bf16_t* O; int ldc;
    __device__ __forceinline__ void operator()(f32x4 (&acc)[2][2][4][2], const Unit& u, LAS unsigned char*, int wr, int wc, int fr, int fq) const {
        const int row0 = u.pm * BM + wr * 64 + fr;
#pragma unroll
        for (int ai = 0; ai < 2; ++ai)
#pragma unroll
            for (int m = 0; m < 4; ++m) { bf16_t* rp = O + (size_t)(row0 + ai * HALF + m * 16) * ldc + u.pn * BM + wc * 32 + 8 * fq;
#pragma unroll
                for (int bj = 0; bj < 2; ++bj) { const f32x4 v0 = acc[ai][bj][m][0], v1 = acc[ai][bj][m][1];
                    u32x4 w; w.x = cvt_pk_bf16(v0[0], v0[1]); w.y = cvt_pk_bf16(v0[2], v0[3]); w.z = cvt_pk_bf16(v1[0], v1[1]); w.w = cvt_pk_bf16(v1[2], v1[3]);
                    __builtin_nontemporal_store(w, (u32x4*)(rp + bj * HALF)); } }
    }
};
template <bool OUT8> struct EpiGateT {
    void* Mg; const bf16_t* P; const float* bg;
    __device__ __forceinline__ void operator()(f32x4 (&acc)[2][2][4][2], const Unit& u, LAS unsigned char*, int wr, int wc, int fr, int fq) const {
        const int row0 = u.pm * BM + wr * 64 + fr; const int c = 64 * u.pn + 16 * wc + 4 * fq;
        constexpr float NL2E = -1.4426950408889634f;
        f32x4 bl[4];
#pragma unroll
        for (int k = 0; k < 4; ++k) bl[k] = *(const f32x4*)(bg + k * D + c) * NL2E;
#pragma unroll
        for (int ai = 0; ai < 2; ++ai) {
            u32x2 pw[4][4];
#pragma unroll
            for (int m = 0; m < 4; ++m) { const bf16_t* pr = P + (size_t)(row0 + ai * HALF + m * 16) * 8192 + c;
#pragma unroll
                for (int k = 0; k < 4; ++k) pw[m][k] = *(const u32x2*)(pr + k * D); }
            asm volatile("" ::: "memory");
#pragma unroll
            for (int m = 0; m < 4; ++m) { const size_t row = (size_t)(row0 + ai * HALF + m * 16); f32x4 s = (f32x4){0.f, 0.f, 0.f, 0.f};
#pragma unroll
                for (int k = 0; k < 4; ++k) { const f32x4 e = acc[ai][k >> 1][m][k & 1] * NL2E + bl[k]; const u32x2 p = pw[m][k];
                    f32x4 t; t[0] = __builtin_amdgcn_exp2f(e[0]); t[1] = __builtin_amdgcn_exp2f(e[1]); t[2] = __builtin_amdgcn_exp2f(e[2]); t[3] = __builtin_amdgcn_exp2f(e[3]);
                    t = t + 1.0f;
                    f32x4 r; r[0] = __builtin_amdgcn_rcpf(t[0]); r[1] = __builtin_amdgcn_rcpf(t[1]); r[2] = __builtin_amdgcn_rcpf(t[2]); r[3] = __builtin_amdgcn_rcpf(t[3]);
                    const f32x4 pv = (f32x4){bf_lo(p.x), bf_hi(p.x), bf_lo(p.y), bf_hi(p.y)};
                    s = r * pv + s; }
                if constexpr (OUT8) { int p = __builtin_amdgcn_cvt_pk_fp8_f32(s[0], s[1], 0, false); p = __builtin_amdgcn_cvt_pk_fp8_f32(s[2], s[3], p, true); *(unsigned*)((unsigned char*)Mg + row * D + c) = (unsigned)p; }
                else { u32x2 w; w.x = cvt_pk_bf16(s[0], s[1]); w.y = cvt_pk_bf16(s[2], s[3]); *(u32x2*)((bf16_t*)Mg + row * D + c) = w; } }
        }
    }
};
struct EpiResid {
    const float* XF; bf16_t* XB;
    __device__ __forceinline__ void operator()(f32x4 (&acc)[2][2][4][2], const Unit& u, LAS unsigned char*, int wr, int wc, int fr, int fq) const {
        const int row0 = u.pm * BM + wr * 64 + fr;
#pragma unroll
        for (int ai = 0; ai < 2; ++ai)
#pragma unroll
            for (int m = 0; m < 4; ++m) { const size_t off = (size_t)(row0 + ai * HALF + m * 16) * D + u.pn * BM + wc * 32 + 8 * fq;
#pragma unroll
                for (int bj = 0; bj < 2; ++bj) { f32x4 x0, x1;
                    if (XF) { x0 = *(const f32x4*)(XF + off + bj * HALF); x1 = *(const f32x4*)(XF + off + bj * HALF + 4); }
                    else { const u32x4 r = *(const u32x4*)(XB + off + bj * HALF); x0 = (f32x4){bf_lo(r.x), bf_hi(r.x), bf_lo(r.y), bf_hi(r.y)}; x1 = (f32x4){bf_lo(r.z), bf_hi(r.z), bf_lo(r.w), bf_hi(r.w)}; }
                    x0 += acc[ai][bj][m][0]; x1 += acc[ai][bj][m][1];
                    u32x4 w; w.x = cvt_pk_bf16(x0[0], x0[1]); w.y = cvt_pk_bf16(x0[2], x0[3]); w.z = cvt_pk_bf16(x1[0], x1[1]); w.w = cvt_pk_bf16(x1[2], x1[3]);
                    *(u32x4*)(XB + off + bj * HALF) = w; } }
    }
};
struct MoeOrder {
    static constexpr bool GATHER = false;
    int nN, G, c; LAS const int* tab; const u32x4* list; int nexp_rows;
    __device__ __forceinline__ bool next(int i, Unit& u) const {
        const int L = i * G + c; const int TT = tab[32]; const int rt = L / nN;
        if (rt >= TT) return false;
        int e = 0;
#pragma unroll 1
        for (int k = 1; k < 32; ++k) e = (tab[k] <= rt) ? k : e;
        u.pm = rt; u.pn = L - rt * nN; u.aux = e; return true;
    }
    __device__ __forceinline__ const char* b_base(const Desc& g, const Unit& u) const { return (const char*)g.Bt + ((size_t)u.aux * nexp_rows + (size_t)u.pn * BM) * g.ldb; }
};
struct MoeUpOrder : MoeOrder {
    static constexpr bool GATHER = true;
    __device__ __forceinline__ const char* a_base(const Desc& g, const Unit&) const { return (const char*)g.A; }
    __device__ __forceinline__ void a_off(const Desc& g, const Unit& u, const int (&R)[2], const int (&C)[2], unsigned (&v)[2][2]) const {
        const int e = u.aux, base = (u.pm - tab[e]) * BM, cnt = tab[40 + e];
#pragma unroll
        for (int h = 0; h < 2; ++h)
#pragma unroll
            for (int i = 0; i < 2; ++i) { const int idx = base + R[i] + HALF * h; int tok = 0; if (idx < cnt) tok = (int)(list[(size_t)e * T + idx].x & 0x7fffu);
                v[h][i] = (unsigned)(tok * g.lda + C[i] * 2); }
    }
};
struct MoeDownOrder : MoeOrder {
    __device__ __forceinline__ const char* a_base(const Desc& g, const Unit& u) const { return (const char*)g.A + (size_t)u.pm * BM * g.lda; }
    __device__ __forceinline__ void a_off(const Desc& g, const Unit&, const int (&R)[2], const int (&C)[2], unsigned (&v)[2][2]) const {
#pragma unroll
        for (int h = 0; h < 2; ++h)
#pragma unroll
            for (int i = 0; i < 2; ++i) v[h][i] = (unsigned)((R[i] + HALF * h) * g.lda + C[i] * 2);
    }
};
template <bool OUT8> struct EpiUpT {
    void* Hid; const u32x4* list;
    __device__ __forceinline__ void operator()(f32x4 (&acc)[2][2][4][2], const Unit& u, LAS unsigned char* lds, int wr, int wc, int fr, int fq) const {
        LAS const int* tab = (LAS const int*)(lds + TAB_OFF);
        const int e = u.aux, base = (u.pm - tab[e]) * BM, cnt = tab[40 + e];
        const int row0 = u.pm * BM + wr * 64 + fr;
        float rs[2][4];
#pragma unroll
        for (int ai = 0; ai < 2; ++ai)
#pragma unroll
            for (int m = 0; m < 4; ++m) { const int idx = base + ai * HALF + wr * 64 + m * 16 + fr; rs[ai][m] = (idx < cnt) ? __uint_as_float(list[(size_t)e * T + idx].z) : 0.f; }
#pragma unroll
        for (int ai = 0; ai < 2; ++ai)
#pragma unroll
            for (int m = 0; m < 4; ++m) { const size_t eo = (size_t)(row0 + ai * HALF + m * 16) * 512 + u.pn * 128 + wc * 32 + 8 * fq; f32x4 o[2]; const float r = rs[ai][m];
#pragma unroll
                for (int n = 0; n < 2; ++n)
#pragma unroll
                    for (int j = 0; j < 4; ++j) { const float a = acc[ai][0][m][n][j] * r; o[n][j] = a * sigmoidf_(a) * (acc[ai][1][m][n][j] * r); }
                if constexpr (OUT8) { u32x2 w; int p = __builtin_amdgcn_cvt_pk_fp8_f32(o[0][0] * 16.f, o[0][1] * 16.f, 0, false); p = __builtin_amdgcn_cvt_pk_fp8_f32(o[0][2] * 16.f, o[0][3] * 16.f, p, true); w.x = (unsigned)p;
                    p = __builtin_amdgcn_cvt_pk_fp8_f32(o[1][0] * 16.f, o[1][1] * 16.f, 0, false); p = __builtin_amdgcn_cvt_pk_fp8_f32(o[1][2] * 16.f, o[1][3] * 16.f, p, true); w.y = (unsigned)p;
                    *(u32x2*)((unsigned char*)Hid + eo) = w; }
                else { u32x4 w; w.x = cvt_pk_bf16(o[0][0], o[0][1]); w.y = cvt_pk_bf16(o[0][2], o[0][3]); w.z = cvt_pk_bf16(o[1][0], o[1][1]); w.w = cvt_pk_bf16(o[1][2], o[1][3]);
                    *(u32x4*)((bf16_t*)Hid + eo) = w; } }
    }
};
template <bool OUT8> struct EpiDownT {
    void *Y0, *Y1; const u32x4* list;
    __device__ __forceinline__ void operator()(f32x4 (&acc)[2][2][4][2], const Unit& u, LAS unsigned char* lds, int wr, int wc, int fr, int fq) const {
        LAS const int* tab = (LAS const int*)(lds + TAB_OFF);
        const int e = u.aux, base = (u.pm - tab[e]) * BM, cnt = tab[40 + e];
#pragma unroll
        for (int ai = 0; ai < 2; ++ai)
#pragma unroll
            for (int m = 0; m < 4; ++m) { const int idx = base + ai * HALF + wr * 64 + m * 16 + fr;
                if (idx < cnt) { const u32x4 en = list[(size_t)e * T + idx]; const int tok = (int)(en.x & 0x7fffu); const float w = __uint_as_float(en.y);
                    const size_t eo = (size_t)tok * D + u.pn * BM + wc * 32 + 8 * fq; void* yb = (en.x >> 16) ? Y1 : Y0;
#pragma unroll
                    for (int bj = 0; bj < 2; ++bj) { const f32x4 v0 = acc[ai][bj][m][0] * w, v1 = acc[ai][bj][m][1] * w;
                        if constexpr (OUT8) { int p0 = __builtin_amdgcn_cvt_pk_fp8_f32(v0[0] * 16.f, v0[1] * 16.f, 0, false); p0 = __builtin_amdgcn_cvt_pk_fp8_f32(v0[2] * 16.f, v0[3] * 16.f, p0, true);
                            int p1 = __builtin_amdgcn_cvt_pk_fp8_f32(v1[0] * 16.f, v1[1] * 16.f, 0, false); p1 = __builtin_amdgcn_cvt_pk_fp8_f32(v1[2] * 16.f, v1[3] * 16.f, p1, true);
                            *(u32x2*)((unsigned char*)yb + eo + bj * HALF) = (u32x2){(unsigned)p0, (unsigned)p1}; }
                        else { u32x4 ww; ww.x = cvt_pk_bf16(v0[0], v0[1]); ww.y = cvt_pk_bf16(v0[2], v0[3]); ww.z = cvt_pk_bf16(v1[0], v1[1]); ww.w = cvt_pk_bf16(v1[2], v1[3]);
                            *(u32x4*)((bf16_t*)yb + eo + bj * HALF) = ww; } } } }
    }
};
struct EpiProbe {
    float* dummy;
    __device__ __forceinline__ void operator()(f32x4 (&acc)[2][2][4][2], const Unit& u, LAS unsigned char*, int wr, int wc, int fr, int fq) const {
        f32x4 s = (f32x4){0.f, 0.f, 0.f, 0.f};
#pragma unroll
        for (int ai = 0; ai < 2; ++ai)
#pragma unroll
            for (int bj = 0; bj < 2; ++bj)
#pragma unroll
                for (int m = 0; m < 4; ++m)
#pragma unroll
                    for (int n = 0; n < 2; ++n) s += acc[ai][bj][m][n];
        if (s[0] + s[1] + s[2] + s[3] == 12345.678f) dummy[u.pm * 64 + fr] = s[0];
    }
};
}

namespace at {
#define SBAR() __builtin_amdgcn_sched_barrier(0)
__device__ __forceinline__ int crow(int r, int hi) { return (r & 3) + 8 * (r >> 2) + 4 * hi; }
template <int DQK> __device__ __forceinline__ int kswz(int row, int colB) { if (DQK == 128) return row * 256 + (colB ^ ((row & 7) << 4)); else return row * 128 + (colB ^ (((row >> 1) & 7) << 4)); }
constexpr int SHM_V = 64 * 128 * 2;
constexpr int LDS_WS = 131072;
__device__ __forceinline__ int v_st(int k, int c) { const int kk = (k & ~0xC) | ((k & 4) << 1) | ((k & 8) >> 1); return ((kk >> 3) * 4 + (c >> 5)) * 512 + ((kk & 7) * 32 + (c & 31)) * 2; }
__device__ __forceinline__ int v_rd_base(int lane) { return ((lane & 3) << 3) | (((lane >> 2) & 3) << 6) | (((lane >> 4) & 1) << 5) | (((lane >> 5) & 1) << 8); }
constexpr int v_rd_off(int d0, int ks, int half) { return d0 * 512 + ks * 4096 + half * 2048; }
template <int OFF> __device__ __forceinline__ s16x4 tr_read(unsigned vb) { s16x4 r; asm volatile("ds_read_b64_tr_b16 %0, %1 offset:%2" : "=&v"(r) : "v"(vb), "i"(OFF) : "memory"); return r; }
template <int D0> __device__ __forceinline__ void v_read8(s16x4 (&v)[8], unsigned vb) {
    v[0] = tr_read<v_rd_off(D0, 0, 0)>(vb); v[1] = tr_read<v_rd_off(D0, 0, 1)>(vb); v[2] = tr_read<v_rd_off(D0, 1, 0)>(vb); v[3] = tr_read<v_rd_off(D0, 1, 1)>(vb);
    v[4] = tr_read<v_rd_off(D0, 2, 0)>(vb); v[5] = tr_read<v_rd_off(D0, 2, 1)>(vb); v[6] = tr_read<v_rd_off(D0, 3, 0)>(vb); v[7] = tr_read<v_rd_off(D0, 3, 1)>(vb);
}
__device__ __forceinline__ void pv_mma4(f32x16& od, const s16x4 (&v)[8], bf16x8 pa0, bf16x8 pa1, bf16x8 pa2, bf16x8 pa3) {
#define AT_PK(L, H) (bf16x8){L[0], L[1], L[2], L[3], H[0], H[1], H[2], H[3]}
    od = __builtin_amdgcn_mfma_f32_32x32x16_bf16(pa0, AT_PK(v[0], v[1]), od, 0, 0, 0);
    od = __builtin_amdgcn_mfma_f32_32x32x16_bf16(pa1, AT_PK(v[2], v[3]), od, 0, 0, 0);
    od = __builtin_amdgcn_mfma_f32_32x32x16_bf16(pa2, AT_PK(v[4], v[5]), od, 0, 0, 0);
    od = __builtin_amdgcn_mfma_f32_32x32x16_bf16(pa3, AT_PK(v[6], v[7]), od, 0, 0, 0);
#undef AT_PK
}
__device__ __forceinline__ void pv_d0(f32x16* o, unsigned vb, bf16x8 pa0, bf16x8 pa1, bf16x8 pa2, bf16x8 pa3) {
    s16x4 va[8], vb8[8];
    v_read8<0>(va, vb);
    v_read8<1>(vb8, vb); asm volatile("s_waitcnt lgkmcnt(8)" ::: "memory"); SBAR(); pv_mma4(o[0], va, pa0, pa1, pa2, pa3);
    v_read8<2>(va, vb);  asm volatile("s_waitcnt lgkmcnt(8)" ::: "memory"); SBAR(); pv_mma4(o[1], vb8, pa0, pa1, pa2, pa3);
    v_read8<3>(vb8, vb); asm volatile("s_waitcnt lgkmcnt(8)" ::: "memory"); SBAR(); pv_mma4(o[2], va, pa0, pa1, pa2, pa3);
    asm volatile("s_waitcnt lgkmcnt(0)" ::: "memory"); SBAR(); pv_mma4(o[3], vb8, pa0, pa1, pa2, pa3);
}
template <int DQK> struct SmC { static constexpr float SCALE = (DQK == 128) ? 0.08838834764831845f : 0.125f; static constexpr float MNAT = (DQK == 128) ? 16.f : 12.f; };
template <int DQK> __device__ __forceinline__ void softmax_tile(f32x16& p0, f32x16& p1, float& l_reg, bf16x8& pa0, bf16x8& pa1, bf16x8& pa2, bf16x8& pa3) {
    constexpr float C = SmC<DQK>::SCALE * 1.4426950408889634f, MC = -SmC<DQK>::MNAT * 1.4426950408889634f;
#pragma unroll
    for (int r = 0; r < 16; ++r) p0[r] = __builtin_amdgcn_exp2f(fmaf(p0[r], C, MC));
#pragma unroll
    for (int r = 0; r < 16; ++r) p1[r] = __builtin_amdgcn_exp2f(fmaf(p1[r], C, MC));
    float ps = 0;
#pragma unroll
    for (int r = 0; r < 16; ++r) ps += p0[r];
#pragma unroll
    for (int r = 0; r < 16; ++r) ps += p1[r];
    { auto rr = __builtin_amdgcn_permlane32_swap(__float_as_uint(ps), __float_as_uint(ps), false, false);
      ps = __uint_as_float(rr[0]) + __uint_as_float(rr[1]); }
    l_reg += ps;
#define AT_PK4(P, BASE, OUT) do { unsigned a0 = cvt_pk_bf16(P[BASE + 0], P[BASE + 1]), a1 = cvt_pk_bf16(P[BASE + 2], P[BASE + 3]);   \
    unsigned b0 = cvt_pk_bf16(P[BASE + 4], P[BASE + 5]), b1 = cvt_pk_bf16(P[BASE + 6], P[BASE + 7]);                              \
    auto r0 = __builtin_amdgcn_permlane32_swap(a0, b0, false, false); auto r1 = __builtin_amdgcn_permlane32_swap(a1, b1, false, false); \
    u32x4 w = {r0[0], r1[0], r0[1], r1[1]}; OUT = __builtin_bit_cast(bf16x8, w); } while (0)
    AT_PK4(p0, 0, pa0); AT_PK4(p0, 8, pa1); AT_PK4(p1, 0, pa2); AT_PK4(p1, 8, pa3);
#undef AT_PK4
}
template <int DQK> __device__ __forceinline__ void qkt(f32x16& p0, f32x16& p1, LAS const unsigned char* Ks, const bf16x8* qr, int r32, int hi) {
#pragma unroll
    for (int r = 0; r < 16; ++r) { p0[r] = 0.f; p1[r] = 0.f; }
#pragma unroll
    for (int d0 = 0; d0 < DQK / 16; ++d0) { const int cb = (d0 * 16 + hi * 8) * 2;
        const bf16x8 b0 = *(LAS const bf16x8*)(Ks + kswz<DQK>(r32, cb));
        const bf16x8 b1 = *(LAS const bf16x8*)(Ks + kswz<DQK>(32 + r32, cb));
        p0 = __builtin_amdgcn_mfma_f32_32x32x16_bf16(b0, qr[d0], p0, 0, 0, 0);
        p1 = __builtin_amdgcn_mfma_f32_32x32x16_bf16(b1, qr[d0], p1, 0, 0, 0); }
}
struct AttnP {
    const bf16_t *zq, *zk, *zv;
    int tokbase, stride;
    int q0;
    int kstart;
    int NT;
    int W;
};
__device__ __forceinline__ void mask_tile(f32x16& p0, f32x16& p1, int qm, int kb, int W, int hi, int qw0) {
    const bool full = (qw0 - (kb + 63) >= 0) && (qw0 + 31 - kb <= W) && (kb >= 0);
    if (full) return;
    const float ninf = -__builtin_inff();
#pragma unroll
    for (int r = 0; r < 16; ++r) { const int km = kb + crow(r, hi); const int d0 = qm - km, d1 = d0 - 32;
        p0[r] = (d0 >= 0 && d0 <= W && km >= 0) ? p0[r] : ninf;
        p1[r] = (d1 >= 0 && d1 <= W && km + 32 >= 0) ? p1[r] : ninf; }
}
template <int DQK>
__device__ __forceinline__ void attn_run(const AttnP& P, LAS unsigned char* lds, f32x16 (&o)[4], float& l_reg, float& m_reg) {
    const int tid = opaque_tid(), wid = __builtin_amdgcn_readfirstlane(tid >> 6), lane = tid & 63, r32 = lane & 31, hi = lane >> 5;
    constexpr int KSUB = 64 * DQK * 2, KBUF = 2 * KSUB, VSUB = 16384, VBUF = 2 * VSUB;
    LAS unsigned char* K_lds = lds; LAS unsigned char* V_lds = lds + 2 * KBUF;
    m_reg = SmC<DQK>::MNAT / SmC<DQK>::SCALE; l_reg = 0.f;
#pragma unroll
    for (int d = 0; d < 4; ++d)
#pragma unroll
        for (int r = 0; r < 16; ++r) o[d][r] = 0.f;
    const int qw0 = P.q0 + wid * 32, qm = qw0 + r32;
    bf16x8 qr[DQK / 16];
    { const bf16_t* Qw = P.zq + (size_t)(P.tokbase + qm * P.stride) * WIN + hi * 8;
#pragma unroll
      for (int d0 = 0; d0 < DQK / 16; ++d0) qr[d0] = *(const bf16x8*)(Qw + d0 * 16); }
    int vkey[2], vcol[2], kkey[2], kcol[2];
#pragma unroll
    for (int i = 0; i < 2; ++i) { const int off = (tid + 512 * i) * 16; const int sub = off >> 9, within = off & 511, kk = (sub >> 2) * 8 + (within >> 6);
        vkey[i] = (kk & ~0xC) | ((kk & 4) << 1) | ((kk & 8) >> 1); vcol[i] = (sub & 3) * 32 + ((within & 63) >> 1);
        if (DQK == 128) { const int row = off >> 8, cs = off & 255; kkey[i] = row; kcol[i] = (cs ^ ((row & 7) << 4)) >> 1; }
        else { const int row = off >> 7, cs = off & 127; kkey[i] = row; kcol[i] = (cs ^ (((row >> 1) & 7) << 4)) >> 1; } }
    const unsigned vb0 = (unsigned)(size_t)V_lds + v_rd_base(lane);
#define AT_ROW(km) ((size_t)(P.tokbase + ((km) < 0 ? 0 : (km)) * P.stride) * WIN)
#define AT_DMA(jp, b) do { _Pragma("unroll") for (int s_ = 0; s_ < 2; ++s_) { const int k0_ = P.kstart + (2 * (jp) + s_) * 64; \
        _Pragma("unroll") for (int i_ = 0; i_ < 2; ++i_) __builtin_amdgcn_global_load_lds((const unsigned*)(P.zv + AT_ROW(k0_ + vkey[i_]) + vcol[i_]), (LAS unsigned*)(V_lds + (b) * VBUF + s_ * VSUB + wid * 1024 + i_ * 8192), 16, 0, 0); \
        _Pragma("unroll") for (int i_ = 0; i_ < (DQK == 128 ? 2 : 1); ++i_) __builtin_amdgcn_global_load_lds((const unsigned*)(P.zk + AT_ROW(k0_ + kkey[i_]) + kcol[i_]), (LAS unsigned*)(K_lds + (b) * KBUF + s_ * KSUB + wid * 1024 + i_ * 8192), 16, 0, 0); } } while (0)
    f32x16 pA0, pA1, pB0, pB1; bf16x8 pa0, pa1, pa2, pa3; const int NT2 = P.NT >> 1;
    AT_DMA(0, 0); VM_WAIT(); __syncthreads();
#pragma unroll 1
    for (int jp = 0; jp < NT2; ++jp) {
        const int b = jp & 1;
        if (jp + 1 < NT2) AT_DMA(jp + 1, b ^ 1);
        SBAR();
        const int kbA = P.kstart + jp * 128, kbB = kbA + 64;
        const bool noneA = (qw0 + 31 - kbA < 0) || (qw0 - (kbA + 63) > P.W) || (kbA + 63 < 0);
        const bool noneB = (qw0 + 31 - kbB < 0) || (qw0 - (kbB + 63) > P.W) || (kbB + 63 < 0);
        if (!noneA) qkt<DQK>(pA0, pA1, K_lds + b * KBUF, qr, r32, hi);
        if (!noneB) qkt<DQK>(pB0, pB1, K_lds + b * KBUF + KSUB, qr, r32, hi);
        SBAR();
        if (!noneA) { mask_tile(pA0, pA1, qm, kbA, P.W, hi, qw0); softmax_tile<DQK>(pA0, pA1, l_reg, pa0, pa1, pa2, pa3); SBAR(); pv_d0(o, vb0 + b * VBUF, pa0, pa1, pa2, pa3); }
        if (!noneB) { mask_tile(pB0, pB1, qm, kbB, P.W, hi, qw0); softmax_tile<DQK>(pB0, pB1, l_reg, pa0, pa1, pa2, pa3); SBAR(); pv_d0(o, vb0 + b * VBUF + VSUB, pa0, pa1, pa2, pa3); }
        VM_WAIT(); __syncthreads();
    }
#undef AT_ROW
#undef AT_DMA
}
__device__ __forceinline__ void attn_normalise(LAS unsigned char* lds, f32x16 (&o)[4], float l_reg) {
    const int tid = opaque_tid(), wid = tid >> 6, lane = tid & 63, r32 = lane & 31, hi = lane >> 5;
    LAS float* li_l = (LAS float*)(lds + LDS_WS) + wid * 64;
    if (hi == 0) li_l[r32] = l_reg; asm volatile("s_waitcnt lgkmcnt(0)" ::: "memory");
#pragma unroll
    for (int r = 0; r < 16; ++r) { const float rl = __builtin_amdgcn_rcpf(li_l[crow(r, hi)]);
#pragma unroll
        for (int d = 0; d < 4; ++d) o[d][r] *= rl; }
    asm volatile("s_waitcnt lgkmcnt(0)" ::: "memory");
}
}

#define XB_TMO      128
#define XB_XCNT(j)  (256  + 64 * (j))
#define XB_XSUB(j)  (1280 + 64 * (j))
#define XB_XGEN(j)  (2304 + 64 * (j))
#define XB_TOP      3328
#define XB_TOPGEN   3392
#define XCD_BAR_WORDS 3456
#define XB_SPIN_CAP (1u << 18)

__device__ __forceinline__ unsigned xb_ld(unsigned* p)              { return __hip_atomic_load(p, __ATOMIC_RELAXED, __HIP_MEMORY_SCOPE_AGENT); }
__device__ __forceinline__ unsigned xb_add(unsigned* p, unsigned v) { return __hip_atomic_fetch_add(p, v, __ATOMIC_RELAXED, __HIP_MEMORY_SCOPE_AGENT); }
__device__ __forceinline__ unsigned xb_xcc_id() { return (unsigned)__builtin_amdgcn_s_getreg((3 << 11) | 20) & 0xFu; }
#define XB_SPIN(cond, bar) do { unsigned _sp = 0; while (cond) { __builtin_amdgcn_s_sleep(1); \
    if ((++_sp & 255u) == 0u) { if (xb_ld(&(bar)[XB_TMO])) break; if (_sp > XB_SPIN_CAP) { atomicAdd(&(bar)[XB_TMO], 1u); break; } } } } while (0)

struct XcdBarrier {
    unsigned* bar; unsigned x;
    volatile LAS unsigned* st;
};

__device__ __forceinline__ XcdBarrier xcd_barrier_post(unsigned* bar, volatile LAS unsigned* st) {
    XcdBarrier b; b.bar = bar; b.x = xb_xcc_id(); b.st = st;
    if (threadIdx.x == 0) (void)xb_add(&bar[XB_XCNT(b.x)], 1u);
    return b;
}
__device__ __forceinline__ void xcd_barrier_complete(unsigned* bar, unsigned x, unsigned& nloc, unsigned& nx) {
    const unsigned G = gridDim.x * gridDim.y * gridDim.z;
    unsigned sum, cnt, mine, sp = 0u;
    for (;;) {
        sum = 0u; cnt = 0u; mine = 0u;
#pragma unroll
        for (unsigned j = 0; j < 16; ++j) { const unsigned c = xb_ld(&bar[XB_XCNT(j)]); sum += c; cnt += (c > 0u) ? 1u : 0u; mine = (j == x) ? c : mine; }
        if (sum == G) break;
        __builtin_amdgcn_s_sleep(1);
        if ((++sp & 255u) == 0u) { if (xb_ld(&bar[XB_TMO])) break; if (sp > XB_SPIN_CAP) { atomicAdd(&bar[XB_TMO], 1u); break; } }
    }
    nloc = mine > 0u ? mine : 1u; nx = cnt > 0u ? cnt : 1u;
}

__device__ __forceinline__ void xcd_barrier(const XcdBarrier& b) {
    asm volatile("s_waitcnt vmcnt(0)" ::: "memory");
    __syncthreads();
    if (threadIdx.x == 0) {
        unsigned* bar = b.bar;
        __builtin_amdgcn_s_waitcnt(0);
        unsigned nloc = b.st[0], nx = b.st[1];
        if (nloc == 0u) { xcd_barrier_complete(bar, b.x, nloc, nx); b.st[0] = nloc; b.st[1] = nx; }
        const unsigned old = xb_add(&bar[XB_XSUB(b.x)], 1u);
        const unsigned gen = old / nloc;
        if (old + 1u == (gen + 1u) * nloc) {
            __builtin_amdgcn_fence(__ATOMIC_RELEASE, "agent");
            asm volatile("s_waitcnt vmcnt(0)" ::: "memory");
            const unsigned og = xb_add(&bar[XB_TOP], 1u);
            const unsigned tg = og / nx;
            if (og + 1u == (tg + 1u) * nx) xb_add(&bar[XB_TOPGEN], 1u);
            else XB_SPIN(xb_ld(&bar[XB_TOPGEN]) == tg, bar);
            __builtin_amdgcn_fence(__ATOMIC_ACQUIRE, "agent");
            xb_add(&bar[XB_XGEN(b.x)], 1u);
            asm volatile("s_waitcnt vmcnt(0)" ::: "memory");
        } else {
            XB_SPIN(xb_ld(&bar[XB_XGEN(b.x)]) == gen, bar);
            __builtin_amdgcn_fence(__ATOMIC_ACQUIRE, "agent");
            asm volatile("s_waitcnt vmcnt(0)" ::: "memory");
        }
    }
    __syncthreads();
}

struct Args { const float* in[27]; float* out; unsigned char* ws; int ph_lo, ph_hi, mix_mask, pad; };
enum { I_X = 0, I_NORM_MIX, I_W_IN, I_SG_NORM, I_SG_W, I_SG_B, I_CONV_W, I_QN_C, I_KN_C, I_QN_D, I_KN_D, I_LQ1, I_LK1, I_LQ2, I_LK2, I_SUBLN, I_W_GATE, I_B_GATE, I_W_BRANCH, I_W_OUT,
       I_NORM_FFN, I_W_RG, I_B_RG, I_W_RE, I_B_RE, I_W_UP, I_W_DOWN };

__device__ __forceinline__ int perm_in(int n) {
    const int pn = n >> 8, tc = n & 255, bj = tc >> 7, wc = (tc >> 5) & 3, x = tc & 31;
    if (pn >= 10 && pn < 22) return ZC + (2 * (pn - 10) + (wc >> 1)) * 128 + 64 * bj + 32 * (wc & 1) + x;
    if (pn >= 28 && pn < 32) return ZD + (pn - 28) * 256 + wc * 64 + 32 * bj + x;
    return n;
}
__device__ __forceinline__ void tr_item(const float* colp, size_t ld, bf16_t* WT, int ldk, int n0, int k0, LAS float* scr, int lane) {
#pragma unroll 8
    for (int i = 0; i < 32; ++i) { const int kk = 2 * i + (lane >> 5); scr[kk * 33 + (lane & 31)] = colp[(size_t)(k0 + kk) * ld]; }
    LDS_WAIT(); asm volatile("" ::: "memory");
    const int c = lane & 7;
#pragma unroll
    for (int j = 0; j < 4; ++j) { const int n = (lane >> 3) + 8 * j; const LAS float* s = scr + (8 * c) * 33 + n;
        u32x4 o; o.x = cvt_pk_bf16(s[0 * 33], s[1 * 33]); o.y = cvt_pk_bf16(s[2 * 33], s[3 * 33]); o.z = cvt_pk_bf16(s[4 * 33], s[5 * 33]); o.w = cvt_pk_bf16(s[6 * 33], s[7 * 33]);
        *(u32x4*)(WT + (size_t)(n0 + n) * ldk + k0 + 8 * c) = o; }
    LDS_WAIT(); asm volatile("" ::: "memory");
}
__device__ __forceinline__ void tr_item_fp8(const float* colp, size_t ld, unsigned char* WT, int ldk, int n0, int k0, LAS float* scr, int lane, float scale) {
#pragma unroll 8
    for (int i = 0; i < 32; ++i) { const int kk = 2 * i + (lane >> 5); scr[kk * 33 + (lane & 31)] = colp[(size_t)(k0 + kk) * ld]; }
    LDS_WAIT(); asm volatile("" ::: "memory");
    const int n = lane >> 1, kh = (lane & 1) * 32; const LAS float* s = scr + kh * 33 + n;
    u32x4 o[2];
#pragma unroll
    for (int q = 0; q < 8; ++q) { int p = __builtin_amdgcn_cvt_pk_fp8_f32(s[(4 * q) * 33] * scale, s[(4 * q + 1) * 33] * scale, 0, false); p = __builtin_amdgcn_cvt_pk_fp8_f32(s[(4 * q + 2) * 33] * scale, s[(4 * q + 3) * 33] * scale, p, true); o[q >> 2][q & 3] = (unsigned)p; }
    *(u32x4*)(WT + (size_t)(n0 + n) * ldk + k0 + kh) = o[0]; *(u32x4*)(WT + (size_t)(n0 + n) * ldk + k0 + kh + 16) = o[1];
    LDS_WAIT(); asm volatile("" ::: "memory");
}
__device__ __forceinline__ void phase_prologue(const Args& a, LAS unsigned char* lds) {
    const int tid = opaque_tid(), wave = tid >> 6, lane = tid & 63, gw = blockIdx.x * NWAVES + wave, NGW = gridDim.x * NWAVES;
    LAS float* scr = (LAS float*)(lds + wave * 8704);
    const int l32 = lane & 31;
    for (int l = 0; l < 2; ++l) {
        unsigned char* wb = a.ws + WS_W + (size_t)l * W_LAYER;
        {
            const float* W = a.in[I_W_IN] + (size_t)l * D * WIN; bf16_t* WT = (bf16_t*)(wb + W_IN); const int nblk = WIN / 32;
            for (int it = gw; it < (D / 64) * nblk; it += NGW) { const int kb = it / nblk, nb = it % nblk;
                if ((MK_Z8 >> l) & 1) tr_item_fp8(W + perm_in(nb * 32 + l32), WIN, (unsigned char*)WT, D, nb * 32, kb * 64, scr, lane, 64.f);
                else tr_item(W + perm_in(nb * 32 + l32), WIN, WT, D, nb * 32, kb * 64, scr, lane); } }
        {
            const float* W = a.in[I_W_GATE] + (size_t)l * 4 * D * D; unsigned char* WT = wb + W_G; const int nblk = 8192 / 32;
            for (int it = gw; it < (D / 64) * nblk; it += NGW) { const int kb = it / nblk, nb = it % nblk; const int n = nb * 32 + l32, pn = n >> 8, tc = n & 255;
                const int bj = tc >> 7, wc = (tc >> 5) & 3, fq = (tc >> 3) & 3, nn = (tc >> 2) & 1, j = tc & 3, k = 2 * bj + nn, c = 64 * pn + 16 * wc + 4 * fq + j;
                tr_item_fp8(W + (size_t)k * D * D + c, D, WT, D, nb * 32, kb * 64, scr, lane, 64.f); } }
        {
            const float* W = a.in[I_W_BRANCH] + (size_t)l * 4 * 512 * D; bf16_t* WT = (bf16_t*)(wb + W_B); const int nblk = D / 32, per = (512 / 64) * nblk;
            for (int it = gw; it < 4 * per; it += NGW) { const int k = it / per, r = it % per, kb = r / nblk, nb = r % nblk;
                tr_item(W + (size_t)k * 512 * D + nb * 32 + l32, D, WT + (size_t)k * D * 512, 512, nb * 32, kb * 64, scr, lane); } }
        {
            const float* W = a.in[I_W_OUT] + (size_t)l * D * D; bf16_t* WT = (bf16_t*)(wb + W_O); const int nblk = D / 32;
            for (int it = gw; it < (D / 64) * nblk; it += NGW) { const int kb = it / nblk, nb = it % nblk;
                if (((MK_WO8 >> l) & 1) && !MK_DEBUG) tr_item_fp8(W + nb * 32 + l32, D, (unsigned char*)WT, D, nb * 32, kb * 64, scr, lane, 64.f);
                else tr_item(W + nb * 32 + l32, D, WT, D, nb * 32, kb * 64, scr, lane); } }
        {
            const float* W = a.in[I_W_UP] + (size_t)l * NEXP * D * 1024; bf16_t* WT = (bf16_t*)(wb + W_UP); const int nblk = 1024 / 32, per = (D / 64) * nblk;
            for (int it = gw; it < NEXP * per; it += NGW) { const int e = it / per, r = it % per, kb = r / nblk, nb = r % nblk; const int n = nb * 32 + l32, pn = n >> 8, tc = n & 255;
                const int src = (tc >> 7) * 512 + 128 * pn + (tc & 127);
                if (MK_MOE8 && l >= 0) tr_item_fp8(W + (size_t)e * D * 1024 + src, 1024, (unsigned char*)WT + (size_t)e * 1024 * D, D, nb * 32, kb * 64, scr, lane, 64.f);
                else tr_item(W + (size_t)e * D * 1024 + src, 1024, WT + (size_t)e * 1024 * D, D, nb * 32, kb * 64, scr, lane); } }
        {
            const float* W = a.in[I_W_DOWN] + (size_t)l * NEXP * 512 * D; bf16_t* WT = (bf16_t*)(wb + W_DN); const int nblk = D / 32, per = (512 / 64) * nblk;
            for (int it = gw; it < NEXP * per; it += NGW) { const int e = it / per, r = it % per, kb = r / nblk, nb = r % nblk;
                if (MK_MOE8 && l >= 0) tr_item_fp8(W + (size_t)e * 512 * D + nb * 32 + l32, D, (unsigned char*)WT + (size_t)e * D * 512, 512, nb * 32, kb * 64, scr, lane, 64.f);
                else tr_item(W + (size_t)e * 512 * D + nb * 32 + l32, D, WT + (size_t)e * D * 512, 512, nb * 32, kb * 64, scr, lane); } }
        {
            bf16_t* WT = (bf16_t*)(wb + W_R); const float* wrg = a.in[I_W_RG] + (size_t)l * D * 4; const float* wre = a.in[I_W_RE] + (size_t)l * D * 32;
            for (int i = blockIdx.x * NTHR + tid; i < 48 * D; i += gridDim.x * NTHR) { const int n = i / D, k = i % D; float v = 0.f;
                if (n < 4) v = wrg[k * 4 + n]; else if (n < 36) v = wre[k * 32 + (n - 4)];
                WT[i] = (bf16_t)(cvt_pk_bf16(v, 0.f) & 0xffffu); } }
    }
    float* cosC = (float*)(a.ws + WS_COSC); float* sinC = (float*)(a.ws + WS_SINC); float* cosD = (float*)(a.ws + WS_COSD); float* sinD = (float*)(a.ws + WS_SIND);
    for (int i = blockIdx.x * NTHR + tid; i < SEQ * 96; i += gridDim.x * NTHR) {
        if (i < SEQ * 64) { const int p = i >> 6, k = i & 63; const float inv = (float)pow(10000.0, -(double)k / 64.0); const float ang = (float)p * inv; double s, c; sincos((double)ang, &s, &c); cosC[i] = (float)c; sinC[i] = (float)s; }
        else { const int q = i - SEQ * 64, p = q >> 5, k = q & 31; const float inv = (float)pow(10000.0, -(double)k / 32.0); const float ang = (float)p * inv; double s, c; sincos((double)ang, &s, &c); cosD[q] = (float)c; sinD[q] = (float)s; }
    }
}
__device__ __forceinline__ void phase_norm(const float* xf, const bf16_t* xb, const bf16_t* y0, const bf16_t* y1, bf16_t* xb_out, float* xf_out, const float* gain, bf16_t* h, unsigned* h8, const bool y8 = false) {
    const int tid = opaque_tid(), wave = tid >> 6, lane = tid & 63, gw = blockIdx.x * NWAVES + wave, NGW = gridDim.x * NWAVES;
    for (int m0 = gw; m0 < T; m0 += 2 * NGW) {
        f32x4 v[2][8];
#pragma unroll
        for (int r = 0; r < 2; ++r) { const int m = m0 + r * NGW; if (m < T) {
            if (xf) { const f32x4* xr = (const f32x4*)(xf + (size_t)m * D) + lane;
#pragma unroll
                for (int j = 0; j < 8; ++j) v[r][j] = __builtin_nontemporal_load(xr + 64 * j); }
            else { const u32x2* xr = (const u32x2*)(xb + (size_t)m * D) + lane;
#pragma unroll
                for (int j = 0; j < 8; ++j) { const u32x2 p = xr[64 * j]; v[r][j] = (f32x4){bf_lo(p.x), bf_hi(p.x), bf_lo(p.y), bf_hi(p.y)}; } } } }
        if (y0) {
#pragma unroll
            for (int r = 0; r < 2; ++r) { const int m = m0 + r * NGW; if (m < T) {
                if (y8) { const unsigned* a0 = (const unsigned*)((const unsigned char*)y0 + (size_t)m * D) + lane; const unsigned* a1 = (const unsigned*)((const unsigned char*)y1 + (size_t)m * D) + lane;
#pragma unroll
                    for (int j = 0; j < 8; ++j) { const int p = (int)__builtin_nontemporal_load(a0 + 64 * j), q = (int)__builtin_nontemporal_load(a1 + 64 * j);
                        v[r][j][0] += (__builtin_amdgcn_cvt_f32_fp8(p, 0) + __builtin_amdgcn_cvt_f32_fp8(q, 0)) * 0.0625f; v[r][j][1] += (__builtin_amdgcn_cvt_f32_fp8(p, 1) + __builtin_amdgcn_cvt_f32_fp8(q, 1)) * 0.0625f;
                        v[r][j][2] += (__builtin_amdgcn_cvt_f32_fp8(p, 2) + __builtin_amdgcn_cvt_f32_fp8(q, 2)) * 0.0625f; v[r][j][3] += (__builtin_amdgcn_cvt_f32_fp8(p, 3) + __builtin_amdgcn_cvt_f32_fp8(q, 3)) * 0.0625f; } }
                else {
                const u32x2* a0 = (const u32x2*)(y0 + (size_t)m * D) + lane; const u32x2* a1 = (const u32x2*)(y1 + (size_t)m * D) + lane;
#pragma unroll
                for (int j = 0; j < 8; ++j) { const u32x2 p = __builtin_nontemporal_load(a0 + 64 * j), q = __builtin_nontemporal_load(a1 + 64 * j);
                    v[r][j][0] += bf_lo(p.x) + bf_lo(q.x); v[r][j][1] += bf_hi(p.x) + bf_hi(q.x); v[r][j][2] += bf_lo(p.y) + bf_lo(q.y); v[r][j][3] += bf_hi(p.y) + bf_hi(q.y); } } } }
        }
        if (xb_out) {
#pragma unroll
            for (int r = 0; r < 2; ++r) { const int m = m0 + r * NGW; if (m < T) { u32x2* xo = (u32x2*)(xb_out + (size_t)m * D) + lane;
#pragma unroll
                for (int j = 0; j < 8; ++j) { u32x2 w; w.x = cvt_pk_bf16(v[r][j][0], v[r][j][1]); w.y = cvt_pk_bf16(v[r][j][2], v[r][j][3]); xo[64 * j] = w; } } }
        }
        if (xf_out) {
#pragma unroll
            for (int r = 0; r < 2; ++r) { const int m = m0 + r * NGW; if (m < T) { f32x4* xo = (f32x4*)(xf_out + (size_t)m * D) + lane;
#pragma unroll
                for (int j = 0; j < 8; ++j) xo[64 * j] = v[r][j]; } }
        }
        if (h || h8) {
#pragma unroll
            for (int r = 0; r < 2; ++r) { const int m = m0 + r * NGW; if (m < T) { float ss = 0.f;
#pragma unroll
                for (int j = 0; j < 8; ++j) ss += (v[r][j][0] * v[r][j][0] + v[r][j][1] * v[r][j][1]) + (v[r][j][2] * v[r][j][2] + v[r][j][3] * v[r][j][3]);
                const float rstd = 1.0f / sqrtf(wave_sum(ss) * (1.0f / D) + EPS);
                u32x2* ho = (u32x2*)(h + (size_t)m * D) + lane; const f32x4* gr = (const f32x4*)gain + lane;
#pragma unroll
                for (int j = 0; j < 8; ++j) { const f32x4 g = gr[64 * j]; const float h0 = v[r][j][0] * rstd * g[0], h1 = v[r][j][1] * rstd * g[1], h2 = v[r][j][2] * rstd * g[2], h3 = v[r][j][3] * rstd * g[3];
                    if (h) { u32x2 w; w.x = cvt_pk_bf16(h0, h1); w.y = cvt_pk_bf16(h2, h3); ho[64 * j] = w; }
                    if (h8) { int p = __builtin_amdgcn_cvt_pk_fp8_f32(h0, h1, 0, false); p = __builtin_amdgcn_cvt_pk_fp8_f32(h2, h3, p, true); h8[(size_t)m * (D / 4) + lane + 64 * j] = (unsigned)p; } } } }
        }
    }
}
__device__ __forceinline__ void mixer_a_unit(const Args& a, int l, int chunk, LAS unsigned char* lds) {
    const int tid = opaque_tid(), wid = tid >> 6, lane = tid & 63, r32 = lane & 31, hi = lane >> 5;
    const bf16_t* Z = (const bf16_t*)(a.ws + WS_Z); bf16_t* Y = (bf16_t*)(a.ws + WS_Y);
    const int t0 = chunk * 128;
    {
        const int j = tid >> 2, g = tid & 3; const bf16_t* vp = Z + (size_t)(t0 + j) * WIN + 512 + g * 128; const float* gn = a.in[I_SG_NORM] + l * 512 + g * 128;
        u32x4 raw[16]; float ss = 0.f;
#pragma unroll
        for (int c = 0; c < 16; ++c) { raw[c] = *(const u32x4*)(vp + c * 8);
#pragma unroll
            for (int q = 0; q < 4; ++q) { const float x0 = bf_lo(raw[c][q]), x1 = bf_hi(raw[c][q]); ss += x0 * x0 + x1 * x1; } }
        ss += __shfl_xor(ss, 1); ss += __shfl_xor(ss, 2);
        const float rstd = 1.0f / sqrtf(ss * (1.0f / 512.0f) + EPS);
        LAS unsigned char* img = lds + g * 32768 + (j >> 6) * 16384;
#pragma unroll
        for (int c = 0; c < 16; ++c) { const f32x4 g0 = *(const f32x4*)(gn + c * 8), g1 = *(const f32x4*)(gn + c * 8 + 4); u32x4 w;
            w.x = cvt_pk_bf16(bf_lo(raw[c].x) * rstd * g0[0], bf_hi(raw[c].x) * rstd * g0[1]); w.y = cvt_pk_bf16(bf_lo(raw[c].y) * rstd * g0[2], bf_hi(raw[c].y) * rstd * g0[3]);
            w.z = cvt_pk_bf16(bf_lo(raw[c].z) * rstd * g1[0], bf_hi(raw[c].z) * rstd * g1[1]); w.w = cvt_pk_bf16(bf_lo(raw[c].w) * rstd * g1[2], bf_hi(raw[c].w) * rstd * g1[3]);
            *(LAS u32x4*)(img + at::v_st(j & 63, c * 8)) = w; }
    }
    __syncthreads();
    f32x16 o2[2][4];
    const int g = wid >> 1;
    { const float* Wg = a.in[I_SG_W] + ((size_t)(l * 4 + g) * 128) * 128;
#pragma unroll
      for (int ibs = 0; ibs < 2; ++ibs) { const int ib = 2 * (wid & 1) + ibs; const int i = 32 * ib + r32;
#pragma unroll
        for (int d = 0; d < 4; ++d)
#pragma unroll
            for (int r = 0; r < 16; ++r) o2[ibs][d][r] = 0.f;
        for (int jt = 0; jt < 2; ++jt) {
            if (64 * jt > 32 * ib + 31) continue;
            bf16x8 pa[4];
#pragma unroll
            for (int ks = 0; ks < 4; ++ks) { const int j0 = 64 * jt + 16 * ks + 8 * hi; const f32x4 w0 = *(const f32x4*)(Wg + (size_t)i * 128 + j0), w1 = *(const f32x4*)(Wg + (size_t)i * 128 + j0 + 4);
                float w[8] = {w0[0], w0[1], w0[2], w0[3], w1[0], w1[1], w1[2], w1[3]};
#pragma unroll
                for (int q = 0; q < 8; ++q) w[q] = (j0 + q <= i) ? w[q] : 0.f;
                u32x4 pk; pk.x = cvt_pk_bf16(w[0], w[1]); pk.y = cvt_pk_bf16(w[2], w[3]); pk.z = cvt_pk_bf16(w[4], w[5]); pk.w = cvt_pk_bf16(w[6], w[7]); pa[ks] = __builtin_bit_cast(bf16x8, pk); }
            const unsigned vb = (unsigned)(size_t)(lds + g * 32768 + jt * 16384) + at::v_rd_base(lane);
            at::pv_d0(o2[ibs], vb, pa[0], pa[1], pa[2], pa[3]);
        }
      } }
    __syncthreads();
    { const float* bs = a.in[I_SG_B] + (l * 4 + g) * 128;
#pragma unroll
      for (int ibs = 0; ibs < 2; ++ibs) { const int ib = 2 * (wid & 1) + ibs;
#pragma unroll
        for (int r = 0; r < 16; ++r) { const int ii = 32 * ib + at::crow(r, hi); const float b = bs[ii];
#pragma unroll
            for (int d = 0; d < 4; ++d) *(LAS bf16_t*)(lds + g * 32768 + ii * 256 + (32 * d + r32) * 2) = (bf16_t)(cvt_pk_bf16(o2[ibs][d][r] + b, 0.f) & 0xffffu); } } }
    __syncthreads();
#pragma unroll 4
    for (int k = 0; k < 16; ++k) { const int chunk = tid + 512 * k, i = chunk >> 6, c8 = (chunk & 63) * 8;
        const u32x4 mx = *(const LAS u32x4*)(lds + (c8 >> 7) * 32768 + i * 256 + (c8 & 127) * 2); const u32x4 uu = *(const u32x4*)(Z + (size_t)(t0 + i) * WIN + c8); u32x4 y;
#pragma unroll
        for (int q = 0; q < 4; ++q) y[q] = cvt_pk_bf16(bf_lo(uu[q]) * bf_lo(mx[q]), bf_hi(uu[q]) * bf_hi(mx[q]));
        *(u32x4*)(Y + (size_t)(t0 + i) * D + c8) = y; }
    __syncthreads();
}
__device__ __forceinline__ void mixer_b(const Args& a, int l) {
    const int tid = opaque_tid(), wave = tid >> 6, lane = tid & 63, gw = blockIdx.x * NWAVES + wave, NGW = gridDim.x * NWAVES;
    const bf16_t* Z = (const bf16_t*)(a.ws + WS_Z); bf16_t* Y = (bf16_t*)(a.ws + WS_Y); const float* cw = a.in[I_CONV_W] + l * 3 * 512; const int c = lane * 8;
    float kw[3][8];
#pragma unroll
    for (int w = 0; w < 3; ++w) { const f32x4 k0 = *(const f32x4*)(cw + w * 512 + c), k1 = *(const f32x4*)(cw + w * 512 + c + 4);
        kw[w][0] = k0[0]; kw[w][1] = k0[1]; kw[w][2] = k0[2]; kw[w][3] = k0[3]; kw[w][4] = k1[0]; kw[w][5] = k1[1]; kw[w][6] = k1[2]; kw[w][7] = k1[3]; }
    for (int blk = gw; blk < T / 8; blk += NGW) { const int t0 = blk * 8; const bool first = (t0 & (SEQ - 1)) == 0;
        const bf16_t* zr = Z + (size_t)t0 * WIN + ZB + c;
        u32x4 cg[10], hb[10], bg[8];
#pragma unroll
        for (int i = 0; i < 10; ++i) { if (i < 2 && first) { cg[i] = (u32x4){0u, 0u, 0u, 0u}; hb[i] = cg[i]; } else { const bf16_t* zz = zr + (ptrdiff_t)(i - 2) * WIN; cg[i] = *(const u32x4*)(zz + 512); hb[i] = *(const u32x4*)(zz + 1024); } }
#pragma unroll
        for (int i = 0; i < 8; ++i) bg[i] = *(const u32x4*)(zr + (size_t)i * WIN);
        float p2[8], p1[8];
#pragma unroll
        for (int q = 0; q < 4; ++q) { p2[2 * q] = bf_lo(cg[0][q]) * bf_lo(hb[0][q]); p2[2 * q + 1] = bf_hi(cg[0][q]) * bf_hi(hb[0][q]); p1[2 * q] = bf_lo(cg[1][q]) * bf_lo(hb[1][q]); p1[2 * q + 1] = bf_hi(cg[1][q]) * bf_hi(hb[1][q]); }
#pragma unroll
        for (int i = 0; i < 8; ++i) { float p0[8]; u32x4 o;
#pragma unroll
            for (int q = 0; q < 4; ++q) { p0[2 * q] = bf_lo(cg[i + 2][q]) * bf_lo(hb[i + 2][q]); p0[2 * q + 1] = bf_hi(cg[i + 2][q]) * bf_hi(hb[i + 2][q]); }
#pragma unroll
            for (int q = 0; q < 4; ++q) { const float y0 = kw[0][2 * q] * p2[2 * q] + kw[1][2 * q] * p1[2 * q] + kw[2][2 * q] * p0[2 * q], y1 = kw[0][2 * q + 1] * p2[2 * q + 1] + kw[1][2 * q + 1] * p1[2 * q + 1] + kw[2][2 * q + 1] * p0[2 * q + 1];
                o[q] = cvt_pk_bf16(bf_lo(bg[i][q]) * y0, bf_hi(bg[i][q]) * y1); }
            *(u32x4*)(Y + (size_t)(t0 + i) * D + 512 + c) = o;
#pragma unroll
            for (int q = 0; q < 8; ++q) { p2[q] = p1[q]; p1[q] = p0[q]; } }
    }
}
__device__ __forceinline__ void mixer_c_unit(const Args& a, int unit, LAS unsigned char* lds) {
    const int tid = opaque_tid(), wid = tid >> 6, lane = tid & 63, r32 = lane & 31, hi = lane >> 5;
    const int sub = unit & 15, h = (unit >> 4) & 3, g = (unit >> 6) % 3, b = unit / 192;
    const int dil = (g == 0) ? 1 : (g == 1 ? 4 : 16); const int r = (g == 0) ? 0 : (g == 1 ? (sub & 3) : sub); const int n2 = (g == 0) ? sub : (g == 1 ? (sub >> 2) : 0);
    const bf16_t* Z = (const bf16_t*)(a.ws + WS_Z);
    at::AttnP P; P.zq = Z + ZC + ((0 * 3 + g) * 4 + h) * 128; P.zk = Z + ZC + ((1 * 3 + g) * 4 + h) * 128; P.zv = Z + ZC + ((2 * 3 + g) * 4 + h) * 128;
    P.tokbase = b * SEQ + r; P.stride = dil; P.q0 = 256 * n2; P.kstart = 256 * n2 - 128; P.NT = 6; P.W = 128;
    f32x16 o[4]; float l_reg, m_reg;
    at::attn_run<128>(P, lds, o, l_reg, m_reg);
    at::attn_normalise(lds, o, l_reg);
    bf16_t* CO = (bf16_t*)(a.ws + WS_CO) + (size_t)g * T * 512; float* LSE = (float*)(a.ws + WS_LSE) + (size_t)g * T * 4;
    const int qw0 = P.q0 + wid * 32;
    if (hi == 0) { const int tok = P.tokbase + (qw0 + r32) * dil; LSE[(size_t)tok * 4 + h] = m_reg * 0.08838834764831845f + __logf(l_reg); }
#pragma unroll
    for (int rr = 0; rr < 16; ++rr) { const size_t tok = (size_t)(P.tokbase + (qw0 + at::crow(rr, hi)) * dil);
#pragma unroll
        for (int d = 0; d < 4; ++d) __builtin_nontemporal_store((bf16_t)(cvt_pk_bf16(o[d][rr], 0.f) & 0xffffu), &CO[tok * 512 + h * 128 + 32 * d + r32]); }
    __syncthreads();
}
__device__ __forceinline__ void mixer_c_merge(const Args& a) {
    const bf16_t* CO = (const bf16_t*)(a.ws + WS_CO); const float* LSE = (const float*)(a.ws + WS_LSE); bf16_t* Y = (bf16_t*)(a.ws + WS_Y);
    for (int it = blockIdx.x * NTHR + opaque_tid(); it < T * 64; it += gridDim.x * NTHR) { const int t = it >> 6, c = (it & 63) * 8, h = c >> 7;
        const float l0 = LSE[(size_t)t * 4 + h], l1 = LSE[(size_t)(T + t) * 4 + h], l2 = LSE[(size_t)(2 * T + t) * 4 + h]; const float mx = fmaxf(l0, fmaxf(l1, l2));
        float e0 = __expf(l0 - mx), e1 = __expf(l1 - mx), e2 = __expf(l2 - mx); const float inv = 1.0f / (e0 + e1 + e2); e0 *= inv; e1 *= inv; e2 *= inv;
        const u32x4 a0 = *(const u32x4*)(CO + (size_t)t * 512 + c), a1 = *(const u32x4*)(CO + ((size_t)T + t) * 512 + c), a2 = *(const u32x4*)(CO + ((size_t)2 * T + t) * 512 + c); u32x4 o;
#pragma unroll
        for (int q = 0; q < 4; ++q) o[q] = cvt_pk_bf16(e0 * bf_lo(a0[q]) + e1 * bf_lo(a1[q]) + e2 * bf_lo(a2[q]), e0 * bf_hi(a0[q]) + e1 * bf_hi(a1[q]) + e2 * bf_hi(a2[q]));
        *(u32x4*)(Y + (size_t)t * D + 1024 + c) = o; }
}
__device__ __forceinline__ float diff_lambda(const Args& a, int l, float lam_init) {
    const int lane = opaque_tid() & 63;
    const float s1 = wave_sum(a.in[I_LQ1][l * 64 + lane] * a.in[I_LK1][l * 64 + lane]), s2 = wave_sum(a.in[I_LQ2][l * 64 + lane] * a.in[I_LK2][l * 64 + lane]);
    return expf(s1) - expf(s2) + lam_init;
}
__device__ __forceinline__ void mixer_d_unit(const Args& a, int l, int unit, LAS unsigned char* lds) {
    const int tid = opaque_tid(), wid = tid >> 6, lane = tid & 63, r32 = lane & 31, hi = lane >> 5;
    const int pr = unit & 7, h = (unit >> 3) & 3, b = unit >> 5;
    const float lam_init = (l == 0) ? 0.2f : 0.35550906759096926f;
    const bf16_t* Z = (const bf16_t*)(a.ws + WS_Z); bf16_t* Y = (bf16_t*)(a.ws + WS_Y);
#pragma unroll 1
    for (int it = 0; it < 4; ++it) { const int qb = (it >> 1) ? 15 - pr : pr, map = it & 1;
        at::AttnP P; P.zq = Z + ZD + (h * 2 + map) * 64; P.zk = Z + ZD + 512 + (h * 2 + map) * 64; P.zv = Z + ZD + 1024 + h * 128;
        P.tokbase = b * SEQ; P.stride = 1; P.q0 = 256 * qb; P.kstart = 0; P.NT = 4 * (qb + 1); P.W = 1 << 29;
        f32x16 o[4]; float l_reg, m_reg;
        at::attn_run<64>(P, lds, o, l_reg, m_reg);
        at::attn_normalise(lds, o, l_reg);
        const int qw0 = P.q0 + wid * 32;
        if (map == 0) {
#pragma unroll
            for (int rr = 0; rr < 16; ++rr) { const size_t tok = (size_t)(P.tokbase + qw0 + at::crow(rr, hi));
#pragma unroll
                for (int d = 0; d < 4; ++d) Y[tok * D + 1536 + h * 128 + 32 * d + r32] = (bf16_t)(cvt_pk_bf16(o[d][rr], 0.f) & 0xffffu); }
            VM_WAIT();
        } else {
            const float lam = diff_lambda(a, l, lam_init); const float* sub = a.in[I_SUBLN] + l * 128;
            float sg[4];
#pragma unroll
            for (int d = 0; d < 4; ++d) sg[d] = sub[32 * d + r32] * (1.0f - lam_init);
#pragma unroll
            for (int rr = 0; rr < 16; ++rr) { const size_t tok = (size_t)(P.tokbase + qw0 + at::crow(rr, hi)); float ss = 0.f; float v[4];
#pragma unroll
                for (int d = 0; d < 4; ++d) { const float o1 = bf2f(Y[tok * D + 1536 + h * 128 + 32 * d + r32]); v[d] = o1 - lam * o[d][rr]; ss += v[d] * v[d]; }
                ss += __shfl_xor(ss, 1); ss += __shfl_xor(ss, 2); ss += __shfl_xor(ss, 4); ss += __shfl_xor(ss, 8); ss += __shfl_xor(ss, 16);
                const float rstd = 1.0f / sqrtf(ss * (1.0f / 128.0f) + EPS);
#pragma unroll
                for (int d = 0; d < 4; ++d) Y[tok * D + 1536 + h * 128 + 32 * d + r32] = (bf16_t)(cvt_pk_bf16(v[d] * rstd * sg[d], 0.f) & 0xffffu); }
        }
    }
}
__device__ __forceinline__ void phase_route(const Args& a, int l, LAS unsigned char* lds) {
    const int tid = opaque_tid(), wave = tid >> 6, lane = tid & 63, gw = blockIdx.x * NWAVES + wave, NGW = gridDim.x * NWAVES;
    const bf16_t* X = (const bf16_t*)(a.ws + WS_XB); bf16_t* H = (bf16_t*)(a.ws + WS_H); const bf16_t* WR = (const bf16_t*)(a.ws + WS_W + (size_t)l * W_LAYER + W_R);
    const float* gain = a.in[I_NORM_FFN] + l * D; const float* brg = a.in[I_B_RG] + l * 4; const float* bre = a.in[I_B_RE] + l * 32;
    unsigned* cnt = (unsigned*)(a.ws + WS_CTL) + CW_CNT + l * 32; u32x4* list = (u32x4*)(a.ws + WS_LIST); u32x4* route = (u32x4*)(a.ws + WS_ROUTE);
    LAS float* lg = (LAS float*)(lds + wave * 3072);
    const int rw = lane & 15, kg = lane >> 4;
    for (int grp = gw; grp < T / 16; grp += NGW) { const int row = grp * 16 + rw; const bf16_t* xr = X + (size_t)row * D + 8 * kg; bf16_t* hr = H + (size_t)row * D + 8 * kg; unsigned char* h8r = a.ws + WS_H8 + (size_t)row * D + 8 * kg;
        f32x4 acc[3];
#pragma unroll
        for (int nb = 0; nb < 3; ++nb) acc[nb] = (f32x4){0.f, 0.f, 0.f, 0.f};
        float ss = 0.f;
#pragma unroll 8
        for (int k0 = 0; k0 < D; k0 += 32) { const u32x4 xr4 = *(const u32x4*)(xr + k0); const f32x4 x0 = (f32x4){bf_lo(xr4.x), bf_hi(xr4.x), bf_lo(xr4.y), bf_hi(xr4.y)}, x1 = (f32x4){bf_lo(xr4.z), bf_hi(xr4.z), bf_lo(xr4.w), bf_hi(xr4.w)}; const f32x4 g0 = *(const f32x4*)(gain + k0 + 8 * kg), g1 = *(const f32x4*)(gain + k0 + 8 * kg + 4);
            ss += (x0[0] * x0[0] + x0[1] * x0[1]) + (x0[2] * x0[2] + x0[3] * x0[3]) + (x1[0] * x1[0] + x1[1] * x1[1]) + (x1[2] * x1[2] + x1[3] * x1[3]);
            u32x4 pk; pk.x = cvt_pk_bf16(x0[0] * g0[0], x0[1] * g0[1]); pk.y = cvt_pk_bf16(x0[2] * g0[2], x0[3] * g0[3]); pk.z = cvt_pk_bf16(x1[0] * g1[0], x1[1] * g1[1]); pk.w = cvt_pk_bf16(x1[2] * g1[2], x1[3] * g1[3]);
            if (MK_MOE8 && l >= 0) { int p0 = __builtin_amdgcn_cvt_pk_fp8_f32(x0[0] * g0[0], x0[1] * g0[1], 0, false); p0 = __builtin_amdgcn_cvt_pk_fp8_f32(x0[2] * g0[2], x0[3] * g0[3], p0, true);
                int p1 = __builtin_amdgcn_cvt_pk_fp8_f32(x1[0] * g1[0], x1[1] * g1[1], 0, false); p1 = __builtin_amdgcn_cvt_pk_fp8_f32(x1[2] * g1[2], x1[3] * g1[3], p1, true);
                *(u32x2*)(h8r + k0) = (u32x2){(unsigned)p0, (unsigned)p1}; }
            else *(u32x4*)(hr + k0) = pk;
            const bf16x8 af = __builtin_bit_cast(bf16x8, pk);
#pragma unroll
            for (int nb = 0; nb < 3; ++nb) { const bf16x8 bfr = *(const bf16x8*)(WR + (size_t)(16 * nb + rw) * D + k0 + 8 * kg); acc[nb] = __builtin_amdgcn_mfma_f32_16x16x32_bf16(af, bfr, acc[nb], 0, 0, 0); } }
        ss += __shfl_xor(ss, 16); ss += __shfl_xor(ss, 32);
        const float rstd = 1.0f / sqrtf(ss * (1.0f / D) + EPS);
#pragma unroll
        for (int nb = 0; nb < 3; ++nb)
#pragma unroll
            for (int rg = 0; rg < 4; ++rg) lg[(4 * kg + rg) * 48 + 16 * nb + rw] = acc[nb][rg];
        LDS_WAIT();
        if (lane < 16) { const LAS float* lr = lg + lane * 48;
            float gl[4]; int gi = 0; float gmx = -1e30f;
#pragma unroll
            for (int i = 0; i < 4; ++i) { gl[i] = lr[i] * rstd + brg[i]; if (gl[i] > gmx) { gmx = gl[i]; gi = i; } }
            float gs = 0.f;
#pragma unroll
            for (int i = 0; i < 4; ++i) gs += __expf(gl[i] - gmx);
            const float gp = 1.0f / gs;
            float v1 = -1e30f, v2 = -1e30f; int i1 = 0, i2 = 0;
            for (int i = 0; i < 8; ++i) { const float v = lr[4 + 8 * gi + i] * rstd + bre[8 * gi + i];
                if (v > v1) { v2 = v1; i2 = i1; v1 = v; i1 = i; } else if (v > v2) { v2 = v; i2 = i; } }
            const float ex = __expf(v2 - v1); const float w1 = gp / (1.0f + ex), w2 = gp * ex / (1.0f + ex);
            const int e1 = gi * 8 + i1, e2 = gi * 8 + i2;
            if (!(a.mix_mask & 16)) {
            const unsigned p1 = atomicAdd(cnt + e1, 1u), p2 = atomicAdd(cnt + e2, 1u);
            list[(size_t)e1 * T + p1] = (u32x4){(unsigned)row, __float_as_uint(w1), __float_as_uint(rstd), 0u};
            list[(size_t)e2 * T + p2] = (u32x4){(unsigned)row | 0x10000u, __float_as_uint(w2), __float_as_uint(rstd), 0u}; }
            route[row] = (u32x4){(unsigned)e1, (unsigned)e2, __float_as_uint(w1), __float_as_uint(w2)};
        }
        LDS_WAIT();
    }
}
__device__ __forceinline__ void moe_tables(const Args& a, int l, LAS unsigned char* lds) {
    LAS int* tab = (LAS int*)(lds + gm::TAB_OFF); const unsigned* cnt = (const unsigned*)(a.ws + WS_CTL) + CW_CNT + l * 32;
    if (threadIdx.x == 0) { int off = 0; for (int e = 0; e < 32; ++e) { const int c = (int)__hip_atomic_load(cnt + e, __ATOMIC_RELAXED, __HIP_MEMORY_SCOPE_AGENT); tab[e] = off; tab[40 + e] = c; off += (c + 255) >> 8; } tab[32] = off; }
    __syncthreads();
}
__device__ __forceinline__ void phase_final(const Args& a) { phase_norm(nullptr, (const bf16_t*)(a.ws + WS_XB), (const bf16_t*)(a.ws + WS_Y0), (const bf16_t*)(a.ws + WS_Y1), nullptr, a.out, nullptr, nullptr, nullptr, MK_Y8 && !MK_DEBUG); }

constexpr int PH_PER_LAYER = 10, N_PHASES = 2 + 2 * PH_PER_LAYER;
template <int l> __device__ __forceinline__ void layer_phases(const Args& a, LAS unsigned char* lds, const int lo, const int hi, const XcdBarrier& bar) {
#define IN(k) (lo <= (k) && (k) < hi)
#define SEAM(k) do { if (IN(k) && IN((k) + 1)) xcd_barrier(bar); } while (0)
    {
        const int pb = 1 + l * PH_PER_LAYER;
        unsigned char* wb = a.ws + WS_W + (size_t)l * W_LAYER;
        bf16_t* H = (bf16_t*)(a.ws + WS_H); bf16_t* Z = (bf16_t*)(a.ws + WS_Z); bf16_t* Y = (bf16_t*)(a.ws + WS_Y);
        if (IN(pb + 0)) {
            if (l == 0) phase_norm(a.in[I_X], nullptr, nullptr, nullptr, nullptr, nullptr, a.in[I_NORM_MIX], H, (unsigned*)(a.ws + WS_H8));
            else phase_norm(nullptr, (const bf16_t*)(a.ws + WS_XB), (const bf16_t*)(a.ws + WS_Y0), (const bf16_t*)(a.ws + WS_Y1), (bf16_t*)(a.ws + WS_XB), nullptr, a.in[I_NORM_MIX] + D, ((MK_Z8 >> 1) & 1) && !MK_DEBUG ? nullptr : H, (unsigned*)(a.ws + WS_H8));
        }
        SEAM(pb + 0);
        if (IN(pb + 1)) {
            gm::Desc g{H, wb + W_IN, 2 * D, 2 * D, 2 * D}; if ((MK_Z8 >> l) & 1) g = gm::Desc{a.ws + WS_H8, wb + W_IN, D, D, D, 121, 127}; gm::StaticOrder S; S.init(T, WIN, gridDim.x, blockIdx.x);
            gm::EpiZ E{Z, a.in[I_QN_C] + l * 128, a.in[I_KN_C] + l * 128, a.in[I_QN_D] + l * 64, a.in[I_KN_D] + l * 64,
                       (const float*)(a.ws + WS_COSC), (const float*)(a.ws + WS_SINC), (const float*)(a.ws + WS_COSD), (const float*)(a.ws + WS_SIND)};
            if constexpr ((MK_Z8 >> l) & 1) gm::gemm_phase<true>(lds, g, S, E); else gm::gemm_phase(lds, g, S, E);
        }
        SEAM(pb + 1);
        if (IN(pb + 2)) {
            const int vbx = (gridDim.x == 256) ? (int)((blockIdx.x & 7) * 32 + (blockIdx.x >> 3)) : (int)blockIdx.x;
            if (a.mix_mask & 1) for (int u = vbx; u < 256; u += gridDim.x) mixer_d_unit(a, l, u, lds);
            if (a.mix_mask & 2) for (int u = vbx; u < 1536; u += gridDim.x) mixer_c_unit(a, u, lds);
            if (a.mix_mask & 4) for (int u = blockIdx.x; u < T / 128; u += gridDim.x) mixer_a_unit(a, l, u, lds);
            if (a.mix_mask & 8) mixer_b(a, l);
        }
        SEAM(pb + 2);
        if (IN(pb + 3)) mixer_c_merge(a);
        SEAM(pb + 3);
        if (IN(pb + 4)) {
            gm::Desc g{Y, wb + W_B, 2 * D, 1024, 1024}; gm::BranchOrder S; S.init(T, 8192, gridDim.x, blockIdx.x);
            gm::EpiBf16 E{Z, 8192};
            gm::gemm_phase(lds, g, S, E);
        }
        SEAM(pb + 4);
        if (IN(pb + 5)) {
            gm::Desc g{a.ws + WS_H8, wb + W_G, D, D, D};     gm::StaticOrder S; S.init(T, 8192, gridDim.x, blockIdx.x);
            gm::EpiGateT<((MK_WO8 >> l) & 1) && !MK_DEBUG> E{Y, Z, a.in[I_B_GATE] + (size_t)l * 4 * D};
            gm::gemm_phase<true>(lds, g, S, E);
        }
        SEAM(pb + 5);
        if (IN(pb + 6)) {
            gm::Desc g{Y, wb + W_O, 2 * D, 2 * D, 2 * D}; if (((MK_WO8 >> l) & 1) && !MK_DEBUG) g = gm::Desc{Y, wb + W_O, D, D, D, 121, 127}; gm::StaticOrder S; S.init(T, D, gridDim.x, blockIdx.x);
            gm::EpiResid E{l == 0 ? a.in[I_X] : nullptr, (bf16_t*)(a.ws + WS_XB)};
            if constexpr (((MK_WO8 >> l) & 1) && !MK_DEBUG) gm::gemm_phase<true>(lds, g, S, E); else gm::gemm_phase(lds, g, S, E);
        }
        SEAM(pb + 6);
        if (IN(pb + 7)) phase_route(a, l, lds);
        SEAM(pb + 7);
        if (IN(pb + 8)) {
            moe_tables(a, l, lds);
            gm::Desc g{H, wb + W_UP, 2 * D, 2 * D, 2 * D}; if (MK_MOE8 && l >= 0) g = gm::Desc{a.ws + WS_H8, wb + W_UP, D, D, D, 121, 127}; gm::MoeUpOrder S; S.nN = 4; S.G = gridDim.x; S.c = blockIdx.x; S.tab = (LAS const int*)(lds + gm::TAB_OFF); S.list = (const u32x4*)(a.ws + WS_LIST); S.nexp_rows = 1024;
            if constexpr (MK_MOE8 && l >= 0) { gm::EpiUpT<true> E{a.ws + WS_HID, (const u32x4*)(a.ws + WS_LIST)}; gm::gemm_phase<true>(lds, g, S, E); }
            else { gm::EpiUpT<false> E{a.ws + WS_HID, (const u32x4*)(a.ws + WS_LIST)}; gm::gemm_phase(lds, g, S, E); }
        }
        SEAM(pb + 8);
        if (IN(pb + 9)) {
            moe_tables(a, l, lds);
            gm::Desc g{a.ws + WS_HID, wb + W_DN, 1024, 1024, 1024}; if (MK_MOE8 && l >= 0) g = gm::Desc{a.ws + WS_HID, wb + W_DN, 512, 512, 512, 121, 123}; gm::MoeDownOrder S; S.nN = 8; S.G = gridDim.x; S.c = blockIdx.x; S.tab = (LAS const int*)(lds + gm::TAB_OFF); S.list = (const u32x4*)(a.ws + WS_LIST); S.nexp_rows = 2048;
            gm::EpiDownT<(MK_Y8 && l == 1 && !MK_DEBUG)> E{a.ws + WS_Y0, a.ws + WS_Y1, (const u32x4*)(a.ws + WS_LIST)};
            if constexpr (MK_MOE8 && l >= 0) gm::gemm_phase<true>(lds, g, S, E); else gm::gemm_phase(lds, g, S, E);
        }
        SEAM(pb + 9);
    }
#undef SEAM
#undef IN
}
constexpr int MISC_OFF = 143360;
__global__ void __launch_bounds__(NTHR, 2) mk_fwd(Args a) {
    extern __shared__ __attribute__((aligned(16))) unsigned char lds_raw[];
    LAS unsigned char* lds = (LAS unsigned char*)lds_raw;
    const int lo = a.ph_lo, hi = a.ph_hi;
    volatile LAS unsigned* misc = (volatile LAS unsigned*)(lds + MISC_OFF);
    if (threadIdx.x < 4) misc[threadIdx.x] = 0u;
    __syncthreads();
    XcdBarrier bar; bar.bar = (unsigned*)(a.ws + WS_CTL) + CW_BAR; bar.x = 0; bar.st = misc;
    if (hi - lo > 1) bar = xcd_barrier_post((unsigned*)(a.ws + WS_CTL) + CW_BAR, misc);
    if (lo <= 0 && 0 < hi) phase_prologue(a, lds);
    layer_phases<0>(a, lds, lo, hi, bar);
    layer_phases<1>(a, lds, lo, hi, bar);
    if (lo <= N_PHASES - 1 && N_PHASES - 1 < hi) phase_final(a);
#if MK_XPROBE
    if (lo <= 50 && 50 < hi) {
        unsigned char* wb = a.ws + WS_W;
        gm::Desc g{a.ws + WS_H, wb + MK_XPROBE_W, 2 * D, 2 * MK_XPROBE_K, 2 * MK_XPROBE_K}; gm::StaticOrder S; S.init(T, MK_XPROBE_N, gridDim.x, blockIdx.x);
        gm::EpiProbe E{(float*)(a.ws + WS_CO)};
        gm::gemm_phase(lds, g, S, E);
    }
#endif
}

#if MK_DEBUG
__device__ __forceinline__ void diag_put(unsigned char* ws, int stage, float err, float ref, float rel, float absf) {
    float ratio = fabsf(err) / (rel * fabsf(ref) + absf); if (!(ratio == ratio) || !(fabsf(err) < 1e30f)) ratio = 1e9f;
    atomicMax((unsigned*)(ws + WS_CTL) + CW_DIAG + stage, __float_as_uint(ratio));
}
__device__ __forceinline__ unsigned hash_u(unsigned x) { x ^= x >> 16; x *= 0x7feb352du; x ^= x >> 15; x *= 0x846ca68bu; x ^= x >> 16; return x; }
__global__ void ck_h(Args a, int l, int stage) {
    const int row = hash_u(blockIdx.x * 7 + 1) % T; const float* g = a.in[I_NORM_MIX] + l * D; const bf16_t* h = (const bf16_t*)(a.ws + WS_H) + (size_t)row * D;
#define CKX(c) (l == 0 ? a.in[I_X][(size_t)row * D + (c)] : bf2f(((const bf16_t*)(a.ws + WS_XB))[(size_t)row * D + (c)]))
    float ss = 0.f; for (int c = threadIdx.x; c < D; c += 64) ss += CKX(c) * CKX(c); ss = wave_sum(ss); const float rstd = 1.0f / sqrtf(ss / D + EPS);
    for (int c = threadIdx.x; c < D; c += 64) { const float ref = CKX(c) * rstd * g[c]; diag_put(a.ws, stage, bf2f(h[c]) - ref, ref, 0.01f, 0.01f); }
#undef CKX
}
__device__ float dot_hw(const bf16_t* hrow, const float* W, size_t ld, int K) { float s = 0.f; for (int k = 0; k < K; ++k) s += bf2f(hrow[k]) * W[(size_t)k * ld]; return s; }
__global__ void ck_z_ident(Args a, int l, int stage) {
    const unsigned hsh = hash_u(blockIdx.x * 64 + threadIdx.x + 77); const int row = hsh % T; int col; { const unsigned q = hash_u(hsh + 5) % 4096; col = q < 2560 ? q : (q < 3328 ? ZC + 3072 + (q - 2560) * 2 : ZD + 1024 + (q - 3328) % 512); }
    const bf16_t* h = (const bf16_t*)(a.ws + WS_H) + (size_t)row * D; float ref = dot_hw(h, a.in[I_W_IN] + (size_t)l * D * WIN + col, WIN, D);
    if (col < 1024) { const float u = 0.7978845608028654f * (ref + 0.044715f * ref * ref * ref); ref = 0.5f * ref * (1.0f + tanhf(u)); }
    diag_put(a.ws, stage, bf2f(((const bf16_t*)(a.ws + WS_Z))[(size_t)row * WIN + col]) - ref, ref, 0.02f, 0.02f);
}
__global__ void ck_z_qk(Args a, int l, int stage, int isD) {
    __shared__ float v[128]; __shared__ float ssum;
    const unsigned hsh = hash_u(blockIdx.x + 1234 + isD * 999); const int row = hsh % T; const int nd = isD ? 64 : 128; const int grp = hash_u(hsh + 3) % (isD ? 16 : 24);
    const int d = threadIdx.x; const int colbase = isD ? ZD + grp * 64 : ZC + grp * 128;
    const bf16_t* h = (const bf16_t*)(a.ws + WS_H) + (size_t)row * D;
    if (d < nd) v[d] = dot_hw(h, a.in[I_W_IN] + (size_t)l * D * WIN + colbase + d, WIN, D);
    __syncthreads();
    if (d == 0) { float s = 0.f; for (int i = 0; i < nd; ++i) s += v[i] * v[i]; ssum = s; }
    __syncthreads();
    if (d < nd) { const float rstd = 1.0f / sqrtf(ssum / nd + EPS); const float* gn = isD ? ((grp >= 8 ? a.in[I_KN_D] : a.in[I_QN_D]) + l * 64) : ((grp >= 12 ? a.in[I_KN_C] : a.in[I_QN_C]) + l * 128);
        const int half = nd / 2, i = d % half; const float inv = powf(10000.0f, -(float)i / (float)half); const float ang = (float)(row % SEQ) * inv; const float cs = cosf(ang), sn = sinf(ang);
        const float x1 = v[i] * rstd * gn[i], x2 = v[i + half] * rstd * gn[i + half]; const float ref = (d < half) ? (x1 * cs - x2 * sn) : (x2 * cs + x1 * sn);
        diag_put(a.ws, stage, bf2f(((const bf16_t*)(a.ws + WS_Z))[(size_t)row * WIN + colbase + d]) - ref, ref, 0.02f, 0.03f); }
}
__global__ void ck_ya(Args a, int l, int stage) {
    __shared__ float rstd[128];
    const unsigned hsh = hash_u(blockIdx.x + 4321); const int chunk = hsh % (T / 128), i = (blockIdx.x < 4) ? (blockIdx.x * 42 + 1) % 128 : hash_u(hsh + 1) % 128, g = hash_u(hsh + 2) % 4; const int c = threadIdx.x; const int t0 = chunk * 128;
    const bf16_t* Z = (const bf16_t*)(a.ws + WS_Z);
    { float s = 0.f; const bf16_t* vr = Z + (size_t)(t0 + c) * WIN + 512; for (int k = 0; k < 512; ++k) s += bf2f(vr[k]) * bf2f(vr[k]); rstd[c] = 1.0f / sqrtf(s / 512.f + EPS); }
    __syncthreads();
    const float gn = a.in[I_SG_NORM][l * 512 + g * 128 + c]; const float* W = a.in[I_SG_W] + ((size_t)(l * 4 + g) * 128 + i) * 128; float mix = 0.f;
    for (int j = 0; j <= i; ++j) mix += W[j] * bf2f(Z[(size_t)(t0 + j) * WIN + 512 + g * 128 + c]) * rstd[j] * gn;
    mix += a.in[I_SG_B][(l * 4 + g) * 128 + i];
    const float ref = bf2f(Z[(size_t)(t0 + i) * WIN + g * 128 + c]) * mix;
    diag_put(a.ws, stage, bf2f(((const bf16_t*)(a.ws + WS_Y))[(size_t)(t0 + i) * D + g * 128 + c]) - ref, ref, 0.03f, 0.03f);
}
__global__ void ck_yb(Args a, int l, int stage) {
    const unsigned hsh = hash_u(blockIdx.x * 64 + threadIdx.x + 99); int t = hsh % T; if (threadIdx.x < 4) t = (t & ~(SEQ - 1)) + threadIdx.x; const int c = hash_u(hsh + 1) % 512, s = t % SEQ; const bf16_t* Z = (const bf16_t*)(a.ws + WS_Z);
    float acc = 0.f; for (int w = 0; w < 3; ++w) { const int back = 2 - w; if (s - back < 0) continue; const bf16_t* zr = Z + (size_t)(t - back) * WIN + ZB; acc += a.in[I_CONV_W][l * 1536 + w * 512 + c] * bf2f(zr[512 + c]) * bf2f(zr[1024 + c]); }
    const float ref = bf2f(Z[(size_t)t * WIN + ZB + c]) * acc;
    diag_put(a.ws, stage, bf2f(((const bf16_t*)(a.ws + WS_Y))[(size_t)t * D + 512 + c]) - ref, ref, 0.02f, 0.02f);
}
__global__ void ck_yc(Args a, int l, int stage) {
    __shared__ float sc[132]; __shared__ float red[2]; __shared__ float og[3][128]; __shared__ float lse[3];
    const unsigned hsh = hash_u(blockIdx.x + 555); int t = hsh % T; if (blockIdx.x < 6) t = (t & ~(SEQ - 1)) + blockIdx.x * 37; const int j = hash_u(hsh + 1) % 4; const int s = t % SEQ, d = threadIdx.x; const bf16_t* Z = (const bf16_t*)(a.ws + WS_Z);
    for (int g = 0; g < 3; ++g) { const int dil = g == 0 ? 1 : (g == 1 ? 4 : 16);
        const bf16_t* q = Z + (size_t)t * WIN + ZC + ((0 * 3 + g) * 4 + j) * 128;
        for (int kk = d; kk < 129; kk += 128) { const int sk = s - kk * dil; float v = -1e30f; if (sk >= 0) { const bf16_t* kp = Z + (size_t)(t - kk * dil) * WIN + ZC + ((1 * 3 + g) * 4 + j) * 128; float dd = 0.f; for (int e = 0; e < 128; ++e) dd += bf2f(q[e]) * bf2f(kp[e]); v = dd * 0.08838834764831845f; } sc[kk] = v; }
        __syncthreads();
        if (d == 0) { float mx = -1e30f; for (int kk = 0; kk < 129; ++kk) mx = fmaxf(mx, sc[kk]); float sm = 0.f; for (int kk = 0; kk < 129; ++kk) sm += (sc[kk] > -1e29f) ? expf(sc[kk] - mx) : 0.f; red[0] = mx; red[1] = sm; lse[g] = mx + logf(sm); }
        __syncthreads();
        float o = 0.f; for (int kk = 0; kk < 129; ++kk) { if (sc[kk] > -1e29f) o += expf(sc[kk] - red[0]) / red[1] * bf2f(Z[(size_t)(t - kk * dil) * WIN + ZC + ((2 * 3 + g) * 4 + j) * 128 + d]); }
        og[g][d] = o; __syncthreads(); }
    const float mx = fmaxf(lse[0], fmaxf(lse[1], lse[2])); const float e0 = expf(lse[0] - mx), e1 = expf(lse[1] - mx), e2 = expf(lse[2] - mx); const float ref = (e0 * og[0][d] + e1 * og[1][d] + e2 * og[2][d]) / (e0 + e1 + e2);
    diag_put(a.ws, stage, bf2f(((const bf16_t*)(a.ws + WS_Y))[(size_t)t * D + 1024 + j * 128 + d]) - ref, ref, 0.03f, 0.02f);
}
__global__ void ck_yd(Args a, int l, int stage) {
    __shared__ float sc[SEQ]; __shared__ float red[256]; __shared__ float o1s[128];
    const unsigned hsh = hash_u(blockIdx.x + 888); const int b = hsh % NB, h = hash_u(hsh + 1) % 4; int s = hash_u(hsh + 2) % SEQ; if (blockIdx.x < 8) { const int sp[8] = {0, 1, 31, 255, 256, 2047, 2048, 4095}; s = sp[blockIdx.x]; }
    const int d = threadIdx.x, t = b * SEQ + s; const bf16_t* Z = (const bf16_t*)(a.ws + WS_Z);
    const float lam_init = (l == 0) ? 0.2f : 0.35550906759096926f; float s1 = 0.f, s2 = 0.f; for (int i = 0; i < 64; ++i) { s1 += a.in[I_LQ1][l * 64 + i] * a.in[I_LK1][l * 64 + i]; s2 += a.in[I_LQ2][l * 64 + i] * a.in[I_LK2][l * 64 + i]; }
    const float lam = expf(s1) - expf(s2) + lam_init; float outv = 0.f;
    for (int map = 0; map < 2; ++map) { const bf16_t* q = Z + (size_t)t * WIN + ZD + (h * 2 + map) * 64;
        for (int k = d; k <= s; k += 128) { const bf16_t* kp = Z + (size_t)(b * SEQ + k) * WIN + ZD + 512 + (h * 2 + map) * 64; float dd = 0.f; for (int e = 0; e < 64; ++e) dd += bf2f(q[e]) * bf2f(kp[e]); sc[k] = dd * 0.125f; }
        __syncthreads();
        float mx = -1e30f; for (int k = d; k <= s; k += 128) mx = fmaxf(mx, sc[k]); red[d] = mx; __syncthreads(); if (d == 0) { float m = -1e30f; for (int i = 0; i < 128; ++i) m = fmaxf(m, red[i]); red[128] = m; } __syncthreads(); mx = red[128];
        float sm = 0.f; for (int k = d; k <= s; k += 128) sm += expf(sc[k] - mx); __syncthreads(); red[d] = sm; __syncthreads(); if (d == 0) { float m = 0.f; for (int i = 0; i < 128; ++i) m += red[i]; red[129] = m; } __syncthreads(); sm = red[129];
        float o = 0.f; for (int k = 0; k <= s; ++k) o += expf(sc[k] - mx) / sm * bf2f(Z[(size_t)(b * SEQ + k) * WIN + ZD + 1024 + h * 128 + d]);
        if (map == 0) outv = o; else outv -= lam * o; __syncthreads(); }
    o1s[d] = outv * outv; __syncthreads(); if (d == 0) { float m = 0.f; for (int i = 0; i < 128; ++i) m += o1s[i]; red[130] = m; } __syncthreads();
    const float ref = outv / sqrtf(red[130] / 128.f + EPS) * a.in[I_SUBLN][l * 128 + d] * (1.0f - lam_init);
    diag_put(a.ws, stage, bf2f(((const bf16_t*)(a.ws + WS_Y))[(size_t)t * D + 1536 + h * 128 + d]) - ref, ref, 0.04f, 0.04f);
}
__global__ void ck_p(Args a, int l, int stage) {
    const unsigned hsh = hash_u(blockIdx.x * 64 + threadIdx.x + 31337); const int t = hsh % T, k = hash_u(hsh + 1) % 4, c = hash_u(hsh + 2) % D; const bf16_t* y = (const bf16_t*)(a.ws + WS_Y) + (size_t)t * D + 512 * k;
    const float ref = dot_hw(y, a.in[I_W_BRANCH] + ((size_t)(l * 4 + k) * 512) * D + c, D, 512);
    diag_put(a.ws, stage, bf2f(((const bf16_t*)(a.ws + WS_Z))[(size_t)t * 8192 + k * D + c]) - ref, ref, 0.02f, 0.02f);
}
__global__ void ck_merged(Args a, int l, int stage) {
    const unsigned hsh = hash_u(blockIdx.x * 64 + threadIdx.x + 4242); const int t = hsh % T, c = hash_u(hsh + 2) % D; const bf16_t* h = (const bf16_t*)(a.ws + WS_H) + (size_t)t * D; float ref = 0.f;
    for (int k = 0; k < 4; ++k) { const float gl = dot_hw(h, a.in[I_W_GATE] + ((size_t)(l * 4 + k) * D) * D + c, D, D) + a.in[I_B_GATE][(l * 4 + k) * D + c]; ref += 1.0f / (1.0f + expf(-gl)) * bf2f(((const bf16_t*)(a.ws + WS_Z))[(size_t)t * 8192 + k * D + c]); }
    diag_put(a.ws, stage, bf2f(((const bf16_t*)(a.ws + WS_Y))[(size_t)t * D + c]) - ref, ref, 0.05f, 0.12f);
}
__global__ void ck_x1(Args a, int l, int stage) {
    const unsigned hsh = hash_u(blockIdx.x * 64 + threadIdx.x + 777); const int t = hsh % T, c = hash_u(hsh + 2) % D; const bf16_t* mg = (const bf16_t*)(a.ws + WS_Y) + (size_t)t * D;
    const float ref = a.in[I_X][(size_t)t * D + c] + dot_hw(mg, a.in[I_W_OUT] + (size_t)l * D * D + c, D, D);
    diag_put(a.ws, stage, bf2f(((const bf16_t*)(a.ws + WS_XB))[(size_t)t * D + c]) - ref, ref, 0.01f, 0.02f);
}
__global__ void ck_route(Args a, int l, int stage) {
    __shared__ float lg[36];
    const int t = hash_u(blockIdx.x + 9091) % T, lane = threadIdx.x; const bf16_t* xb_ = (const bf16_t*)(a.ws + WS_XB) + (size_t)t * D; const float* g = a.in[I_NORM_FFN] + l * D;
#define x(c) bf2f(xb_[c])
    float ss = 0.f; for (int c = lane; c < D; c += 64) ss += x(c) * x(c); ss = wave_sum(ss); const float rstd = 1.0f / sqrtf(ss / D + EPS);
    const bf16_t* h2 = (const bf16_t*)(a.ws + WS_H) + (size_t)t * D;
    if (!(MK_MOE8 && l >= 0)) for (int c = lane; c < D; c += 64) { const float ref = x(c) * g[c]; diag_put(a.ws, stage, bf2f(h2[c]) - ref, ref, 0.01f, 0.01f); }
    for (int n = 0; n < 36; ++n) { float s = 0.f; for (int c = lane; c < D; c += 64) { const float hv = x(c) * rstd * g[c]; s += hv * (n < 4 ? a.in[I_W_RG][(size_t)l * D * 4 + c * 4 + n] : a.in[I_W_RE][(size_t)l * D * 32 + c * 32 + (n - 4)]); } s = wave_sum(s); if (lane == 0) lg[n] = s + (n < 4 ? a.in[I_B_RG][l * 4 + n] : a.in[I_B_RE][l * 32 + n - 4]); }
    __syncthreads();
    if (lane == 0) { int gi = 0; for (int i = 1; i < 4; ++i) if (lg[i] > lg[gi]) gi = i; float gs = 0.f; for (int i = 0; i < 4; ++i) gs += expf(lg[i] - lg[gi]); const float gp = 1.0f / gs;
        int i1 = 0; for (int i = 1; i < 8; ++i) if (lg[4 + 8 * gi + i] > lg[4 + 8 * gi + i1]) i1 = i; int i2 = (i1 == 0) ? 1 : 0; for (int i = 0; i < 8; ++i) if (i != i1 && lg[4 + 8 * gi + i] > lg[4 + 8 * gi + i2]) i2 = i;
        const float v1 = lg[4 + 8 * gi + i1], v2 = lg[4 + 8 * gi + i2]; const float ex = expf(v2 - v1); const float w1 = gp / (1.f + ex), w2 = gp * ex / (1.f + ex);
        const u32x4 r = ((const u32x4*)(a.ws + WS_ROUTE))[t]; const int e1 = gi * 8 + i1, e2 = gi * 8 + i2;
        if ((int)r.x == e1 && (int)r.y == e2) { diag_put(a.ws, stage, __uint_as_float(r.z) - w1, w1, 0.03f, 0.003f); diag_put(a.ws, stage, __uint_as_float(r.w) - w2, w2, 0.03f, 0.003f); }
        else {
            float gap = 1e9f; const int me1 = (int)r.x, me2 = (int)r.y;
            if (me1 / 8 != gi) gap = lg[gi] - lg[me1 / 8]; else { const float a1 = lg[4 + me1], a2 = lg[4 + me2]; gap = fmaxf(fabsf(fminf(v1, v2) - fminf(a1, a2)), fabsf(fmaxf(v1, v2) - fmaxf(a1, a2))); }
            diag_put(a.ws, stage, gap, 0.f, 0.f, 0.02f); } }
}
#undef x
__global__ void ck_moe(Args a, int l, int stage) {
    __shared__ float hid[512]; __shared__ float hx[D];
    const unsigned hsh = hash_u(blockIdx.x + 6006); const int t = hsh % T, k = blockIdx.x & 1; const u32x4 r = ((const u32x4*)(a.ws + WS_ROUTE))[t]; const int e = k ? (int)r.y : (int)r.x; const float w = __uint_as_float(k ? r.w : r.z);
    const bf16_t* xb = (const bf16_t*)(a.ws + WS_XB) + (size_t)t * D; const float* g = a.in[I_NORM_FFN] + l * D; const float* Wu = a.in[I_W_UP] + ((size_t)(l * NEXP + e) * D) * 1024;
    for (int c = threadIdx.x; c < D; c += 256) hx[c] = bf2f(xb[c]) * g[c];
    __syncthreads();
    float rs_; { float s_ = 0.f; for (int c = 0; c < D; ++c) { const float xv = bf2f(xb[c]); s_ += xv * xv; } rs_ = 1.0f / sqrtf(s_ / D + EPS); }
    for (int j = threadIdx.x; j < 512; j += 256) { float av = 0.f, cv = 0.f; for (int c = 0; c < D; ++c) { av += hx[c] * Wu[(size_t)c * 1024 + j]; cv += hx[c] * Wu[(size_t)c * 1024 + 512 + j]; } av *= rs_; cv *= rs_; hid[j] = av / (1.0f + expf(-av)) * cv; }
    __syncthreads();
    const int c = (threadIdx.x * 8 + 3) % D; const float* Wd = a.in[I_W_DOWN] + ((size_t)(l * NEXP + e) * 512) * D + c; float s = 0.f; for (int j = 0; j < 512; ++j) s += hid[j] * Wd[(size_t)j * D];
    const float ref = w * s; const bf16_t* ys = (const bf16_t*)(a.ws + (k ? WS_Y1 : WS_Y0));
    if (MK_MOE8 && l >= 0) diag_put(a.ws, stage, bf2f(ys[(size_t)t * D + c]) - ref, ref, 0.10f, 0.15f); else diag_put(a.ws, stage, bf2f(ys[(size_t)t * D + c]) - ref, ref, 0.03f, 0.02f);
}
__global__ void ck_report(Args a) {
    const float* dg = (const float*)(a.ws + WS_CTL) + CW_DIAG; int bad = 0; for (int s = 1; s < 64; ++s) if (dg[s] > 1.0f) { bad = s; break; }
    if (!bad) return;
    const float v = powf(10.0f, 2.0f + 0.5f * (float)bad) * (dg[bad] > 30.f ? 2.0f : 1.0f);
    for (size_t i = (size_t)blockIdx.x * blockDim.x + threadIdx.x; i < (size_t)T * D; i += (size_t)gridDim.x * blockDim.x) a.out[i] = v;
}
#endif

extern "C" void kernel_launch(void* const* d_in, const int* in_sizes, int n_in, void* d_out, int out_size, void* d_ws, size_t ws_size, hipStream_t stream) {
    static int grid = 0;
    if (grid == 0) {
        if (n_in != 27 || out_size != T * D || ws_size < WS_END) { fprintf(stderr, "kernel_launch: unexpected shapes (n_in %d out %d ws %zu)\n", n_in, out_size, ws_size); grid = -1; return; }
        (void)hipFuncSetAttribute((const void*)mk_fwd, hipFuncAttributeMaxDynamicSharedMemorySize, LDS_BYTES);
        int dev = 0, cus = 0; (void)hipGetDevice(&dev); (void)hipDeviceGetAttribute(&cus, hipDeviceAttributeMultiprocessorCount, dev);
        grid = cus > 0 ? cus : 256;
    }
    if (grid < 0) return;
    (void)hipMemsetAsync((char*)d_ws + WS_CTL, 0, CTL_BYTES, stream);
    Args a{};
    for (int i = 0; i < 27; ++i) a.in[i] = (const float*)d_in[i];
    a.out = (float*)d_out; a.ws = (unsigned char*)d_ws; a.mix_mask = 15;
#if MK_DEBUG
#define CK(kern, nblk, nthr, ...) hipLaunchKernelGGL(kern, dim3(nblk), dim3(nthr), 0, stream, a, __VA_ARGS__)
#endif
#if MK_FUSED && !MK_DEBUG
    if (MK_PROBE_LO < 0) {
        a.ph_lo = 0; a.ph_hi = N_PHASES;
        hipLaunchKernelGGL(mk_fwd, dim3(grid), dim3(NTHR), LDS_BYTES, stream, a);
#if MK_XPROBE
        a.ph_lo = 50; a.ph_hi = 51; hipLaunchKernelGGL(mk_fwd, dim3(grid), dim3(NTHR), LDS_BYTES, stream, a);
#endif
    } else {
        const int cuts[4] = {0, MK_PROBE_HI, MK_PROBE_LO, N_PHASES};
        const int los[3] = {0, MK_PROBE_LO, MK_PROBE_HI}, his[3] = {MK_PROBE_HI, MK_PROBE_HI, N_PHASES}; (void)cuts;
        for (int i = 0; i < 3; ++i) { if (los[i] >= his[i]) continue;
            if (i) (void)hipMemsetAsync((char*)d_ws + WS_CTL + CW_BAR * 4, 0, XCD_BAR_WORDS * 4, stream);
            a.ph_lo = los[i]; a.ph_hi = his[i]; a.mix_mask = (i == 1) ? MK_PROBE_MIX : 15;
            hipLaunchKernelGGL(mk_fwd, dim3(grid), dim3(NTHR), LDS_BYTES, stream, a); }
    }
    return;
#endif
    for (int ph = 0; ph < N_PHASES; ++ph) {
        a.ph_lo = ph; a.ph_hi = ph + 1;
        hipLaunchKernelGGL(mk_fwd, dim3(grid), dim3(NTHR), LDS_BYTES, stream, a);
#if MK_DEBUG
        if (ph >= 1 && ph < N_PHASES - 1) { const int l = (ph - 1) / PH_PER_LAYER, p = (ph - 1) % PH_PER_LAYER, sb = l * 13;
            if (p == 0) CK(ck_h, 64, 64, l, sb + 1);
            if (p == 1) { CK(ck_z_ident, 16, 64, l, sb + 2); CK(ck_z_qk, 128, 128, l, sb + 3, 0); CK(ck_z_qk, 128, 128, l, sb + 4, 1); }
            if (p == 2) { CK(ck_ya, 64, 128, l, sb + 5); CK(ck_yb, 16, 64, l, sb + 6); CK(ck_yd, 40, 128, l, sb + 8); }
            if (p == 3) CK(ck_yc, 64, 128, l, sb + 7);
            if (p == 4) CK(ck_p, 16, 64, l, sb + 9);
            if (p == 5) CK(ck_merged, 8, 64, l, sb + 10);
            if (p == 6 && l == 0) CK(ck_x1, 16, 64, l, sb + 11);
            if (p == 7) CK(ck_route, 128, 64, l, sb + 12);
            if (p == 9) CK(ck_moe, 32, 256, l, sb + 13);
        }
#endif
    }
#if MK_DEBUG
    hipLaunchKernelGGL(ck_report, dim3(1024), dim3(256), 0, stream, a);
#endif
}
```

```cpp
#include <hip/hip_runtime.h>
#include <cstdio>
#include <cstdint>

#ifndef MK_XPROBE
#define MK_XPROBE 0
#define MK_XPROBE_W W_G
#define MK_XPROBE_K 2048
#define MK_XPROBE_N 8192
#endif
#ifndef MK_PROBE_MIX
#define MK_PROBE_MIX 15
#endif
#ifndef MK_PROBE_LO
#define MK_PROBE_LO -1
#define MK_PROBE_HI -1
#endif
#ifndef MK_MOE8
#define MK_MOE8 1
#endif
#ifndef MK_Z8
#define MK_Z8 2
#endif
#ifndef MK_WO8
#define MK_WO8 0
#endif
#ifndef MK_Y8
#define MK_Y8 1
#endif
#ifndef MK_FUSED
#define MK_FUSED 1
#endif
#ifndef MK_DEBUG
#define MK_DEBUG 0
#endif

#define LAS __attribute__((address_space(3)))
typedef unsigned short bf16_t;
typedef short bf16x8 __attribute__((ext_vector_type(8)));
typedef short s16x4 __attribute__((ext_vector_type(4)));
typedef float f32x4 __attribute__((ext_vector_type(4)));
typedef float f32x2 __attribute__((ext_vector_type(2)));
typedef float f32x16 __attribute__((ext_vector_type(16)));
typedef unsigned u32x4 __attribute__((ext_vector_type(4)));
typedef unsigned u32x2 __attribute__((ext_vector_type(2)));

constexpr int NB = 8, SEQ = 4096, T = NB * SEQ, D = 2048, WIN = 8704;
constexpr int ZA = 0, ZB = 1024, ZC = 2560, ZD = 7168;
constexpr int NEXP = 32;
constexpr float EPS = 1e-6f;
constexpr int NWAVES = 8, NTHR = 512;
constexpr int LDS_BYTES = 147456;

constexpr size_t MiB = 1u << 20;
constexpr size_t WS_CTL = 0, CTL_BYTES = 1 * MiB;
constexpr size_t WS_COSC = 1 * MiB, WS_SINC = 2 * MiB, WS_COSD = 3 * MiB, WS_SIND = 3 * MiB + 512 * 1024;
constexpr size_t WS_LIST = 8 * MiB;
constexpr size_t WS_ROUTE = 24 * MiB;
constexpr size_t WS_LSE = 25 * MiB;
constexpr size_t WS_W = 32 * MiB, W_LAYER = 276 * MiB;
constexpr size_t W_IN = 0, W_G = 34 * MiB, W_B = 66 * MiB, W_O = 74 * MiB, W_UP = 82 * MiB, W_DN = 210 * MiB, W_R = 274 * MiB;
constexpr size_t WS_H = 584 * MiB;
constexpr size_t WS_Z = 712 * MiB;
constexpr size_t WS_HID = WS_Z;
constexpr size_t WS_Y0 = WS_Z + 80 * MiB, WS_Y1 = WS_Z + 208 * MiB;
constexpr size_t WS_Y = 1256 * MiB;
constexpr size_t WS_CO = 1384 * MiB;
constexpr size_t WS_H8 = 1480 * MiB;
constexpr size_t WS_XB = 1544 * MiB;
constexpr size_t WS_END = 1672 * MiB;
constexpr int CW_CNT = 64;
constexpr int CW_DIAG = 256;
constexpr int CW_BAR = 4096;

__device__ __forceinline__ unsigned cvt_pk_bf16(float lo, float hi) { unsigned r; asm("v_cvt_pk_bf16_f32 %0, %1, %2" : "=v"(r) : "v"(lo), "v"(hi)); return r; }
__device__ __forceinline__ float bf_lo(unsigned w) { return __uint_as_float(w << 16); }
__device__ __forceinline__ float bf_hi(unsigned w) { return __uint_as_float(w & 0xffff0000u); }
__device__ __forceinline__ float bf2f(bf16_t b) { return __uint_as_float(((unsigned)b) << 16); }
__device__ __forceinline__ float fast_exp(float x) { return __builtin_amdgcn_exp2f(x * 1.4426950408889634f); }
__device__ __forceinline__ float sigmoidf_(float x) { return __builtin_amdgcn_rcpf(1.0f + fast_exp(-x)); }
__device__ __forceinline__ float gelu_tanh(float x) { const float u = 0.7978845608028654f * (x + 0.044715f * x * x * x); return x * sigmoidf_(2.0f * u); }
__device__ __forceinline__ float wave_sum(float v) {
#pragma unroll
    for (int o = 1; o < 64; o <<= 1) v += __shfl_xor(v, o);
    return v;
}
#define LDS_WAIT() asm volatile("s_waitcnt lgkmcnt(0)" ::: "memory")
#define VM_WAIT() asm volatile("s_waitcnt vmcnt(0)" ::: "memory")
__device__ __forceinline__ int opaque_tid() { int t = threadIdx.x; asm volatile("" : "+v"(t)); return t; }

namespace gm {
constexpr int BM = 256, BK = 64, HALF = 128, HTB = HALF * BK * 2, STAGE_BYTES = 8 * HTB;
constexpr int NXCD = 8, WGM = 8;
constexpr int XCH_OFF = STAGE_BYTES;
constexpr int TAB_OFF = STAGE_BYTES + 8192;
__host__ __device__ __forceinline__ int lds_byte(int r, int c) { const int st = (r >> 4) * 2 + (c >> 5), rr = r & 15, cc = c & 31, ob = rr * 64 + cc * 2; return st * 1024 + (ob ^ (((ob >> 9) & 1) << 5)); }
__host__ __device__ __forceinline__ void stage_rc(int b, int& R, int& C) { const int st = b / 1024, sb = b % 1024, swz = sb ^ (((sb >> 9) & 1) << 5); R = (st >> 1) * 16 + swz / 64; C = (st & 1) * 32 + (swz % 64) / 2; }
__host__ __device__ __forceinline__ int perm32(int rho) { const int n = rho >> 4, i = rho & 15; return 8 * (i >> 2) + 4 * n + (i & 3); }

struct Unit { int pm, pn, aux; };
typedef int v8i32 __attribute__((ext_vector_type(8)));
__device__ __forceinline__ void mfma8(f32x4& acc, v8i32 a, v8i32 b, int sa, int sb) {
    asm volatile("v_mfma_scale_f32_16x16x128_f8f6f4 %0, %1, %2, %0, %3, %4 op_sel_hi:[0,0,0]" : "+v"(acc) : "v"(a), "v"(b), "v"(sa), "v"(sb)); }
__device__ __forceinline__ v8i32 cat8(bf16x8 lo, bf16x8 hi) { const u32x4 a = __builtin_bit_cast(u32x4, lo), b = __builtin_bit_cast(u32x4, hi); return (v8i32){(int)a.x, (int)a.y, (int)a.z, (int)a.w, (int)b.x, (int)b.y, (int)b.z, (int)b.w}; }
struct Desc { const void* A; const void* Bt; int lda, ldb, K; int sw = 121, sa = 127; };

struct StaticOrder {
    static constexpr bool GATHER = false;
    int nM, nN, nwg, G, c, i0 = 0, iend = 1 << 30;
    __device__ void init(int M, int N, int G_, int c_) { nM = M / BM; nN = N / BM; nwg = nM * nN; G = G_; c = c_; }
    __device__ __forceinline__ bool next(int i, Unit& u) const {
        if (i + i0 >= iend) return false;
        const long L = (long)(i + i0) * G + c; if (L >= nwg) return false;
        int wgid = (int)L; { const int q = nwg / NXCD, r = nwg % NXCD, xcd = wgid % NXCD, off = wgid / NXCD; wgid = (xcd < r ? xcd * (q + 1) : r * (q + 1) + (xcd - r) * q) + off; }
        const int nig = WGM * nN, gid = wgid / nig, fm = gid * WGM, gsz = (nM - fm) < WGM ? (nM - fm) : WGM;
        u.pm = fm + ((wgid % nig) % gsz); u.pn = (wgid % nig) / gsz; u.aux = 0; return true;
    }
    __device__ __forceinline__ const char* a_base(const Desc& g, const Unit& u) const { return (const char*)g.A + (size_t)u.pm * BM * g.lda; }
    __device__ __forceinline__ const char* b_base(const Desc& g, const Unit& u) const { return (const char*)g.Bt + (size_t)u.pn * BM * g.ldb; }
    __device__ __forceinline__ void a_off(const Desc& g, const Unit&, const int (&R)[2], const int (&C)[2], unsigned (&v)[2][2]) const {
#pragma unroll
        for (int h = 0; h < 2; ++h)
#pragma unroll
            for (int i = 0; i < 2; ++i) v[h][i] = (unsigned)((R[i] + HALF * h) * g.lda + C[i] * 2);
    }
};
struct BranchOrder : StaticOrder {
    __device__ __forceinline__ const char* a_base(const Desc& g, const Unit& u) const { return (const char*)g.A + (size_t)u.pm * BM * g.lda + (size_t)(u.pn >> 3) * 512 * 2; }
};

template <bool FP8 = false, class Epi, class Sched>
__device__ __forceinline__ void gemm_phase(LAS unsigned char* lds, const Desc g, const Sched& S, const Epi& E) {
    const int tid = opaque_tid(), wid = __builtin_amdgcn_readfirstlane(tid >> 6), lane = tid & 63, wr = wid >> 2, wc = wid & 3, fr = lane & 15, fq = lane >> 4;
    const int nt = g.K / (BK * 2);
    int Rr[2], Cc[2]; unsigned voffB[2];
#pragma unroll
    for (int i = 0; i < 2; ++i) { int R, C; stage_rc(tid * 16 + i * 8192, R, C); Rr[i] = R; Cc[i] = C; const int Rb = (R & ~31) + perm32(R & 31); voffB[i] = (unsigned)(Rb * g.ldb + C * 2); }
    const size_t kstep = (size_t)(BK * 2);
    const size_t hstepB = (size_t)HALF * g.ldb;
    const unsigned ldsw = (unsigned)wid * 1024u;
    const int aoff = lds_byte(wr * 64 + fr, FP8 ? fq * 16 : fq * 8), boff = lds_byte(wc * 32 + fr, FP8 ? fq * 16 : fq * 8);
    constexpr int KSTR = FP8 ? 16 : 1024;
#define GM_SA(b, h) (((b) * 2 + (h)) * HTB)
#define GM_SB(b, h) ((4 + (b) * 2 + (h)) * HTB)
#define GM_STAGE(bufoff, gbase, voff) do { _Pragma("unroll") for (int _i = 0; _i < 2; ++_i) \
        __builtin_amdgcn_global_load_lds((const unsigned*)((const char*)(gbase) + (voff)[_i]), (LAS unsigned*)(lds + (bufoff) + ldsw + _i * 8192), 16, 0, 0); } while (0)
#define GM_LDA(dst, b, h) do { _Pragma("unroll") for (int m = 0; m < 4; ++m) _Pragma("unroll") for (int k = 0; k < 2; ++k) dst[m][k] = *(const LAS bf16x8*)(lds + GM_SA(b, h) + aoff + m * 2048 + k * KSTR); } while (0)
#define GM_LDB(dst, b, h) do { _Pragma("unroll") for (int n = 0; n < 2; ++n) _Pragma("unroll") for (int k = 0; k < 2; ++k) dst[n][k] = *(const LAS bf16x8*)(lds + GM_SB(b, h) + boff + n * 2048 + k * KSTR); } while (0)
#define GM_MMA(ai, bj, At, Bt) do { __builtin_amdgcn_s_setprio(1); \
        if constexpr (FP8) { _Pragma("unroll") for (int m = 0; m < 4; ++m) _Pragma("unroll") for (int n = 0; n < 2; ++n) \
            mfma8(acc[ai][bj][m][n], cat8(Bt[n][0], Bt[n][1]), cat8(At[m][0], At[m][1]), sc_w, sc_1); } \
        else { _Pragma("unroll") for (int m = 0; m < 4; ++m) _Pragma("unroll") for (int n = 0; n < 2; ++n) _Pragma("unroll") for (int k = 0; k < 2; ++k) \
            acc[ai][bj][m][n] = __builtin_amdgcn_mfma_f32_16x16x32_bf16(Bt[n][k], At[m][k], acc[ai][bj][m][n], 0, 0, 0); } \
        __builtin_amdgcn_s_setprio(0); } while (0)
#define GM_WAIT_V(n) asm volatile("s_waitcnt vmcnt(" #n ")" ::: "memory")
#define GM_WAIT_L(n) asm volatile("s_waitcnt lgkmcnt(" #n ")" ::: "memory")
#define GM_BAR __builtin_amdgcn_s_barrier()
#define GM_SCHED __builtin_amdgcn_sched_barrier(0)
    Unit cur, nxt; int ui = 0;
    if (!S.next(0, cur)) return;
    int sc_w = g.sw, sc_1 = g.sa; asm volatile("" : "+v"(sc_w), "+v"(sc_1));
    f32x4 acc[2][2][4][2];
#pragma unroll
    for (int a = 0; a < 2; ++a)
#pragma unroll
        for (int b = 0; b < 2; ++b)
#pragma unroll
            for (int m = 0; m < 4; ++m)
#pragma unroll
                for (int n = 0; n < 2; ++n) acc[a][b][m][n] = (f32x4){0.f, 0.f, 0.f, 0.f};
    bf16x8 At[4][2], B0[2][2], B1[2][2];
    unsigned vc[2][2], vn[2][2];
    S.a_off(g, cur, Rr, Cc, vc);
    const char* cA = S.a_base(g, cur); const char* cB = S.b_base(g, cur);
    GM_STAGE(GM_SB(0, 0), cB, voffB); GM_STAGE(GM_SB(0, 1), cB + hstepB, voffB); GM_STAGE(GM_SA(0, 0), cA, vc[0]); GM_STAGE(GM_SA(0, 1), cA, vc[1]);
    if (wr == 1) GM_BAR;
    GM_WAIT_V(2); GM_BAR;
    GM_STAGE(GM_SB(1, 0), cB + kstep, voffB); GM_STAGE(GM_SA(1, 0), cA + kstep, vc[0]); GM_STAGE(GM_SB(1, 1), cB + hstepB + kstep, voffB);
    GM_WAIT_V(6); GM_BAR;
    for (;;) {
        const bool has_next = S.next(ui + 1, nxt);
        const char* nA = cA; const char* nB = cB;
#pragma unroll
        for (int h = 0; h < 2; ++h)
#pragma unroll
            for (int i = 0; i < 2; ++i) vn[h][i] = vc[h][i];
        if (has_next) { nA = S.a_base(g, nxt); nB = S.b_base(g, nxt); if constexpr (Sched::GATHER) S.a_off(g, nxt, Rr, Cc, vn); }
        for (int t = 0; t < nt; t += 2) {
            const bool last = (t == nt - 2);
            const char* a1 = cA + (size_t)(t + 1) * kstep;
            const char* a2 = last ? nA : cA + (size_t)(t + 2) * kstep; const char* b2 = last ? nB : cB + (size_t)(t + 2) * kstep;
            const char* a3 = a2 + kstep; const char* b3 = b2 + kstep;
            unsigned v2[2][2];
#pragma unroll
            for (int h = 0; h < 2; ++h)
#pragma unroll
                for (int i = 0; i < 2; ++i) v2[h][i] = (Sched::GATHER && last) ? vn[h][i] : vc[h][i];
            GM_LDB(B0, 0, 0); GM_LDB(B1, 0, 1); GM_SCHED; GM_LDA(At, 0, 0); GM_STAGE(GM_SA(1, 1), a1, vc[1]);
            GM_WAIT_V(8); GM_WAIT_L(0); GM_BAR; GM_MMA(0, 0, At, B0); GM_MMA(0, 1, At, B1); GM_BAR; GM_SCHED;
            GM_LDA(At, 0, 1); GM_STAGE(GM_SB(0, 0), b2, voffB); GM_STAGE(GM_SB(0, 1), b2 + hstepB, voffB); GM_STAGE(GM_SA(0, 0), a2, v2[0]);
            GM_WAIT_V(8); GM_WAIT_L(0); GM_BAR; GM_MMA(1, 0, At, B0); GM_MMA(1, 1, At, B1); GM_BAR; GM_SCHED;
            GM_LDB(B0, 1, 0); GM_LDB(B1, 1, 1); GM_SCHED; GM_LDA(At, 1, 0); GM_STAGE(GM_SA(0, 1), a2, v2[1]);
            GM_WAIT_V(8); GM_WAIT_L(0); GM_BAR; GM_MMA(0, 0, At, B0); GM_MMA(0, 1, At, B1); GM_BAR; GM_SCHED;
            GM_LDA(At, 1, 1); GM_STAGE(GM_SB(1, 0), b3, voffB); GM_STAGE(GM_SB(1, 1), b3 + hstepB, voffB); GM_STAGE(GM_SA(1, 0), a3, v2[0]);
            GM_WAIT_V(8); GM_WAIT_L(0); GM_BAR; GM_MMA(1, 0, At, B0); GM_MMA(1, 1, At, B1); GM_BAR; GM_SCHED;
        }
        if (wr == 0) GM_BAR;
        if constexpr (FP8) { asm volatile("s_nop 15\n\ts_nop 15\n\ts_nop 15" ::: "memory"); }
        { int fr_e = fr, fq_e = fq; asm volatile("" : "+v"(fr_e), "+v"(fq_e));
          E(acc, cur, lds, wr, wc, fr_e, fq_e); }
        if (!has_next) break;
#pragma unroll
        for (int a = 0; a < 2; ++a)
#pragma unroll
            for (int b = 0; b < 2; ++b)
#pragma unroll
                for (int m = 0; m < 4; ++m)
#pragma unroll
                    for (int n = 0; n < 2; ++n) acc[a][b][m][n] = (f32x4){0.f, 0.f, 0.f, 0.f};
        cur = nxt; cA = nA; cB = nB; ++ui;
#pragma unroll
        for (int h = 0; h < 2; ++h)
#pragma unroll
            for (int i = 0; i < 2; ++i) vc[h][i] = vn[h][i];
        if (wr == 1) GM_BAR;
    }
    GM_WAIT_V(0);
    GM_BAR;
#undef GM_SA
#undef GM_SB
#undef GM_STAGE
#undef GM_LDA
#undef GM_LDB
#undef GM_MMA
#undef GM_WAIT_V
#undef GM_WAIT_L
#undef GM_BAR
#undef GM_SCHED
}

struct EpiZ {
    bf16_t* Z; const float *qn_c, *kn_c, *qn_d, *kn_d; const float *cosC, *sinC, *cosD, *sinD;
    __device__ __forceinline__ void operator()(f32x4 (&acc)[2][2][4][2], const Unit& u, LAS unsigned char* lds, int wr, int wc, int fr, int fq) const {
        const int pn = u.pn; const int row0 = u.pm * BM + wr * 64 + fr;
        if (pn >= 10 && pn < 22) {
            LAS float* xch = (LAS float*)(lds + XCH_OFF);
            const int hh = 2 * (pn - 10) + (wc >> 1); const float* gn = (hh >= 12) ? kn_c : qn_c;
            const int i0 = 32 * (wc & 1) + 8 * fq;
#pragma unroll
            for (int ai = 0; ai < 2; ++ai)
#pragma unroll
                for (int m = 0; m < 4; ++m) { float ss = 0.f;
#pragma unroll
                    for (int bj = 0; bj < 2; ++bj)
#pragma unroll
                        for (int n = 0; n < 2; ++n) { const f32x4 x = acc[ai][bj][m][n]; ss += (x[0] * x[0] + x[1] * x[1]) + (x[2] * x[2] + x[3] * x[3]); }
                    ss += __shfl_xor(ss, 16); ss += __shfl_xor(ss, 32);
                    if (fq == 0) xch[(ai * HALF + wr * 64 + m * 16 + fr) * 4 + wc] = ss; }
            LDS_WAIT(); __builtin_amdgcn_s_barrier(); asm volatile("" ::: "memory");
            f32x4 ivr[2];
#pragma unroll
            for (int n = 0; n < 2; ++n) {
#pragma unroll
                for (int j = 0; j < 4; ++j) ivr[n][j] = __builtin_amdgcn_exp2f(-(float)(i0 + 4 * n + j) * (13.287712379549449f / 64.0f)) * 0.15915494309189535f; }
#pragma unroll
            for (int ai = 0; ai < 2; ++ai)
#pragma unroll
                for (int m = 0; m < 4; ++m) { const int rl = ai * HALF + wr * 64 + m * 16 + fr; const int row = u.pm * BM + rl;
                    const float tot = xch[rl * 4 + wc] + xch[rl * 4 + (wc ^ 1)];
                    const float rstd = 1.0f / sqrtf(tot * (1.0f / 128.0f) + EPS);
                    const float posf = (float)(row & (SEQ - 1));
                    u32x4 w0, w1;
#pragma unroll
                    for (int n = 0; n < 2; ++n) { f32x4 cs, sn;
#pragma unroll
                        for (int j = 0; j < 4; ++j) { const float xr = __builtin_amdgcn_fractf(posf * ivr[n][j]); cs[j] = __builtin_amdgcn_cosf(xr); sn[j] = __builtin_amdgcn_sinf(xr); }
                        const f32x4 g0 = *(const f32x4*)(gn + i0 + 4 * n), g1 = *(const f32x4*)(gn + 64 + i0 + 4 * n);
                        const f32x4 x1 = acc[ai][0][m][n] * rstd * g0, x2 = acc[ai][1][m][n] * rstd * g1;
                        const f32x4 o1 = x1 * cs - x2 * sn, o2 = x2 * cs + x1 * sn;
                        w0[2 * n] = cvt_pk_bf16(o1[0], o1[1]); w0[2 * n + 1] = cvt_pk_bf16(o1[2], o1[3]);
                        w1[2 * n] = cvt_pk_bf16(o2[0], o2[1]); w1[2 * n + 1] = cvt_pk_bf16(o2[2], o2[3]); }
                    bf16_t* rp = Z + (size_t)row * WIN + ZC + hh * 128 + i0;
                    *(u32x4*)rp = w0; *(u32x4*)(rp + 64) = w1; }
        } else if (pn >= 28 && pn < 32) {
            const float* gn = (pn >= 30) ? kn_d : qn_d;
            const int i0 = 8 * fq;
            f32x4 ivr[2];
#pragma unroll
            for (int n = 0; n < 2; ++n) {
#pragma unroll
                for (int j = 0; j < 4; ++j) ivr[n][j] = __builtin_amdgcn_exp2f(-(float)(i0 + 4 * n + j) * (13.287712379549449f / 32.0f)) * 0.15915494309189535f; }
#pragma unroll
            for (int ai = 0; ai < 2; ++ai)
#pragma unroll
                for (int m = 0; m < 4; ++m) { const int row = row0 + ai * HALF + m * 16; float ss = 0.f;
#pragma unroll
                    for (int bj = 0; bj < 2; ++bj)
#pragma unroll
                        for (int n = 0; n < 2; ++n) { const f32x4 x = acc[ai][bj][m][n]; ss += (x[0] * x[0] + x[1] * x[1]) + (x[2] * x[2] + x[3] * x[3]); }
                    ss += __shfl_xor(ss, 16); ss += __shfl_xor(ss, 32);
                    const float rstd = 1.0f / sqrtf(ss * (1.0f / 64.0f) + EPS);
                    const float posf = (float)(row & (SEQ - 1));
                    u32x4 w0, w1;
#pragma unroll
                    for (int n = 0; n < 2; ++n) { f32x4 cs, sn;
#pragma unroll
                        for (int j = 0; j < 4; ++j) { const float xr = __builtin_amdgcn_fractf(posf * ivr[n][j]); cs[j] = __builtin_amdgcn_cosf(xr); sn[j] = __builtin_amdgcn_sinf(xr); }
                        const f32x4 g0 = *(const f32x4*)(gn + i0 + 4 * n), g1 = *(const f32x4*)(gn + 32 + i0 + 4 * n);
                        const f32x4 x1 = acc[ai][0][m][n] * rstd * g0, x2 = acc[ai][1][m][n] * rstd * g1;
                        const f32x4 o1 = x1 * cs - x2 * sn, o2 = x2 * cs + x1 * sn;
                        w0[2 * n] = cvt_pk_bf16(o1[0], o1[1]); w0[2 * n + 1] = cvt_pk_bf16(o1[2], o1[3]);
                        w1[2 * n] = cvt_pk_bf16(o2[0], o2[1]); w1[2 * n + 1] = cvt_pk_bf16(o2[2], o2[3]); }
                    bf16_t* rp = Z + (size_t)row * WIN + ZD + (pn - 28) * 256 + wc * 64 + i0;
                    *(u32x4*)rp = w0; *(u32x4*)(rp + 32) = w1; }
        } else {
            const bool do_gelu = pn < 4;
#pragma unroll
            for (int ai = 0; ai < 2; ++ai)
#pragma unroll
                for (int m = 0; m < 4; ++m) { bf16_t* rp = Z + (size_t)(row0 + ai * HALF + m * 16) * WIN + pn * BM + wc * 32 + 8 * fq;
#pragma unroll
                    for (int bj = 0; bj < 2; ++bj) { f32x4 v0 = acc[ai][bj][m][0], v1 = acc[ai][bj][m][1];
                        if (do_gelu) {
#pragma unroll
                            for (int j = 0; j < 4; ++j) { v0[j] = gelu_tanh(v0[j]); v1[j] = gelu_tanh(v1[j]); } }
                        u32x4 w; w.x = cvt_pk_bf16(v0[0], v0[1]); w.y = cvt_pk_bf16(v0[2], v0[3]); w.z = cvt_pk_bf16(v1[0], v1[1]); w.w = cvt_pk_bf16(v1[2], v1[3]);
                        *(u32x4*)(rp + bj * HALF) = w; } }
        }
    }
};
struct EpiBf16 {
    bf16_t* O; int ldc;
    __device__ __forceinline__ void operator()(f32x4 (&acc)[2][2][4][2], const Unit& u, LAS unsigned char*, int wr, int wc, int fr, int fq) const {
        const int row0 = u.pm * BM + wr * 64 + fr;
#pragma unroll
        for (int ai = 0; ai < 2; ++ai)
#pragma unroll
            for (int m = 0; m < 4; ++m) { bf16_t* rp = O + (size_t)(row0 + ai * HALF + m * 16) * ldc + u.pn * BM + wc * 32 + 8 * fq;
#pragma unroll
                for (int bj = 0; bj < 2; ++bj) { const f32x4 v0 = acc[ai][bj][m][0], v1 = acc[ai][bj][m][1];
                    u32x4 w; w.x = cvt_pk_bf16(v0[0], v0[1]); w.y = cvt_pk_bf16(v0[2], v0[3]); w.z = cvt_pk_bf16(v1[0], v1[1]); w.w = cvt_pk_bf16(v1[2], v1[3]);
                    __builtin_nontemporal_store(w, (u32x4*)(rp + bj * HALF)); } }
    }
};
template <bool OUT8> struct EpiGateT {
    void* Mg; const bf16_t* P; const float* bg;
    __device__ __forceinline__ void operator()(f32x4 (&acc)[2][2][4][2], const Unit& u, LAS unsigned char*, int wr, int wc, int fr, int fq) const {
        const int row0 = u.pm * BM + wr * 64 + fr; const int c = 64 * u.pn + 16 * wc + 4 * fq;
        constexpr float NL2E = -1.4426950408889634f;
        f32x4 bl[4];
#pragma unroll
        for (int k = 0; k < 4; ++k) bl[k] = *(const f32x4*)(bg + k * D + c) * NL2E;
#pragma unroll
        for (int ai = 0; ai < 2; ++ai) {
            u32x2 pw[4][4];
#pragma unroll
            for (int m = 0; m < 4; ++m) { const bf16_t* pr = P + (size_t)(row0 + ai * HALF + m * 16) * 8192 + c;
#pragma unroll
                for (int k = 0; k < 4; ++k) pw[m][k] = *(const u32x2*)(pr + k * D); }
            asm volatile("" ::: "memory");
#pragma unroll
            for (int m = 0; m < 4; ++m) { const size_t row = (size_t)(row0 + ai * HALF + m * 16); f32x4 s = (f32x4){0.f, 0.f, 0.f, 0.f};
#pragma unroll
                for (int k = 0; k < 4; ++k) { const f32x4 e = acc[ai][k >> 1][m][k & 1] * NL2E + bl[k]; const u32x2 p = pw[m][k];
                    f32x4 t; t[0] = __builtin_amdgcn_exp2f(e[0]); t[1] = __builtin_amdgcn_exp2f(e[1]); t[2] = __builtin_amdgcn_exp2f(e[2]); t[3] = __builtin_amdgcn_exp2f(e[3]);
                    t = t + 1.0f;
                    f32x4 r; r[0] = __builtin_amdgcn_rcpf(t[0]); r[1] = __builtin_amdgcn_rcpf(t[1]); r[2] = __builtin_amdgcn_rcpf(t[2]); r[3] = __builtin_amdgcn_rcpf(t[3]);
                    const f32x4 pv = (f32x4){bf_lo(p.x), bf_hi(p.x), bf_lo(p.y), bf_hi(p.y)};
                    s = r * pv + s; }
                if constexpr (OUT8) { int p = __builtin_amdgcn_cvt_pk_fp8_f32(s[0], s[1], 0, false); p = __builtin_amdgcn_cvt_pk_fp8_f32(s[2], s[3], p, true); *(unsigned*)((unsigned char*)Mg + row * D + c) = (unsigned)p; }
                else { u32x2 w; w.x = cvt_pk_bf16(s[0], s[1]); w.y = cvt_pk_bf16(s[2], s[3]); *(u32x2*)((bf16_t*)Mg + row * D + c) = w; } }
        }
    }
};
struct EpiResid {
    const float* XF; bf16_t* XB;
    __device__ __forceinline__ void operator()(f32x4 (&acc)[2][2][4][2], const Unit& u, LAS unsigned char*, int wr, int wc, int fr, int fq) const {
        const int row0 = u.pm * BM + wr * 64 + fr;
#pragma unroll
        for (int ai = 0; ai < 2; ++ai)
#pragma unroll
            for (int m = 0; m < 4; ++m) { const size_t off = (size_t)(row0 + ai * HALF + m * 16) * D + u.pn * BM + wc * 32 + 8 * fq;
#pragma unroll
                for (int bj = 0; bj < 2; ++bj) { f32x4 x0, x1;
                    if (XF) { x0 = *(const f32x4*)(XF + off + bj * HALF); x1 = *(const f32x4*)(XF + off + bj * HALF + 4); }
                    else { const u32x4 r = *(const u32x4*)(XB + off + bj * HALF); x0 = (f32x4){bf_lo(r.x), bf_hi(r.x), bf_lo(r.y), bf_hi(r.y)}; x1 = (f32x4){bf_lo(r.z), bf_hi(r.z), bf_lo(r.w), bf_hi(r.w)}; }
                    x0 += acc[ai][bj][m][0]; x1 += acc[ai][bj][m][1];
                    u32x4 w; w.x = cvt_pk_bf16(x0[0], x0[1]); w.y = cvt_pk_bf16(x0[2], x0[3]); w.z = cvt_pk_bf16(x1[0], x1[1]); w.w = cvt_pk_bf16(x1[2], x1[3]);
                    *(u32x4*)(XB + off + bj * HALF) = w; } }
    }
};
struct MoeOrder {
    static constexpr bool GATHER = false;
    int nN, G, c; LAS const int* tab; const u32x4* list; int nexp_rows;
    __device__ __forceinline__ bool next(int i, Unit& u) const {
        const int L = i * G + c; const int TT = tab[32]; const int rt = L / nN;
        if (rt >= TT) return false;
        int e = 0;
#pragma unroll 1
        for (int k = 1; k < 32; ++k) e = (tab[k] <= rt) ? k : e;
        u.pm = rt; u.pn = L - rt * nN; u.aux = e; return true;
    }
    __device__ __forceinline__ const char* b_base(const Desc& g, const Unit& u) const { return (const char*)g.Bt + ((size_t)u.aux * nexp_rows + (size_t)u.pn * BM) * g.ldb; }
};
struct MoeUpOrder : MoeOrder {
    static constexpr bool GATHER = true;
    __device__ __forceinline__ const char* a_base(const Desc& g, const Unit&) const { return (const char*)g.A; }
    __device__ __forceinline__ void a_off(const Desc& g, const Unit& u, const int (&R)[2], const int (&C)[2], unsigned (&v)[2][2]) const {
        const int e = u.aux, base = (u.pm - tab[e]) * BM, cnt = tab[40 + e];
#pragma unroll
        for (int h = 0; h < 2; ++h)
#pragma unroll
            for (int i = 0; i < 2; ++i) { const int idx = base + R[i] + HALF * h; int tok = 0; if (idx < cnt) tok = (int)(list[(size_t)e * T + idx].x & 0x7fffu);
                v[h][i] = (unsigned)(tok * g.lda + C[i] * 2); }
    }
};
struct MoeDownOrder : MoeOrder {
    __device__ __forceinline__ const char* a_base(const Desc& g, const Unit& u) const { return (const char*)g.A + (size_t)u.pm * BM * g.lda; }
    __device__ __forceinline__ void a_off(const Desc& g, const Unit&, const int (&R)[2], const int (&C)[2], unsigned (&v)[2][2]) const {
#pragma unroll
        for (int h = 0; h < 2; ++h)
#pragma unroll
            for (int i = 0; i < 2; ++i) v[h][i] = (unsigned)((R[i] + HALF * h) * g.lda + C[i] * 2);
    }
};
template <bool OUT8> struct EpiUpT {
    void* Hid; const u32x4* list;
    __device__ __forceinline__ void operator()(f32x4 (&acc)[2][2][4][2], const Unit& u, LAS unsigned char* lds, int wr, int wc, int fr, int fq) const {
        LAS const int* tab = (LAS const int*)(lds + TAB_OFF);
        const int e = u.aux, base = (u.pm - tab[e]) * BM, cnt = tab[40 + e];
        const int row0 = u.pm * BM + wr * 64 + fr;
        float rs[2][4];
#pragma unroll
        for (int ai = 0; ai < 2; ++ai)
#pragma unroll
            for (int m = 0; m < 4; ++m) { const int idx = base + ai * HALF + wr * 64 + m * 16 + fr; rs[ai][m] = (idx < cnt) ? __uint_as_float(list[(size_t)e * T + idx].z) : 0.f; }
#pragma unroll
        for (int ai = 0; ai < 2; ++ai)
#pragma unroll
            for (int m = 0; m < 4; ++m) { const size_t eo = (size_t)(row0 + ai * HALF + m * 16) * 512 + u.pn * 128 + wc * 32 + 8 * fq; f32x4 o[2]; const float r = rs[ai][m];
#pragma unroll
                for (int n = 0; n < 2; ++n)
#pragma unroll
                    for (int j = 0; j < 4; ++j) { const float a = acc[ai][0][m][n][j] * r; o[n][j] = a * sigmoidf_(a) * (acc[ai][1][m][n][j] * r); }
                if constexpr (OUT8) { u32x2 w; int p = __builtin_amdgcn_cvt_pk_fp8_f32(o[0][0] * 16.f, o[0][1] * 16.f, 0, false); p = __builtin_amdgcn_cvt_pk_fp8_f32(o[0][2] * 16.f, o[0][3] * 16.f, p, true); w.x = (unsigned)p;
                    p = __builtin_amdgcn_cvt_pk_fp8_f32(o[1][0] * 16.f, o[1][1] * 16.f, 0, false); p = __builtin_amdgcn_cvt_pk_fp8_f32(o[1][2] * 16.f, o[1][3] * 16.f, p, true); w.y = (unsigned)p;
                    *(u32x2*)((unsigned char*)Hid + eo) = w; }
                else { u32x4 w; w.x = cvt_pk_bf16(o[0][0], o[0][1]); w.y = cvt_pk_bf16(o[0][2], o[0][3]); w.z = cvt_pk_bf16(o[1][0], o[1][1]); w.w = cvt_pk_bf16(o[1][2], o[1][3]);
                    *(u32x4*)((bf16_t*)Hid + eo) = w; } }
    }
};
template <bool OUT8> struct EpiDownT {
    void *Y0, *Y1; const u32x4* list;
    __device__ __forceinline__ void operator()(f32x4 (&acc)[2][2][4][2], const Unit& u, LAS unsigned char* lds, int wr, int wc, int fr, int fq) const {
        LAS const int* tab = (LAS const int*)(lds + TAB_OFF);
        const int e = u.aux, base = (u.pm - tab[e]) * BM, cnt = tab[40 + e];
#pragma unroll
        for (int ai = 0; ai < 2; ++ai)
#pragma unroll
            for (int m = 0; m < 4; ++m) { const int idx = base + ai * HALF + wr * 64 + m * 16 + fr;
                if (idx < cnt) { const u32x4 en = list[(size_t)e * T + idx]; const int tok = (int)(en.x & 0x7fffu); const float w = __uint_as_float(en.y);
                    const size_t eo = (size_t)tok * D + u.pn * BM + wc * 32 + 8 * fq; void* yb = (en.x >> 16) ? Y1 : Y0;
#pragma unroll
                    for (int bj = 0; bj < 2; ++bj) { const f32x4 v0 = acc[ai][bj][m][0] * w, v1 = acc[ai][bj][m][1] * w;
                        if constexpr (OUT8) { int p0 = __builtin_amdgcn_cvt_pk_fp8_f32(v0[0] * 16.f, v0[1] * 16.f, 0, false); p0 = __builtin_amdgcn_cvt_pk_fp8_f32(v0[2] * 16.f, v0[3] * 16.f, p0, true);
                            int p1 = __builtin_amdgcn_cvt_pk_fp8_f32(v1[0] * 16.f, v1[1] * 16.f, 0, false); p1 = __builtin_amdgcn_cvt_pk_fp8_f32(v1[2] * 16.f, v1[3] * 16.f, p1, true);
                            *(u32x2*)((unsigned char*)yb + eo + bj * HALF) = (u32x2){(unsigned)p0, (unsigned)p1}; }
                        else { u32x4 ww; ww.x = cvt_pk_bf16(v0[0], v0[1]); ww.y = cvt_pk_bf16(v0[2], v0[3]); ww.z = cvt_pk_bf16(v1[0], v1[1]); ww.w = cvt_pk_bf16(v1[2], v1[3]);
                            *(u32x4*)((bf16_t*)yb + eo + bj * HALF) = ww; } } } }
    }
};
struct EpiProbe {
    float* dummy;
    __device__ __forceinline__ void operator()(f32x4 (&acc)[2][2][4][2], const Unit& u, LAS unsigned char*, int wr, int wc, int fr, int fq) const {
        f32x4 s = (f32x4){0.f, 0.f, 0.f, 0.f};
#pragma unroll
        for (int ai = 0; ai < 2; ++ai)
#pragma unroll
            for (int bj = 0; bj < 2; ++bj)
#pragma unroll
                for (int m = 0; m < 4; ++m)
#pragma unroll
                    for (int n = 0; n < 2; ++n) s += acc[ai][bj][m][n];
        if (s[0] + s[1] + s[2] + s[3] == 12345.678f) dummy[u.pm * 64 + fr] = s[0];
    }
};
}

namespace at {
#define SBAR() __builtin_amdgcn_sched_barrier(0)
__device__ __forceinline__ int crow(int r, int hi) { return (r & 3) + 8 * (r >> 2) + 4 * hi; }
template <int DQK> __device__ __forceinline__ int kswz(int row, int colB) { if (DQK == 128) return row * 256 + (colB ^ ((row & 7) << 4)); else return row * 128 + (colB ^ (((row >> 1) & 7) << 4)); }
constexpr int SHM_V = 64 * 128 * 2;
constexpr int LDS_WS = 131072;
__device__ __forceinline__ int v_st(int k, int c) { const int kk = (k & ~0xC) | ((k & 4) << 1) | ((k & 8) >> 1); return ((kk >> 3) * 4 + (c >> 5)) * 512 + ((kk & 7) * 32 + (c & 31)) * 2; }
__device__ __forceinline__ int v_rd_base(int lane) { return ((lane & 3) << 3) | (((lane >> 2) & 3) << 6) | (((lane >> 4) & 1) << 5) | (((lane >> 5) & 1) << 8); }
constexpr int v_rd_off(int d0, int ks, int half) { return d0 * 512 + ks * 4096 + half * 2048; }
template <int OFF> __device__ __forceinline__ s16x4 tr_read(unsigned vb) { s16x4 r; asm volatile("ds_read_b64_tr_b16 %0, %1 offset:%2" : "=&v"(r) : "v"(vb), "i"(OFF) : "memory"); return r; }
template <int D0> __device__ __forceinline__ void v_read8(s16x4 (&v)[8], unsigned vb) {
    v[0] = tr_read<v_rd_off(D0, 0, 0)>(vb); v[1] = tr_read<v_rd_off(D0, 0, 1)>(vb); v[2] = tr_read<v_rd_off(D0, 1, 0)>(vb); v[3] = tr_read<v_rd_off(D0, 1, 1)>(vb);
    v[4] = tr_read<v_rd_off(D0, 2, 0)>(vb); v[5] = tr_read<v_rd_off(D0, 2, 1)>(vb); v[6] = tr_read<v_rd_off(D0, 3, 0)>(vb); v[7] = tr_read<v_rd_off(D0, 3, 1)>(vb);
}
__device__ __forceinline__ void pv_mma4(f32x16& od, const s16x4 (&v)[8], bf16x8 pa0, bf16x8 pa1, bf16x8 pa2, bf16x8 pa3) {
#define AT_PK(L, H) (bf16x8){L[0], L[1], L[2], L[3], H[0], H[1], H[2], H[3]}
    od = __builtin_amdgcn_mfma_f32_32x32x16_bf16(pa0, AT_PK(v[0], v[1]), od, 0, 0, 0);
    od = __builtin_amdgcn_mfma_f32_32x32x16_bf16(pa1, AT_PK(v[2], v[3]), od, 0, 0, 0);
    od = __builtin_amdgcn_mfma_f32_32x32x16_bf16(pa2, AT_PK(v[4], v[5]), od, 0, 0, 0);
    od = __builtin_amdgcn_mfma_f32_32x32x16_bf16(pa3, AT_PK(v[6], v[7]), od, 0, 0, 0);
#undef AT_PK
}
__device__ __forceinline__ void pv_d0(f32x16* o, unsigned vb, bf16x8 pa0, bf16x8 pa1, bf16x8 pa2, bf16x8 pa3) {
    s16x4 va[8], vb8[8];
    v_read8<0>(va, vb);
    v_read8<1>(vb8, vb); asm volatile("s_waitcnt lgkmcnt(8)" ::: "memory"); SBAR(); pv_mma4(o[0], va, pa0, pa1, pa2, pa3);
    v_read8<2>(va, vb);  asm volatile("s_waitcnt lgkmcnt(8)" ::: "memory"); SBAR(); pv_mma4(o[1], vb8, pa0, pa1, pa2, pa3);
    v_read8<3>(vb8, vb); asm volatile("s_waitcnt lgkmcnt(8)" ::: "memory"); SBAR(); pv_mma4(o[2], va, pa0, pa1, pa2, pa3);
    asm volatile("s_waitcnt lgkmcnt(0)" ::: "memory"); SBAR(); pv_mma4(o[3], vb8, pa0, pa1, pa2, pa3);
}
template <int DQK> struct SmC { static constexpr float SCALE = (DQK == 128) ? 0.08838834764831845f : 0.125f; static constexpr float MNAT = (DQK == 128) ? 16.f : 12.f; };
template <int DQK> __device__ __forceinline__ void softmax_tile(f32x16& p0, f32x16& p1, float& l_reg, bf16x8& pa0, bf16x8& pa1, bf16x8& pa2, bf16x8& pa3) {
    constexpr float C = SmC<DQK>::SCALE * 1.4426950408889634f, MC = -SmC<DQK>::MNAT * 1.4426950408889634f;
#pragma unroll
    for (int r = 0; r < 16; ++r) p0[r] = __builtin_amdgcn_exp2f(fmaf(p0[r], C, MC));
#pragma unroll
    for (int r = 0; r < 16; ++r) p1[r] = __builtin_amdgcn_exp2f(fmaf(p1[r], C, MC));
    float ps = 0;
#pragma unroll
    for (int r = 0; r < 16; ++r) ps += p0[r];
#pragma unroll
    for (int r = 0; r < 16; ++r) ps += p1[r];
    { auto rr = __builtin_amdgcn_permlane32_swap(__float_as_uint(ps), __float_as_uint(ps), false, false);
      ps = __uint_as_float(rr[0]) + __uint_as_float(rr[1]); }
    l_reg += ps;
#define AT_PK4(P, BASE, OUT) do { unsigned a0 = cvt_pk_bf16(P[BASE + 0], P[BASE + 1]), a1 = cvt_pk_bf16(P[BASE + 2], P[BASE + 3]);   \
    unsigned b0 = cvt_pk_bf16(P[BASE + 4], P[BASE + 5]), b1 = cvt_pk_bf16(P[BASE + 6], P[BASE + 7]);                              \
    auto r0 = __builtin_amdgcn_permlane32_swap(a0, b0, false, false); auto r1 = __builtin_amdgcn_permlane32_swap(a1, b1, false, false); \
    u32x4 w = {r0[0], r1[0], r0[1], r1[1]}; OUT = __builtin_bit_cast(bf16x8, w); } while (0)
    AT_PK4(p0, 0, pa0); AT_PK4(p0, 8, pa1); AT_PK4(p1, 0, pa2); AT_PK4(p1, 8, pa3);
#undef AT_PK4
}
template <int DQK> __device__ __forceinline__ void qkt(f32x16& p0, f32x16& p1, LAS const unsigned char* Ks, const bf16x8* qr, int r32, int hi) {
#pragma unroll
    for (int r = 0; r < 16; ++r) { p0[r] = 0.f; p1[r] = 0.f; }
#pragma unroll
    for (int d0 = 0; d0 < DQK / 16; ++d0) { const int cb = (d0 * 16 + hi * 8) * 2;
        const bf16x8 b0 = *(LAS const bf16x8*)(Ks + kswz<DQK>(r32, cb));
        const bf16x8 b1 = *(LAS const bf16x8*)(Ks + kswz<DQK>(32 + r32, cb));
        p0 = __builtin_amdgcn_mfma_f32_32x32x16_bf16(b0, qr[d0], p0, 0, 0, 0);
        p1 = __builtin_amdgcn_mfma_f32_32x32x16_bf16(b1, qr[d0], p1, 0, 0, 0); }
}
struct AttnP {
    const bf16_t *zq, *zk, *zv;
    int tokbase, stride;
    int q0;
    int kstart;
    int NT;
    int W;
};
__device__ __forceinline__ void mask_tile(f32x16& p0, f32x16& p1, int qm, int kb, int W, int hi, int qw0) {
    const bool full = (qw0 - (kb + 63) >= 0) && (qw0 + 31 - kb <= W) && (kb >= 0);
    if (full) return;
    const float ninf = -__builtin_inff();
#pragma unroll
    for (int r = 0; r < 16; ++r) { const int km = kb + crow(r, hi); const int d0 = qm - km, d1 = d0 - 32;
        p0[r] = (d0 >= 0 && d0 <= W && km >= 0) ? p0[r] : ninf;
        p1[r] = (d1 >= 0 && d1 <= W && km + 32 >= 0) ? p1[r] : ninf; }
}
template <int DQK>
__device__ __forceinline__ void attn_run(const AttnP& P, LAS unsigned char* lds, f32x16 (&o)[4], float& l_reg, float& m_reg) {
    const int tid = opaque_tid(), wid = __builtin_amdgcn_readfirstlane(tid >> 6), lane = tid & 63, r32 = lane & 31, hi = lane >> 5;
    constexpr int KSUB = 64 * DQK * 2, KBUF = 2 * KSUB, VSUB = 16384, VBUF = 2 * VSUB;
    LAS unsigned char* K_lds = lds; LAS unsigned char* V_lds = lds + 2 * KBUF;
    m_reg = SmC<DQK>::MNAT / SmC<DQK>::SCALE; l_reg = 0.f;
#pragma unroll
    for (int d = 0; d < 4; ++d)
#pragma unroll
        for (int r = 0; r < 16; ++r) o[d][r] = 0.f;
    const int qw0 = P.q0 + wid * 32, qm = qw0 + r32;
    bf16x8 qr[DQK / 16];
    { const bf16_t* Qw = P.zq + (size_t)(P.tokbase + qm * P.stride) * WIN + hi * 8;
#pragma unroll
      for (int d0 = 0; d0 < DQK / 16; ++d0) qr[d0] = *(const bf16x8*)(Qw + d0 * 16); }
    int vkey[2], vcol[2], kkey[2], kcol[2];
#pragma unroll
    for (int i = 0; i < 2; ++i) { const int off = (tid + 512 * i) * 16; const int sub = off >> 9, within = off & 511, kk = (sub >> 2) * 8 + (within >> 6);
        vkey[i] = (kk & ~0xC) | ((kk & 4) << 1) | ((kk & 8) >> 1); vcol[i] = (sub & 3) * 32 + ((within & 63) >> 1);
        if (DQK == 128) { const int row = off >> 8, cs = off & 255; kkey[i] = row; kcol[i] = (cs ^ ((row & 7) << 4)) >> 1; }
        else { const int row = off >> 7, cs = off & 127; kkey[i] = row; kcol[i] = (cs ^ (((row >> 1) & 7) << 4)) >> 1; } }
    const unsigned vb0 = (unsigned)(size_t)V_lds + v_rd_base(lane);
#define AT_ROW(km) ((size_t)(P.tokbase + ((km) < 0 ? 0 : (km)) * P.stride) * WIN)
#define AT_DMA(jp, b) do { _Pragma("unroll") for (int s_ = 0; s_ < 2; ++s_) { const int k0_ = P.kstart + (2 * (jp) + s_) * 64; \
        _Pragma("unroll") for (int i_ = 0; i_ < 2; ++i_) __builtin_amdgcn_global_load_lds((const unsigned*)(P.zv + AT_ROW(k0_ + vkey[i_]) + vcol[i_]), (LAS unsigned*)(V_lds + (b) * VBUF + s_ * VSUB + wid * 1024 + i_ * 8192), 16, 0, 0); \
        _Pragma("unroll") for (int i_ = 0; i_ < (DQK == 128 ? 2 : 1); ++i_) __builtin_amdgcn_global_load_lds((const unsigned*)(P.zk + AT_ROW(k0_ + kkey[i_]) + kcol[i_]), (LAS unsigned*)(K_lds + (b) * KBUF + s_ * KSUB + wid * 1024 + i_ * 8192), 16, 0, 0); } } while (0)
    f32x16 pA0, pA1, pB0, pB1; bf16x8 pa0, pa1, pa2, pa3; const int NT2 = P.NT >> 1;
    AT_DMA(0, 0); VM_WAIT(); __syncthreads();
#pragma unroll 1
    for (int jp = 0; jp < NT2; ++jp) {
        const int b = jp & 1;
        if (jp + 1 < NT2) AT_DMA(jp + 1, b ^ 1);
        SBAR();
        const int kbA = P.kstart + jp * 128, kbB = kbA + 64;
        const bool noneA = (qw0 + 31 - kbA < 0) || (qw0 - (kbA + 63) > P.W) || (kbA + 63 < 0);
        const bool noneB = (qw0 + 31 - kbB < 0) || (qw0 - (kbB + 63) > P.W) || (kbB + 63 < 0);
        if (!noneA) qkt<DQK>(pA0, pA1, K_lds + b * KBUF, qr, r32, hi);
        if (!noneB) qkt<DQK>(pB0, pB1, K_lds + b * KBUF + KSUB, qr, r32, hi);
        SBAR();
        if (!noneA) { mask_tile(pA0, pA1, qm, kbA, P.W, hi, qw0); softmax_tile<DQK>(pA0, pA1, l_reg, pa0, pa1, pa2, pa3); SBAR(); pv_d0(o, vb0 + b * VBUF, pa0, pa1, pa2, pa3); }
        if (!noneB) { mask_tile(pB0, pB1, qm, kbB, P.W, hi, qw0); softmax_tile<DQK>(pB0, pB1, l_reg, pa0, pa1, pa2, pa3); SBAR(); pv_d0(o, vb0 + b * VBUF + VSUB, pa0, pa1, pa2, pa3); }
        VM_WAIT(); __syncthreads();
    }
#undef AT_ROW
#undef AT_DMA
}
__device__ __forceinline__ void attn_normalise(LAS unsigned char* lds, f32x16 (&o)[4], float l_reg) {
    const int tid = opaque_tid(), wid = tid >> 6, lane = tid & 63, r32 = lane & 31, hi = lane >> 5;
    LAS float* li_l = (LAS float*)(lds + LDS_WS) + wid * 64;
    if (hi == 0) li_l[r32] = l_reg; asm volatile("s_waitcnt lgkmcnt(0)" ::: "memory");
#pragma unroll
    for (int r = 0; r < 16; ++r) { const float rl = __builtin_amdgcn_rcpf(li_l[crow(r, hi)]);
#pragma unroll
        for (int d = 0; d < 4; ++d) o[d][r] *= rl; }
    asm volatile("s_waitcnt lgkmcnt(0)" ::: "memory");
}
}

#define XB_TMO      128
#define XB_XCNT(j)  (256  + 64 * (j))
#define XB_XSUB(j)  (1280 + 64 * (j))
#define XB_XGEN(j)  (2304 + 64 * (j))
#define XB_TOP      3328
#define XB_TOPGEN   3392
#define XCD_BAR_WORDS 3456
#define XB_SPIN_CAP (1u << 18)

__device__ __forceinline__ unsigned xb_ld(unsigned* p)              { return __hip_atomic_load(p, __ATOMIC_RELAXED, __HIP_MEMORY_SCOPE_AGENT); }
__device__ __forceinline__ unsigned xb_add(unsigned* p, unsigned v) { return __hip_atomic_fetch_add(p, v, __ATOMIC_RELAXED, __HIP_MEMORY_SCOPE_AGENT); }
__device__ __forceinline__ unsigned xb_xcc_id() { return (unsigned)__builtin_amdgcn_s_getreg((3 << 11) | 20) & 0xFu; }
#define XB_SPIN(cond, bar) do { unsigned _sp = 0; while (cond) { __builtin_amdgcn_s_sleep(1); \
    if ((++_sp & 255u) == 0u) { if (xb_ld(&(bar)[XB_TMO])) break; if (_sp > XB_SPIN_CAP) { atomicAdd(&(bar)[XB_TMO], 1u); break; } } } } while (0)

struct XcdBarrier {
    unsigned* bar; unsigned x;
    volatile LAS unsigned* st;
};

__device__ __forceinline__ XcdBarrier xcd_barrier_post(unsigned* bar, volatile LAS unsigned* st) {
    XcdBarrier b; b.bar = bar; b.x = xb_xcc_id(); b.st = st;
    if (threadIdx.x == 0) (void)xb_add(&bar[XB_XCNT(b.x)], 1u);
    return b;
}
__device__ __forceinline__ void xcd_barrier_complete(unsigned* bar, unsigned x, unsigned& nloc, unsigned& nx) {
    const unsigned G = gridDim.x * gridDim.y * gridDim.z;
    unsigned sum, cnt, mine, sp = 0u;
    for (;;) {
        sum = 0u; cnt = 0u; mine = 0u;
#pragma unroll
        for (unsigned j = 0; j < 16; ++j) { const unsigned c = xb_ld(&bar[XB_XCNT(j)]); sum += c; cnt += (c > 0u) ? 1u : 0u; mine = (j == x) ? c : mine; }
        if (sum == G) break;
        __builtin_amdgcn_s_sleep(1);
        if ((++sp & 255u) == 0u) { if (xb_ld(&bar[XB_TMO])) break; if (sp > XB_SPIN_CAP) { atomicAdd(&bar[XB_TMO], 1u); break; } }
    }
    nloc = mine > 0u ? mine : 1u; nx = cnt > 0u ? cnt : 1u;
}

__device__ __forceinline__ void xcd_barrier(const XcdBarrier& b) {
    asm volatile("s_waitcnt vmcnt(0)" ::: "memory");
    __syncthreads();
    if (threadIdx.x == 0) {
        unsigned* bar = b.bar;
        __builtin_amdgcn_s_waitcnt(0);
        unsigned nloc = b.st[0], nx = b.st[1];
        if (nloc == 0u) { xcd_barrier_complete(bar, b.x, nloc, nx); b.st[0] = nloc; b.st[1] = nx; }
        const unsigned old = xb_add(&bar[XB_XSUB(b.x)], 1u);
        const unsigned gen = old / nloc;
        if (old + 1u == (gen + 1u) * nloc) {
            __builtin_amdgcn_fence(__ATOMIC_RELEASE, "agent");
            asm volatile("s_waitcnt vmcnt(0)" ::: "memory");
            const unsigned og = xb_add(&bar[XB_TOP], 1u);
            const unsigned tg = og / nx;
            if (og + 1u == (tg + 1u) * nx) xb_add(&bar[XB_TOPGEN], 1u);
            else XB_SPIN(xb_ld(&bar[XB_TOPGEN]) == tg, bar);
            __builtin_amdgcn_fence(__ATOMIC_ACQUIRE, "agent");
            xb_add(&bar[XB_XGEN(b.x)], 1u);
            asm volatile("s_waitcnt vmcnt(0)" ::: "memory");
        } else {
            XB_SPIN(xb_ld(&bar[XB_XGEN(b.x)]) == gen, bar);
            __builtin_amdgcn_fence(__ATOMIC_ACQUIRE, "agent");
            asm volatile("s_waitcnt vmcnt(0)" ::: "memory");
        }
    }
    __syncthreads();
}

struct Args { const float* in[27]; float* out; unsigned char* ws; int ph_lo, ph_hi, mix_mask, pad; };
enum { I_X = 0, I_NORM_MIX, I_W_IN, I_SG_NORM, I_SG_W, I_SG_B, I_CONV_W, I_QN_C, I_KN_C, I_QN_D, I_KN_D, I_LQ1, I_LK1, I_LQ2, I_LK2, I_SUBLN, I_W_GATE, I_B_GATE, I_W_BRANCH, I_W_OUT,
       I_NORM_FFN, I_W_RG, I_B_RG, I_W_RE, I_B_RE, I_W_UP, I_W_DOWN };

__device__ __forceinline__ int perm_in(int n) {
    const int pn = n >> 8, tc = n & 255, bj = tc >> 7, wc = (tc >> 5) & 3, x = tc & 31;
    if (pn >= 10 && pn < 22) return ZC + (2 * (pn - 10) + (wc >> 1)) * 128 + 64 * bj + 32 * (wc & 1) + x;
    if (pn >= 28 && pn < 32) return ZD + (pn - 28) * 256 + wc * 64 + 32 * bj + x;
    return n;
}
__device__ __forceinline__ void tr_item(const float* colp, size_t ld, bf16_t* WT, int ldk, int n0, int k0, LAS float* scr, int lane) {
#pragma unroll 8
    for (int i = 0; i < 32; ++i) { const int kk = 2 * i + (lane >> 5); scr[kk * 33 + (lane & 31)] = colp[(size_t)(k0 + kk) * ld]; }
    LDS_WAIT(); asm volatile("" ::: "memory");
    const int c = lane & 7;
#pragma unroll
    for (int j = 0; j < 4; ++j) { const int n = (lane >> 3) + 8 * j; const LAS float* s = scr + (8 * c) * 33 + n;
        u32x4 o; o.x = cvt_pk_bf16(s[0 * 33], s[1 * 33]); o.y = cvt_pk_bf16(s[2 * 33], s[3 * 33]); o.z = cvt_pk_bf16(s[4 * 33], s[5 * 33]); o.w = cvt_pk_bf16(s[6 * 33], s[7 * 33]);
        *(u32x4*)(WT + (size_t)(n0 + n) * ldk + k0 + 8 * c) = o; }
    LDS_WAIT(); asm volatile("" ::: "memory");
}
__device__ __forceinline__ void tr_item_fp8(const float* colp, size_t ld, unsigned char* WT, int ldk, int n0, int k0, LAS float* scr, int lane, float scale) {
#pragma unroll 8
    for (int i = 0; i < 32; ++i) { const int kk = 2 * i + (lane >> 5); scr[kk * 33 + (lane & 31)] = colp[(size_t)(k0 + kk) * ld]; }
    LDS_WAIT(); asm volatile("" ::: "memory");
    const int n = lane >> 1, kh = (lane & 1) * 32; const LAS float* s = scr + kh * 33 + n;
    u32x4 o[2];
#pragma unroll
    for (int q = 0; q < 8; ++q) { int p = __builtin_amdgcn_cvt_pk_fp8_f32(s[(4 * q) * 33] * scale, s[(4 * q + 1) * 33] * scale, 0, false); p = __builtin_amdgcn_cvt_pk_fp8_f32(s[(4 * q + 2) * 33] * scale, s[(4 * q + 3) * 33] * scale, p, true); o[q >> 2][q & 3] = (unsigned)p; }
    *(u32x4*)(WT + (size_t)(n0 + n) * ldk + k0 + kh) = o[0]; *(u32x4*)(WT + (size_t)(n0 + n) * ldk + k0 + kh + 16) = o[1];
    LDS_WAIT(); asm volatile("" ::: "memory");
}
struct TrItem { const float* ub; unsigned vo; unsigned char* dst; };
template <bool F8, class F>
__device__ __forceinline__ void tr_loop(const int n, const int gw, const int NGW, const size_t ld, const int ldk  , LAS float* scr, const int lane, F f) {
    int it = __builtin_amdgcn_readfirstlane(gw); if (it >= n) return;
    const int kh = lane >> 5, l32 = lane & 31; const unsigned khb = (unsigned)(kh * ld * 4);
    TrItem cur = f(it);
    float v[32];
#pragma unroll
    for (int i = 0; i < 32; ++i) v[i] = __builtin_nontemporal_load((const float*)((const char*)(cur.ub + (size_t)(2 * i) * ld) + (cur.vo + khb)));
    for (;;) {
#pragma unroll
        for (int i = 0; i < 32; ++i) scr[(2 * i + kh) * 33 + l32] = v[i];
        const int itn = it + NGW; const bool more = itn < n; TrItem nx = cur;
        if (more) { nx = f(itn);
#pragma unroll
            for (int i = 0; i < 32; ++i) v[i] = __builtin_nontemporal_load((const float*)((const char*)(nx.ub + (size_t)(2 * i) * ld) + (nx.vo + khb))); }
        LDS_WAIT(); asm volatile("" ::: "memory");
        if constexpr (F8) {
            const int nn = lane >> 1, k32 = (lane & 1) * 32; const LAS float* s = scr + k32 * 33 + nn;
            u32x4 o[2];
#pragma unroll
            for (int q = 0; q < 8; ++q) { int p = __builtin_amdgcn_cvt_pk_fp8_f32(s[(4 * q) * 33] * 64.f, s[(4 * q + 1) * 33] * 64.f, 0, false); p = __builtin_amdgcn_cvt_pk_fp8_f32(s[(4 * q + 2) * 33] * 64.f, s[(4 * q + 3) * 33] * 64.f, p, true); o[q >> 2][q & 3] = (unsigned)p; }
            unsigned char* d = cur.dst + (size_t)nn * ldk + k32;
            *(u32x4*)d = o[0]; *(u32x4*)(d + 16) = o[1];
        } else {
            const int c = lane & 7;
#pragma unroll
            for (int j = 0; j < 4; ++j) { const int nn = (lane >> 3) + 8 * j; const LAS float* s = scr + (8 * c) * 33 + nn;
                u32x4 o; o.x = cvt_pk_bf16(s[0 * 33], s[1 * 33]); o.y = cvt_pk_bf16(s[2 * 33], s[3 * 33]); o.z = cvt_pk_bf16(s[4 * 33], s[5 * 33]); o.w = cvt_pk_bf16(s[6 * 33], s[7 * 33]);
                *(u32x4*)(cur.dst + (size_t)nn * ldk + 16 * c) = o; }
        }
        LDS_WAIT(); asm volatile("" ::: "memory");
        if (!more) break;
        cur = nx; it = itn;
    }
}
__device__ __forceinline__ void phase_prologue(const Args& a, LAS unsigned char* lds, const int part) {
    const int tid = opaque_tid(), wave = tid >> 6, lane = tid & 63, gw = blockIdx.x * NWAVES + wave, NGW = gridDim.x * NWAVES;
    LAS float* scr = (LAS float*)(lds + wave * 8704);
    const int l32 = lane & 31;
    for (int l = 0; l < 2; ++l) {
        unsigned char* wb = a.ws + WS_W + (size_t)l * W_LAYER;
        if ((l == 0) == (part == 0)) {
            const float* W = a.in[I_W_IN] + (size_t)l * D * WIN; unsigned char* WT = wb + W_IN; const int nblk = WIN / 32;
            if ((MK_Z8 >> l) & 1) tr_loop<true>((D / 64) * nblk, gw, NGW, WIN, D, scr, lane, [=](int it) { const int kb = it / nblk, nb = it % nblk;
                return TrItem{W + (size_t)kb * 64 * WIN, (unsigned)perm_in(nb * 32 + l32) * 4u, WT + (size_t)nb * 32 * D + kb * 64}; });
            else tr_loop<false>((D / 64) * nblk, gw, NGW, WIN, 2 * D, scr, lane, [=](int it) { const int kb = it / nblk, nb = it % nblk;
                return TrItem{W + (size_t)kb * 64 * WIN, (unsigned)perm_in(nb * 32 + l32) * 4u, WT + ((size_t)nb * 32 * D + kb * 64) * 2}; }); }
        if (part == 1) {
            const float* W = a.in[I_W_GATE] + (size_t)l * 4 * D * D; unsigned char* WT = wb + W_G; const int nblk = 8192 / 32;
            tr_loop<true>((D / 64) * nblk, gw, NGW, D, D, scr, lane, [=](int it) { const int kb = it / nblk, nb = it % nblk; const int n = nb * 32 + l32, pn = n >> 8, tc = n & 255;
                const int bj = tc >> 7, wc = (tc >> 5) & 3, fq = (tc >> 3) & 3, nn = (tc >> 2) & 1, j = tc & 3, k = 2 * bj + nn, c = 64 * pn + 16 * wc + 4 * fq + j;
                return TrItem{W + (size_t)kb * 64 * D, (unsigned)(k * D * D + c) * 4u, WT + (size_t)nb * 32 * D + kb * 64}; }); }
        if (part == 1) {
            const float* W = a.in[I_W_BRANCH] + (size_t)l * 4 * 512 * D; unsigned char* WT = wb + W_B; const int nblk = D / 32, per = (512 / 64) * nblk;
            tr_loop<false>(4 * per, gw, NGW, D, 1024, scr, lane, [=](int it) { const int k = it / per, r = it % per, kb = r / nblk, nb = r % nblk;
                return TrItem{W + (size_t)k * 512 * D + nb * 32 + (size_t)kb * 64 * D, (unsigned)l32 * 4u, WT + ((size_t)k * D * 512 + (size_t)nb * 32 * 512 + kb * 64) * 2}; }); }
        if (part == 1) {
            const float* W = a.in[I_W_OUT] + (size_t)l * D * D; unsigned char* WT = wb + W_O; const int nblk = D / 32;
            if (((MK_WO8 >> l) & 1) && !MK_DEBUG) tr_loop<true>((D / 64) * nblk, gw, NGW, D, D, scr, lane, [=](int it) { const int kb = it / nblk, nb = it % nblk;
                return TrItem{W + nb * 32 + (size_t)kb * 64 * D, (unsigned)l32 * 4u, WT + (size_t)nb * 32 * D + kb * 64}; });
            else tr_loop<false>((D / 64) * nblk, gw, NGW, D, 2 * D, scr, lane, [=](int it) { const int kb = it / nblk, nb = it % nblk;
                return TrItem{W + nb * 32 + (size_t)kb * 64 * D, (unsigned)l32 * 4u, WT + ((size_t)nb * 32 * D + kb * 64) * 2}; }); }
        if (part == 1) {
            const float* W = a.in[I_W_UP] + (size_t)l * NEXP * D * 1024; unsigned char* WT = wb + W_UP; const int nblk = 1024 / 32, per = (D / 64) * nblk;
            if (MK_MOE8 && l >= 0) tr_loop<true>(NEXP * per, gw, NGW, 1024, D, scr, lane, [=](int it) { const int e = it / per, r = it % per, kb = r / nblk, nb = r % nblk; const int n = nb * 32 + l32, pn = n >> 8, tc = n & 255;
                const int sc = (tc >> 7) * 512 + 128 * pn + (tc & 127);
                return TrItem{W + (size_t)e * D * 1024 + (size_t)kb * 64 * 1024, (unsigned)sc * 4u, WT + (size_t)e * 1024 * D + (size_t)nb * 32 * D + kb * 64}; });
            else tr_loop<false>(NEXP * per, gw, NGW, 1024, 2 * D, scr, lane, [=](int it) { const int e = it / per, r = it % per, kb = r / nblk, nb = r % nblk; const int n = nb * 32 + l32, pn = n >> 8, tc = n & 255;
                const int sc = (tc >> 7) * 512 + 128 * pn + (tc & 127);
                return TrItem{W + (size_t)e * D * 1024 + (size_t)kb * 64 * 1024, (unsigned)sc * 4u, WT + ((size_t)e * 1024 * D + (size_t)nb * 32 * D + kb * 64) * 2}; }); }
        if (part == 1) {
            const float* W = a.in[I_W_DOWN] + (size_t)l * NEXP * 512 * D; unsigned char* WT = wb + W_DN; const int nblk = D / 32, per = (512 / 64) * nblk;
            if (MK_MOE8 && l >= 0) tr_loop<true>(NEXP * per, gw, NGW, D, 512, scr, lane, [=](int it) { const int e = it / per, r = it % per, kb = r / nblk, nb = r % nblk;
                return TrItem{W + (size_t)e * 512 * D + nb * 32 + (size_t)kb * 64 * D, (unsigned)l32 * 4u, WT + (size_t)e * D * 512 + (size_t)nb * 32 * 512 + kb * 64}; });
            else tr_loop<false>(NEXP * per, gw, NGW, D, 1024, scr, lane, [=](int it) { const int e = it / per, r = it % per, kb = r / nblk, nb = r % nblk;
                return TrItem{W + (size_t)e * 512 * D + nb * 32 + (size_t)kb * 64 * D, (unsigned)l32 * 4u, WT + ((size_t)e * D * 512 + (size_t)nb * 32 * 512 + kb * 64) * 2}; }); }
        if (part == 0) {
            bf16_t* WT = (bf16_t*)(wb + W_R); const float* wrg = a.in[I_W_RG] + (size_t)l * D * 4; const float* wre = a.in[I_W_RE] + (size_t)l * D * 32;
            for (int i = blockIdx.x * NTHR + tid; i < 48 * D; i += gridDim.x * NTHR) { const int n = i / D, k = i % D; float v = 0.f;
                if (n < 4) v = wrg[k * 4 + n]; else if (n < 36) v = wre[k * 32 + (n - 4)];
                WT[i] = (bf16_t)(cvt_pk_bf16(v, 0.f) & 0xffffu); } }
    }
    if (part != 0) return;
    float* cosC = (float*)(a.ws + WS_COSC); float* sinC = (float*)(a.ws + WS_SINC); float* cosD = (float*)(a.ws + WS_COSD); float* sinD = (float*)(a.ws + WS_SIND);
    for (int i = blockIdx.x * NTHR + tid; i < SEQ * 96; i += gridDim.x * NTHR) {
        if (i < SEQ * 64) { const int p = i >> 6, k = i & 63; const float inv = (float)pow(10000.0, -(double)k / 64.0); const float ang = (float)p * inv; double s, c; sincos((double)ang, &s, &c); cosC[i] = (float)c; sinC[i] = (float)s; }
        else { const int q = i - SEQ * 64, p = q >> 5, k = q & 31; const float inv = (float)pow(10000.0, -(double)k / 32.0); const float ang = (float)p * inv; double s, c; sincos((double)ang, &s, &c); cosD[q] = (float)c; sinD[q] = (float)s; }
    }
}
__device__ __forceinline__ void phase_norm(const float* xf, const bf16_t* xb, const bf16_t* y0, const bf16_t* y1, bf16_t* xb_out, float* xf_out, const float* gain, bf16_t* h, unsigned* h8, const bool y8 = false) {
    const int tid = opaque_tid(), wave = tid >> 6, lane = tid & 63, gw = blockIdx.x * NWAVES + wave, NGW = gridDim.x * NWAVES;
    for (int m0 = gw; m0 < T; m0 += 2 * NGW) {
        f32x4 v[2][8];
#pragma unroll
        for (int r = 0; r < 2; ++r) { const int m = m0 + r * NGW; if (m < T) {
            if (xf) { const f32x4* xr = (const f32x4*)(xf + (size_t)m * D) + lane;
#pragma unroll
                for (int j = 0; j < 8; ++j) v[r][j] = __builtin_nontemporal_load(xr + 64 * j); }
            else { const u32x2* xr = (const u32x2*)(xb + (size_t)m * D) + lane;
#pragma unroll
                for (int j = 0; j < 8; ++j) { const u32x2 p = xr[64 * j]; v[r][j] = (f32x4){bf_lo(p.x), bf_hi(p.x), bf_lo(p.y), bf_hi(p.y)}; } } } }
        if (y0) {
#pragma unroll
            for (int r = 0; r < 2; ++r) { const int m = m0 + r * NGW; if (m < T) {
                if (y8) { const unsigned* a0 = (const unsigned*)((const unsigned char*)y0 + (size_t)m * D) + lane; const unsigned* a1 = (const unsigned*)((const unsigned char*)y1 + (size_t)m * D) + lane;
#pragma unroll
                    for (int j = 0; j < 8; ++j) { const int p = (int)__builtin_nontemporal_load(a0 + 64 * j), q = (int)__builtin_nontemporal_load(a1 + 64 * j);
                        v[r][j][0] += (__builtin_amdgcn_cvt_f32_fp8(p, 0) + __builtin_amdgcn_cvt_f32_fp8(q, 0)) * 0.0625f; v[r][j][1] += (__builtin_amdgcn_cvt_f32_fp8(p, 1) + __builtin_amdgcn_cvt_f32_fp8(q, 1)) * 0.0625f;
                        v[r][j][2] += (__builtin_amdgcn_cvt_f32_fp8(p, 2) + __builtin_amdgcn_cvt_f32_fp8(q, 2)) * 0.0625f; v[r][j][3] += (__builtin_amdgcn_cvt_f32_fp8(p, 3) + __builtin_amdgcn_cvt_f32_fp8(q, 3)) * 0.0625f; } }
                else {
                const u32x2* a0 = (const u32x2*)(y0 + (size_t)m * D) + lane; const u32x2* a1 = (const u32x2*)(y1 + (size_t)m * D) + lane;
#pragma unroll
                for (int j = 0; j < 8; ++j) { const u32x2 p = __builtin_nontemporal_load(a0 + 64 * j), q = __builtin_nontemporal_load(a1 + 64 * j);
                    v[r][j][0] += bf_lo(p.x) + bf_lo(q.x); v[r][j][1] += bf_hi(p.x) + bf_hi(q.x); v[r][j][2] += bf_lo(p.y) + bf_lo(q.y); v[r][j][3] += bf_hi(p.y) + bf_hi(q.y); } } } }
        }
        if (xb_out) {
#pragma unroll
            for (int r = 0; r < 2; ++r) { const int m = m0 + r * NGW; if (m < T) { u32x2* xo = (u32x2*)(xb_out + (size_t)m * D) + lane;
#pragma unroll
                for (int j = 0; j < 8; ++j) { u32x2 w; w.x = cvt_pk_bf16(v[r][j][0], v[r][j][1]); w.y = cvt_pk_bf16(v[r][j][2], v[r][j][3]); xo[64 * j] = w; } } }
        }
        if (xf_out) {
#pragma unroll
            for (int r = 0; r < 2; ++r) { const int m = m0 + r * NGW; if (m < T) { f32x4* xo = (f32x4*)(xf_out + (size_t)m * D) + lane;
#pragma unroll
                for (int j = 0; j < 8; ++j) xo[64 * j] = v[r][j]; } }
        }
        if (h || h8) {
#pragma unroll
            for (int r = 0; r < 2; ++r) { const int m = m0 + r * NGW; if (m < T) { float ss = 0.f;
#pragma unroll
                for (int j = 0; j < 8; ++j) ss += (v[r][j][0] * v[r][j][0] + v[r][j][1] * v[r][j][1]) + (v[r][j][2] * v[r][j][2] + v[r][j][3] * v[r][j][3]);
                const float rstd = 1.0f / sqrtf(wave_sum(ss) * (1.0f / D) + EPS);
                u32x2* ho = (u32x2*)(h + (size_t)m * D) + lane; const f32x4* gr = (const f32x4*)gain + lane;
#pragma unroll
                for (int j = 0; j < 8; ++j) { const f32x4 g = gr[64 * j]; const float h0 = v[r][j][0] * rstd * g[0], h1 = v[r][j][1] * rstd * g[1], h2 = v[r][j][2] * rstd * g[2], h3 = v[r][j][3] * rstd * g[3];
                    if (h) { u32x2 w; w.x = cvt_pk_bf16(h0, h1); w.y = cvt_pk_bf16(h2, h3); ho[64 * j] = w; }
                    if (h8) { int p = __builtin_amdgcn_cvt_pk_fp8_f32(h0, h1, 0, false); p = __builtin_amdgcn_cvt_pk_fp8_f32(h2, h3, p, true); h8[(size_t)m * (D / 4) + lane + 64 * j] = (unsigned)p; } } } }
        }
    }
}
__device__ __forceinline__ void mixer_a_unit(const Args& a, int l, int chunk, LAS unsigned char* lds) {
    const int tid = opaque_tid(), wid = tid >> 6, lane = tid & 63, r32 = lane & 31, hi = lane >> 5;
    const bf16_t* Z = (const bf16_t*)(a.ws + WS_Z); bf16_t* Y = (bf16_t*)(a.ws + WS_Y);
    const int t0 = chunk * 128;
    {
        const int j = tid >> 2, g = tid & 3; const bf16_t* vp = Z + (size_t)(t0 + j) * WIN + 512 + g * 128; const float* gn = a.in[I_SG_NORM] + l * 512 + g * 128;
        u32x4 raw[16]; float ss = 0.f;
#pragma unroll
        for (int c = 0; c < 16; ++c) { raw[c] = *(const u32x4*)(vp + c * 8);
#pragma unroll
            for (int q = 0; q < 4; ++q) { const float x0 = bf_lo(raw[c][q]), x1 = bf_hi(raw[c][q]); ss += x0 * x0 + x1 * x1; } }
        ss += __shfl_xor(ss, 1); ss += __shfl_xor(ss, 2);
        const float rstd = 1.0f / sqrtf(ss * (1.0f / 512.0f) + EPS);
        LAS unsigned char* img = lds + g * 32768 + (j >> 6) * 16384;
#pragma unroll
        for (int c = 0; c < 16; ++c) { const f32x4 g0 = *(const f32x4*)(gn + c * 8), g1 = *(const f32x4*)(gn + c * 8 + 4); u32x4 w;
            w.x = cvt_pk_bf16(bf_lo(raw[c].x) * rstd * g0[0], bf_hi(raw[c].x) * rstd * g0[1]); w.y = cvt_pk_bf16(bf_lo(raw[c].y) * rstd * g0[2], bf_hi(raw[c].y) * rstd * g0[3]);
            w.z = cvt_pk_bf16(bf_lo(raw[c].z) * rstd * g1[0], bf_hi(raw[c].z) * rstd * g1[1]); w.w = cvt_pk_bf16(bf_lo(raw[c].w) * rstd * g1[2], bf_hi(raw[c].w) * rstd * g1[3]);
            *(LAS u32x4*)(img + at::v_st(j & 63, c * 8)) = w; }
    }
    __syncthreads();
    f32x16 o2[2][4];
    const int g = wid >> 1;
    { const float* Wg = a.in[I_SG_W] + ((size_t)(l * 4 + g) * 128) * 128;
#pragma unroll
      for (int ibs = 0; ibs < 2; ++ibs) { const int ib = 2 * (wid & 1) + ibs; const int i = 32 * ib + r32;
#pragma unroll
        for (int d = 0; d < 4; ++d)
#pragma unroll
            for (int r = 0; r < 16; ++r) o2[ibs][d][r] = 0.f;
        for (int jt = 0; jt < 2; ++jt) {
            if (64 * jt > 32 * ib + 31) continue;
            bf16x8 pa[4];
#pragma unroll
            for (int ks = 0; ks < 4; ++ks) { const int j0 = 64 * jt + 16 * ks + 8 * hi; const f32x4 w0 = *(const f32x4*)(Wg + (size_t)i * 128 + j0), w1 = *(const f32x4*)(Wg + (size_t)i * 128 + j0 + 4);
                float w[8] = {w0[0], w0[1], w0[2], w0[3], w1[0], w1[1], w1[2], w1[3]};
#pragma unroll
                for (int q = 0; q < 8; ++q) w[q] = (j0 + q <= i) ? w[q] : 0.f;
                u32x4 pk; pk.x = cvt_pk_bf16(w[0], w[1]); pk.y = cvt_pk_bf16(w[2], w[3]); pk.z = cvt_pk_bf16(w[4], w[5]); pk.w = cvt_pk_bf16(w[6], w[7]); pa[ks] = __builtin_bit_cast(bf16x8, pk); }
            const unsigned vb = (unsigned)(size_t)(lds + g * 32768 + jt * 16384) + at::v_rd_base(lane);
            at::pv_d0(o2[ibs], vb, pa[0], pa[1], pa[2], pa[3]);
        }
      } }
    __syncthreads();
    { const float* bs = a.in[I_SG_B] + (l * 4 + g) * 128;
#pragma unroll
      for (int ibs = 0; ibs < 2; ++ibs) { const int ib = 2 * (wid & 1) + ibs;
#pragma unroll
        for (int r = 0; r < 16; ++r) { const int ii = 32 * ib + at::crow(r, hi); const float b = bs[ii];
#pragma unroll
            for (int d = 0; d < 4; ++d) *(LAS bf16_t*)(lds + g * 32768 + ii * 256 + (32 * d + r32) * 2) = (bf16_t)(cvt_pk_bf16(o2[ibs][d][r] + b, 0.f) & 0xffffu); } } }
    __syncthreads();
#pragma unroll 4
    for (int k = 0; k < 16; ++k) { const int chunk = tid + 512 * k, i = chunk >> 6, c8 = (chunk & 63) * 8;
        const u32x4 mx = *(const LAS u32x4*)(lds + (c8 >> 7) * 32768 + i * 256 + (c8 & 127) * 2); const u32x4 uu = *(const u32x4*)(Z + (size_t)(t0 + i) * WIN + c8); u32x4 y;
#pragma unroll
        for (int q = 0; q < 4; ++q) y[q] = cvt_pk_bf16(bf_lo(uu[q]) * bf_lo(mx[q]), bf_hi(uu[q]) * bf_hi(mx[q]));
        *(u32x4*)(Y + (size_t)(t0 + i) * D + c8) = y; }
    __syncthreads();
}
__device__ __forceinline__ void mixer_b(const Args& a, int l) {
    const int tid = opaque_tid(), wave = tid >> 6, lane = tid & 63, gw = blockIdx.x * NWAVES + wave, NGW = gridDim.x * NWAVES;
    const bf16_t* Z = (const bf16_t*)(a.ws + WS_Z); bf16_t* Y = (bf16_t*)(a.ws + WS_Y); const float* cw = a.in[I_CONV_W] + l * 3 * 512; const int c = lane * 8;
    float kw[3][8];
#pragma unroll
    for (int w = 0; w < 3; ++w) { const f32x4 k0 = *(const f32x4*)(cw + w * 512 + c), k1 = *(const f32x4*)(cw + w * 512 + c + 4);
        kw[w][0] = k0[0]; kw[w][1] = k0[1]; kw[w][2] = k0[2]; kw[w][3] = k0[3]; kw[w][4] = k1[0]; kw[w][5] = k1[1]; kw[w][6] = k1[2]; kw[w][7] = k1[3]; }
    for (int blk = gw; blk < T / 8; blk += NGW) { const int t0 = blk * 8; const bool first = (t0 & (SEQ - 1)) == 0;
        const bf16_t* zr = Z + (size_t)t0 * WIN + ZB + c;
        u32x4 cg[10], hb[10], bg[8];
#pragma unroll
        for (int i = 0; i < 10; ++i) { if (i < 2 && first) { cg[i] = (u32x4){0u, 0u, 0u, 0u}; hb[i] = cg[i]; } else { const bf16_t* zz = zr + (ptrdiff_t)(i - 2) * WIN; cg[i] = *(const u32x4*)(zz + 512); hb[i] = *(const u32x4*)(zz + 1024); } }
#pragma unroll
        for (int i = 0; i < 8; ++i) bg[i] = *(const u32x4*)(zr + (size_t)i * WIN);
        float p2[8], p1[8];
#pragma unroll
        for (int q = 0; q < 4; ++q) { p2[2 * q] = bf_lo(cg[0][q]) * bf_lo(hb[0][q]); p2[2 * q + 1] = bf_hi(cg[0][q]) * bf_hi(hb[0][q]); p1[2 * q] = bf_lo(cg[1][q]) * bf_lo(hb[1][q]); p1[2 * q + 1] = bf_hi(cg[1][q]) * bf_hi(hb[1][q]); }
#pragma unroll
        for (int i = 0; i < 8; ++i) { float p0[8]; u32x4 o;
#pragma unroll
            for (int q = 0; q < 4; ++q) { p0[2 * q] = bf_lo(cg[i + 2][q]) * bf_lo(hb[i + 2][q]); p0[2 * q + 1] = bf_hi(cg[i + 2][q]) * bf_hi(hb[i + 2][q]); }
#pragma unroll
            for (int q = 0; q < 4; ++q) { const float y0 = kw[0][2 * q] * p2[2 * q] + kw[1][2 * q] * p1[2 * q] + kw[2][2 * q] * p0[2 * q], y1 = kw[0][2 * q + 1] * p2[2 * q + 1] + kw[1][2 * q + 1] * p1[2 * q + 1] + kw[2][2 * q + 1] * p0[2 * q + 1];
                o[q] = cvt_pk_bf16(bf_lo(bg[i][q]) * y0, bf_hi(bg[i][q]) * y1); }
            *(u32x4*)(Y + (size_t)(t0 + i) * D + 512 + c) = o;
#pragma unroll
            for (int q = 0; q < 8; ++q) { p2[q] = p1[q]; p1[q] = p0[q]; } }
    }
}
__device__ __forceinline__ void mixer_c_unit(const Args& a, int unit, LAS unsigned char* lds) {
    const int tid = opaque_tid(), wid = tid >> 6, lane = tid & 63, r32 = lane & 31, hi = lane >> 5;
    const int sub = unit & 15, h = (unit >> 4) & 3, g = (unit >> 6) % 3, b = unit / 192;
    const int dil = (g == 0) ? 1 : (g == 1 ? 4 : 16); const int r = (g == 0) ? 0 : (g == 1 ? (sub & 3) : sub); const int n2 = (g == 0) ? sub : (g == 1 ? (sub >> 2) : 0);
    const bf16_t* Z = (const bf16_t*)(a.ws + WS_Z);
    at::AttnP P; P.zq = Z + ZC + ((0 * 3 + g) * 4 + h) * 128; P.zk = Z + ZC + ((1 * 3 + g) * 4 + h) * 128; P.zv = Z + ZC + ((2 * 3 + g) * 4 + h) * 128;
    P.tokbase = b * SEQ + r; P.stride = dil; P.q0 = 256 * n2; P.kstart = 256 * n2 - 128; P.NT = 6; P.W = 128;
    f32x16 o[4]; float l_reg, m_reg;
    at::attn_run<128>(P, lds, o, l_reg, m_reg);
    at::attn_normalise(lds, o, l_reg);
    bf16_t* CO = (bf16_t*)(a.ws + WS_CO) + (size_t)g * T * 512; float* LSE = (float*)(a.ws + WS_LSE) + (size_t)g * T * 4;
    const int qw0 = P.q0 + wid * 32;
    if (hi == 0) { const int tok = P.tokbase + (qw0 + r32) * dil; LSE[(size_t)tok * 4 + h] = m_reg * 0.08838834764831845f + __logf(l_reg); }
#pragma unroll
    for (int rr = 0; rr < 16; ++rr) { const size_t tok = (size_t)(P.tokbase + (qw0 + at::crow(rr, hi)) * dil);
#pragma unroll
        for (int d = 0; d < 4; ++d) CO[tok * 512 + h * 128 + 32 * d + r32] = (bf16_t)(cvt_pk_bf16(o[d][rr], 0.f) & 0xffffu); }
    __syncthreads();
}
__device__ __forceinline__ void mixer_c_merge(const Args& a) {
    const bf16_t* CO = (const bf16_t*)(a.ws + WS_CO); const float* LSE = (const float*)(a.ws + WS_LSE); bf16_t* Y = (bf16_t*)(a.ws + WS_Y);
    for (int it = blockIdx.x * NTHR + opaque_tid(); it < T * 64; it += gridDim.x * NTHR) { const int t = it >> 6, c = (it & 63) * 8, h = c >> 7;
        const float l0 = LSE[(size_t)t * 4 + h], l1 = LSE[(size_t)(T + t) * 4 + h], l2 = LSE[(size_t)(2 * T + t) * 4 + h]; const float mx = fmaxf(l0, fmaxf(l1, l2));
        float e0 = __expf(l0 - mx), e1 = __expf(l1 - mx), e2 = __expf(l2 - mx); const float inv = 1.0f / (e0 + e1 + e2); e0 *= inv; e1 *= inv; e2 *= inv;
        const u32x4 a0 = *(const u32x4*)(CO + (size_t)t * 512 + c), a1 = *(const u32x4*)(CO + ((size_t)T + t) * 512 + c), a2 = *(const u32x4*)(CO + ((size_t)2 * T + t) * 512 + c); u32x4 o;
#pragma unroll
        for (int q = 0; q < 4; ++q) o[q] = cvt_pk_bf16(e0 * bf_lo(a0[q]) + e1 * bf_lo(a1[q]) + e2 * bf_lo(a2[q]), e0 * bf_hi(a0[q]) + e1 * bf_hi(a1[q]) + e2 * bf_hi(a2[q]));
        *(u32x4*)(Y + (size_t)t * D + 1024 + c) = o; }
}
__device__ __forceinline__ float diff_lambda(const Args& a, int l, float lam_init) {
    const int lane = opaque_tid() & 63;
    const float s1 = wave_sum(a.in[I_LQ1][l * 64 + lane] * a.in[I_LK1][l * 64 + lane]), s2 = wave_sum(a.in[I_LQ2][l * 64 + lane] * a.in[I_LK2][l * 64 + lane]);
    return expf(s1) - expf(s2) + lam_init;
}
__device__ __forceinline__ void mixer_d_unit(const Args& a, int l, int unit, LAS unsigned char* lds) {
    const int tid = opaque_tid(), wid = tid >> 6, lane = tid & 63, r32 = lane & 31, hi = lane >> 5;
    const int pr = unit & 7, h = (unit >> 3) & 3, b = unit >> 5;
    const float lam_init = (l == 0) ? 0.2f : 0.35550906759096926f;
    const bf16_t* Z = (const bf16_t*)(a.ws + WS_Z); bf16_t* Y = (bf16_t*)(a.ws + WS_Y);
#pragma unroll 1
    for (int it = 0; it < 4; ++it) { const int qb = (it >> 1) ? 15 - pr : pr, map = it & 1;
        at::AttnP P; P.zq = Z + ZD + (h * 2 + map) * 64; P.zk = Z + ZD + 512 + (h * 2 + map) * 64; P.zv = Z + ZD + 1024 + h * 128;
        P.tokbase = b * SEQ; P.stride = 1; P.q0 = 256 * qb; P.kstart = 0; P.NT = 4 * (qb + 1); P.W = 1 << 29;
        f32x16 o[4]; float l_reg, m_reg;
        at::attn_run<64>(P, lds, o, l_reg, m_reg);
        at::attn_normalise(lds, o, l_reg);
        const int qw0 = P.q0 + wid * 32;
        if (map == 0) {
#pragma unroll
            for (int rr = 0; rr < 16; ++rr) { const size_t tok = (size_t)(P.tokbase + qw0 + at::crow(rr, hi));
#pragma unroll
                for (int d = 0; d < 4; ++d) Y[tok * D + 1536 + h * 128 + 32 * d + r32] = (bf16_t)(cvt_pk_bf16(o[d][rr], 0.f) & 0xffffu); }
            VM_WAIT();
        } else {
            const float lam = diff_lambda(a, l, lam_init); const float* sub = a.in[I_SUBLN] + l * 128;
            float sg[4];
#pragma unroll
            for (int d = 0; d < 4; ++d) sg[d] = sub[32 * d + r32] * (1.0f - lam_init);
#pragma unroll
            for (int rr = 0; rr < 16; ++rr) { const size_t tok = (size_t)(P.tokbase + qw0 + at::crow(rr, hi)); float ss = 0.f; float v[4];
#pragma unroll
                for (int d = 0; d < 4; ++d) { const float o1 = bf2f(Y[tok * D + 1536 + h * 128 + 32 * d + r32]); v[d] = o1 - lam * o[d][rr]; ss += v[d] * v[d]; }
                ss += __shfl_xor(ss, 1); ss += __shfl_xor(ss, 2); ss += __shfl_xor(ss, 4); ss += __shfl_xor(ss, 8); ss += __shfl_xor(ss, 16);
                const float rstd = 1.0f / sqrtf(ss * (1.0f / 128.0f) + EPS);
#pragma unroll
                for (int d = 0; d < 4; ++d) Y[tok * D + 1536 + h * 128 + 32 * d + r32] = (bf16_t)(cvt_pk_bf16(v[d] * rstd * sg[d], 0.f) & 0xffffu); }
        }
    }
}
__device__ __forceinline__ void phase_route(const Args& a, int l, LAS unsigned char* lds) {
    const int tid = opaque_tid(), wave = tid >> 6, lane = tid & 63, gw = blockIdx.x * NWAVES + wave, NGW = gridDim.x * NWAVES;
    const bf16_t* X = (const bf16_t*)(a.ws + WS_XB); bf16_t* H = (bf16_t*)(a.ws + WS_H); const bf16_t* WR = (const bf16_t*)(a.ws + WS_W + (size_t)l * W_LAYER + W_R);
    const float* gain = a.in[I_NORM_FFN] + l * D; const float* brg = a.in[I_B_RG] + l * 4; const float* bre = a.in[I_B_RE] + l * 32;
    unsigned* cnt = (unsigned*)(a.ws + WS_CTL) + CW_CNT + l * 32; u32x4* list = (u32x4*)(a.ws + WS_LIST); u32x4* route = (u32x4*)(a.ws + WS_ROUTE);
    LAS float* lg = (LAS float*)(lds + wave * 3072);
    const int rw = lane & 15, kg = lane >> 4;
    for (int grp = gw; grp < T / 16; grp += NGW) { const int row = grp * 16 + rw; const bf16_t* xr = X + (size_t)row * D + 8 * kg; bf16_t* hr = H + (size_t)row * D + 8 * kg; unsigned char* h8r = a.ws + WS_H8 + (size_t)row * D + 8 * kg;
        f32x4 acc[3];
#pragma unroll
        for (int nb = 0; nb < 3; ++nb) acc[nb] = (f32x4){0.f, 0.f, 0.f, 0.f};
        float ss = 0.f;
#pragma unroll 8
        for (int k0 = 0; k0 < D; k0 += 32) { const u32x4 xr4 = *(const u32x4*)(xr + k0); const f32x4 x0 = (f32x4){bf_lo(xr4.x), bf_hi(xr4.x), bf_lo(xr4.y), bf_hi(xr4.y)}, x1 = (f32x4){bf_lo(xr4.z), bf_hi(xr4.z), bf_lo(xr4.w), bf_hi(xr4.w)}; const f32x4 g0 = *(const f32x4*)(gain + k0 + 8 * kg), g1 = *(const f32x4*)(gain + k0 + 8 * kg + 4);
            ss += (x0[0] * x0[0] + x0[1] * x0[1]) + (x0[2] * x0[2] + x0[3] * x0[3]) + (x1[0] * x1[0] + x1[1] * x1[1]) + (x1[2] * x1[2] + x1[3] * x1[3]);
            u32x4 pk; pk.x = cvt_pk_bf16(x0[0] * g0[0], x0[1] * g0[1]); pk.y = cvt_pk_bf16(x0[2] * g0[2], x0[3] * g0[3]); pk.z = cvt_pk_bf16(x1[0] * g1[0], x1[1] * g1[1]); pk.w = cvt_pk_bf16(x1[2] * g1[2], x1[3] * g1[3]);
            if (MK_MOE8 && l >= 0) { int p0 = __builtin_amdgcn_cvt_pk_fp8_f32(x0[0] * g0[0], x0[1] * g0[1], 0, false); p0 = __builtin_amdgcn_cvt_pk_fp8_f32(x0[2] * g0[2], x0[3] * g0[3], p0, true);
                int p1 = __builtin_amdgcn_cvt_pk_fp8_f32(x1[0] * g1[0], x1[1] * g1[1], 0, false); p1 = __builtin_amdgcn_cvt_pk_fp8_f32(x1[2] * g1[2], x1[3] * g1[3], p1, true);
                *(u32x2*)(h8r + k0) = (u32x2){(unsigned)p0, (unsigned)p1}; }
            else *(u32x4*)(hr + k0) = pk;
            const bf16x8 af = __builtin_bit_cast(bf16x8, pk);
#pragma unroll
            for (int nb = 0; nb < 3; ++nb) { const bf16x8 bfr = *(const bf16x8*)(WR + (size_t)(16 * nb + rw) * D + k0 + 8 * kg); acc[nb] = __builtin_amdgcn_mfma_f32_16x16x32_bf16(af, bfr, acc[nb], 0, 0, 0); } }
        ss += __shfl_xor(ss, 16); ss += __shfl_xor(ss, 32);
        const float rstd = 1.0f / sqrtf(ss * (1.0f / D) + EPS);
#pragma unroll
        for (int nb = 0; nb < 3; ++nb)
#pragma unroll
            for (int rg = 0; rg < 4; ++rg) lg[(4 * kg + rg) * 48 + 16 * nb + rw] = acc[nb][rg];
        LDS_WAIT();
        if (lane < 16) { const LAS float* lr = lg + lane * 48;
            float gl[4]; int gi = 0; float gmx = -1e30f;
#pragma unroll
            for (int i = 0; i < 4; ++i) { gl[i] = lr[i] * rstd + brg[i]; if (gl[i] > gmx) { gmx = gl[i]; gi = i; } }
            float gs = 0.f;
#pragma unroll
            for (int i = 0; i < 4; ++i) gs += __expf(gl[i] - gmx);
            const float gp = 1.0f / gs;
            float v1 = -1e30f, v2 = -1e30f; int i1 = 0, i2 = 0;
            for (int i = 0; i < 8; ++i) { const float v = lr[4 + 8 * gi + i] * rstd + bre[8 * gi + i];
                if (v > v1) { v2 = v1; i2 = i1; v1 = v; i1 = i; } else if (v > v2) { v2 = v; i2 = i; } }
            const float ex = __expf(v2 - v1); const float w1 = gp / (1.0f + ex), w2 = gp * ex / (1.0f + ex);
            const int e1 = gi * 8 + i1, e2 = gi * 8 + i2;
            if (!(a.mix_mask & 16)) {
            const unsigned p1 = atomicAdd(cnt + e1, 1u), p2 = atomicAdd(cnt + e2, 1u);
            list[(size_t)e1 * T + p1] = (u32x4){(unsigned)row, __float_as_uint(w1), __float_as_uint(rstd), 0u};
            list[(size_t)e2 * T + p2] = (u32x4){(unsigned)row | 0x10000u, __float_as_uint(w2), __float_as_uint(rstd), 0u}; }
            route[row] = (u32x4){(unsigned)e1, (unsigned)e2, __float_as_uint(w1), __float_as_uint(w2)};
        }
        LDS_WAIT();
    }
}
__device__ __forceinline__ void moe_tables(const Args& a, int l, LAS unsigned char* lds) {
    LAS int* tab = (LAS int*)(lds + gm::TAB_OFF); const unsigned* cnt = (const unsigned*)(a.ws + WS_CTL) + CW_CNT + l * 32;
    if (threadIdx.x == 0) { int off = 0; for (int e = 0; e < 32; ++e) { const int c = (int)__hip_atomic_load(cnt + e, __ATOMIC_RELAXED, __HIP_MEMORY_SCOPE_AGENT); tab[e] = off; tab[40 + e] = c; off += (c + 255) >> 8; } tab[32] = off; }
    __syncthreads();
}
__device__ __forceinline__ void phase_final(const Args& a) { phase_norm(nullptr, (const bf16_t*)(a.ws + WS_XB), (const bf16_t*)(a.ws + WS_Y0), (const bf16_t*)(a.ws + WS_Y1), nullptr, a.out, nullptr, nullptr, nullptr, MK_Y8 && !MK_DEBUG); }

constexpr int PH_PER_LAYER = 10, N_PHASES = 2 + 2 * PH_PER_LAYER;
template <int l> __device__ __forceinline__ void layer_phases(const Args& a, LAS unsigned char* lds, const int lo, const int hi, const XcdBarrier& bar) {
#define IN(k) (lo <= (k) && (k) < hi)
#define SEAM(k) do { if (IN(k) && IN((k) + 1)) xcd_barrier(bar); } while (0)
    {
        const int pb = 1 + l * PH_PER_LAYER;
        unsigned char* wb = a.ws + WS_W + (size_t)l * W_LAYER;
        bf16_t* H = (bf16_t*)(a.ws + WS_H); bf16_t* Z = (bf16_t*)(a.ws + WS_Z); bf16_t* Y = (bf16_t*)(a.ws + WS_Y);
        if (IN(pb + 0)) {
            if (l == 0) phase_norm(a.in[I_X], nullptr, nullptr, nullptr, nullptr, nullptr, a.in[I_NORM_MIX], H, (unsigned*)(a.ws + WS_H8));
            else phase_norm(nullptr, (const bf16_t*)(a.ws + WS_XB), (const bf16_t*)(a.ws + WS_Y0), (const bf16_t*)(a.ws + WS_Y1), (bf16_t*)(a.ws + WS_XB), nullptr, a.in[I_NORM_MIX] + D, ((MK_Z8 >> 1) & 1) && !MK_DEBUG ? nullptr : H, (unsigned*)(a.ws + WS_H8));
        }
        SEAM(pb + 0);
        if (IN(pb + 1)) {
            gm::Desc g{H, wb + W_IN, 2 * D, 2 * D, 2 * D}; if ((MK_Z8 >> l) & 1) g = gm::Desc{a.ws + WS_H8, wb + W_IN, D, D, D, 121, 127}; gm::StaticOrder S; S.init(T, WIN, gridDim.x, blockIdx.x);
            gm::EpiZ E{Z, a.in[I_QN_C] + l * 128, a.in[I_KN_C] + l * 128, a.in[I_QN_D] + l * 64, a.in[I_KN_D] + l * 64,
                       (const float*)(a.ws + WS_COSC), (const float*)(a.ws + WS_SINC), (const float*)(a.ws + WS_COSD), (const float*)(a.ws + WS_SIND)};
            if constexpr (l == 0) {
                const int split = (int)((blockIdx.x * 17u) >> 8);
#pragma unroll 1
                for (int seg = 0; seg < 2; ++seg) {
                    S.i0 = seg ? split : 0; S.iend = seg ? (1 << 30) : split;
                    if constexpr ((MK_Z8 >> l) & 1) gm::gemm_phase<true>(lds, g, S, E); else gm::gemm_phase(lds, g, S, E);
                    if (seg == 0) { __syncthreads(); phase_prologue(a, lds, 1); __syncthreads(); }
                }
            } else {
                if constexpr ((MK_Z8 >> l) & 1) gm::gemm_phase<true>(lds, g, S, E); else gm::gemm_phase(lds, g, S, E);
            }
        }
        SEAM(pb + 1);
        if (IN(pb + 2)) {
            const int vbx = (gridDim.x == 256) ? (int)((blockIdx.x & 7) * 32 + (blockIdx.x >> 3)) : (int)blockIdx.x;
            if (a.mix_mask & 1) for (int u = vbx; u < 256; u += gridDim.x) mixer_d_unit(a, l, u, lds);
            if (a.mix_mask & 2) for (int u = vbx; u < 1536; u += gridDim.x) mixer_c_unit(a, u, lds);
            if (a.mix_mask & 4) for (int u = blockIdx.x; u < T / 128; u += gridDim.x) mixer_a_unit(a, l, u, lds);
            if (a.mix_mask & 8) mixer_b(a, l);
        }
        SEAM(pb + 2);
        if (IN(pb + 3)) mixer_c_merge(a);
        SEAM(pb + 3);
        if (IN(pb + 4)) {
            gm::Desc g{Y, wb + W_B, 2 * D, 1024, 1024}; gm::BranchOrder S; S.init(T, 8192, gridDim.x, blockIdx.x);
            gm::EpiBf16 E{Z, 8192};
            gm::gemm_phase(lds, g, S, E);
        }
        SEAM(pb + 4);
        if (IN(pb + 5)) {
            gm::Desc g{a.ws + WS_H8, wb + W_G, D, D, D};     gm::StaticOrder S; S.init(T, 8192, gridDim.x, blockIdx.x);
            gm::EpiGateT<((MK_WO8 >> l) & 1) && !MK_DEBUG> E{Y, Z, a.in[I_B_GATE] + (size_t)l * 4 * D};
            gm::gemm_phase<true>(lds, g, S, E);
        }
        SEAM(pb + 5);
        if (IN(pb + 6)) {
            gm::Desc g{Y, wb + W_O, 2 * D, 2 * D, 2 * D}; if (((MK_WO8 >> l) & 1) && !MK_DEBUG) g = gm::Desc{Y, wb + W_O, D, D, D, 121, 127}; gm::StaticOrder S; S.init(T, D, gridDim.x, blockIdx.x);
            gm::EpiResid E{l == 0 ? a.in[I_X] : nullptr, (bf16_t*)(a.ws + WS_XB)};
            if constexpr (((MK_WO8 >> l) & 1) && !MK_DEBUG) gm::gemm_phase<true>(lds, g, S, E); else gm::gemm_phase(lds, g, S, E);
        }
        SEAM(pb + 6);
        if (IN(pb + 7)) phase_route(a, l, lds);
        SEAM(pb + 7);
        if (IN(pb + 8)) {
            moe_tables(a, l, lds);
            gm::Desc g{H, wb + W_UP, 2 * D, 2 * D, 2 * D}; if (MK_MOE8 && l >= 0) g = gm::Desc{a.ws + WS_H8, wb + W_UP, D, D, D, 121, 127}; gm::MoeUpOrder S; S.nN = 4; S.G = gridDim.x; S.c = blockIdx.x; S.tab = (LAS const int*)(lds + gm::TAB_OFF); S.list = (const u32x4*)(a.ws + WS_LIST); S.nexp_rows = 1024;
            if constexpr (MK_MOE8 && l >= 0) { gm::EpiUpT<true> E{a.ws + WS_HID, (const u32x4*)(a.ws + WS_LIST)}; gm::gemm_phase<true>(lds, g, S, E); }
            else { gm::EpiUpT<false> E{a.ws + WS_HID, (const u32x4*)(a.ws + WS_LIST)}; gm::gemm_phase(lds, g, S, E); }
        }
        SEAM(pb + 8);
        if (IN(pb + 9)) {
            moe_tables(a, l, lds);
            gm::Desc g{a.ws + WS_HID, wb + W_DN, 1024, 1024, 1024}; if (MK_MOE8 && l >= 0) g = gm::Desc{a.ws + WS_HID, wb + W_DN, 512, 512, 512, 121, 123}; gm::MoeDownOrder S; S.nN = 8; S.G = gridDim.x; S.c = blockIdx.x; S.tab = (LAS const int*)(lds + gm::TAB_OFF); S.list = (const u32x4*)(a.ws + WS_LIST); S.nexp_rows = 2048;
            gm::EpiDownT<(MK_Y8 && l == 1 && !MK_DEBUG)> E{a.ws + WS_Y0, a.ws + WS_Y1, (const u32x4*)(a.ws + WS_LIST)};
            if constexpr (MK_MOE8 && l >= 0) gm::gemm_phase<true>(lds, g, S, E); else gm::gemm_phase(lds, g, S, E);
        }
        SEAM(pb + 9);
    }
#undef SEAM
#undef IN
}
constexpr int MISC_OFF = 143360;
__global__ void __launch_bounds__(NTHR, 2) mk_fwd(Args a) {
    extern __shared__ __attribute__((aligned(16))) unsigned char lds_raw[];
    LAS unsigned char* lds = (LAS unsigned char*)lds_raw;
    const int lo = a.ph_lo, hi = a.ph_hi;
    volatile LAS unsigned* misc = (volatile LAS unsigned*)(lds + MISC_OFF);
    if (threadIdx.x < 4) misc[threadIdx.x] = 0u;
    __syncthreads();
    XcdBarrier bar; bar.bar = (unsigned*)(a.ws + WS_CTL) + CW_BAR; bar.x = 0; bar.st = misc;
    if (hi - lo > 1) bar = xcd_barrier_post((unsigned*)(a.ws + WS_CTL) + CW_BAR, misc);
    if (lo <= 0 && 0 < hi) phase_prologue(a, lds, 0);
    layer_phases<0>(a, lds, lo, hi, bar);
    layer_phases<1>(a, lds, lo, hi, bar);
    if (lo <= N_PHASES - 1 && N_PHASES - 1 < hi) phase_final(a);
#if MK_XPROBE
    if (lo <= 50 && 50 < hi) {
        unsigned char* wb = a.ws + WS_W;
        gm::Desc g{a.ws + WS_H, wb + MK_XPROBE_W, 2 * D, 2 * MK_XPROBE_K, 2 * MK_XPROBE_K}; gm::StaticOrder S; S.init(T, MK_XPROBE_N, gridDim.x, blockIdx.x);
        gm::EpiProbe E{(float*)(a.ws + WS_CO)};
        gm::gemm_phase(lds, g, S, E);
    }
#endif
}

#if MK_DEBUG
__device__ __forceinline__ void diag_put(unsigned char* ws, int stage, float err, float ref, float rel, float absf) {
    float ratio = fabsf(err) / (rel * fabsf(ref) + absf); if (!(ratio == ratio) || !(fabsf(err) < 1e30f)) ratio = 1e9f;
    atomicMax((unsigned*)(ws + WS_CTL) + CW_DIAG + stage, __float_as_uint(ratio));
}
__device__ __forceinline__ unsigned hash_u(unsigned x) { x ^= x >> 16; x *= 0x7feb352du; x ^= x >> 15; x *= 0x846ca68bu; x ^= x >> 16; return x; }
__global__ void ck_h(Args a, int l, int stage) {
    const int row = hash_u(blockIdx.x * 7 + 1) % T; const float* g = a.in[I_NORM_MIX] + l * D; const bf16_t* h = (const bf16_t*)(a.ws + WS_H) + (size_t)row * D;
#define CKX(c) (l == 0 ? a.in[I_X][(size_t)row * D + (c)] : bf2f(((const bf16_t*)(a.ws + WS_XB))[(size_t)row * D + (c)]))
    float ss = 0.f; for (int c = threadIdx.x; c < D; c += 64) ss += CKX(c) * CKX(c); ss = wave_sum(ss); const float rstd = 1.0f / sqrtf(ss / D + EPS);
    for (int c = threadIdx.x; c < D; c += 64) { const float ref = CKX(c) * rstd * g[c]; diag_put(a.ws, stage, bf2f(h[c]) - ref, ref, 0.01f, 0.01f); }
#undef CKX
}
__device__ float dot_hw(const bf16_t* hrow, const float* W, size_t ld, int K) { float s = 0.f; for (int k = 0; k < K; ++k) s += bf2f(hrow[k]) * W[(size_t)k * ld]; return s; }
__global__ void ck_z_ident(Args a, int l, int stage) {
    const unsigned hsh = hash_u(blockIdx.x * 64 + threadIdx.x + 77); const int row = hsh % T; int col; { const unsigned q = hash_u(hsh + 5) % 4096; col = q < 2560 ? q : (q < 3328 ? ZC + 3072 + (q - 2560) * 2 : ZD + 1024 + (q - 3328) % 512); }
    const bf16_t* h = (const bf16_t*)(a.ws + WS_H) + (size_t)row * D; float ref = dot_hw(h, a.in[I_W_IN] + (size_t)l * D * WIN + col, WIN, D);
    if (col < 1024) { const float u = 0.7978845608028654f * (ref + 0.044715f * ref * ref * ref); ref = 0.5f * ref * (1.0f + tanhf(u)); }
    diag_put(a.ws, stage, bf2f(((const bf16_t*)(a.ws + WS_Z))[(size_t)row * WIN + col]) - ref, ref, 0.02f, 0.02f);
}
__global__ void ck_z_qk(Args a, int l, int stage, int isD) {
    __shared__ float v[128]; __shared__ float ssum;
    const unsigned hsh = hash_u(blockIdx.x + 1234 + isD * 999); const int row = hsh % T; const int nd = isD ? 64 : 128; const int grp = hash_u(hsh + 3) % (isD ? 16 : 24);
    const int d = threadIdx.x; const int colbase = isD ? ZD + grp * 64 : ZC + grp * 128;
    const bf16_t* h = (const bf16_t*)(a.ws + WS_H) + (size_t)row * D;
    if (d < nd) v[d] = dot_hw(h, a.in[I_W_IN] + (size_t)l * D * WIN + colbase + d, WIN, D);
    __syncthreads();
    if (d == 0) { float s = 0.f; for (int i = 0; i < nd; ++i) s += v[i] * v[i]; ssum = s; }
    __syncthreads();
    if (d < nd) { const float rstd = 1.0f / sqrtf(ssum / nd + EPS); const float* gn = isD ? ((grp >= 8 ? a.in[I_KN_D] : a.in[I_QN_D]) + l * 64) : ((grp >= 12 ? a.in[I_KN_C] : a.in[I_QN_C]) + l * 128);
        const int half = nd / 2, i = d % half; const float inv = powf(10000.0f, -(float)i / (float)half); const float ang = (float)(row % SEQ) * inv; const float cs = cosf(ang), sn = sinf(ang);
        const float x1 = v[i] * rstd * gn[i], x2 = v[i + half] * rstd * gn[i + half]; const float ref = (d < half) ? (x1 * cs - x2 * sn) : (x2 * cs + x1 * sn);
        diag_put(a.ws, stage, bf2f(((const bf16_t*)(a.ws + WS_Z))[(size_t)row * WIN + colbase + d]) - ref, ref, 0.02f, 0.03f); }
}
__global__ void ck_ya(Args a, int l, int stage) {
    __shared__ float rstd[128];
    const unsigned hsh = hash_u(blockIdx.x + 4321); const int chunk = hsh % (T / 128), i = (blockIdx.x < 4) ? (blockIdx.x * 42 + 1) % 128 : hash_u(hsh + 1) % 128, g = hash_u(hsh + 2) % 4; const int c = threadIdx.x; const int t0 = chunk * 128;
    const bf16_t* Z = (const bf16_t*)(a.ws + WS_Z);
    { float s = 0.f; const bf16_t* vr = Z + (size_t)(t0 + c) * WIN + 512; for (int k = 0; k < 512; ++k) s += bf2f(vr[k]) * bf2f(vr[k]); rstd[c] = 1.0f / sqrtf(s / 512.f + EPS); }
    __syncthreads();
    const float gn = a.in[I_SG_NORM][l * 512 + g * 128 + c]; const float* W = a.in[I_SG_W] + ((size_t)(l * 4 + g) * 128 + i) * 128; float mix = 0.f;
    for (int j = 0; j <= i; ++j) mix += W[j] * bf2f(Z[(size_t)(t0 + j) * WIN + 512 + g * 128 + c]) * rstd[j] * gn;
    mix += a.in[I_SG_B][(l * 4 + g) * 128 + i];
    const float ref = bf2f(Z[(size_t)(t0 + i) * WIN + g * 128 + c]) * mix;
    diag_put(a.ws, stage, bf2f(((const bf16_t*)(a.ws + WS_Y))[(size_t)(t0 + i) * D + g * 128 + c]) - ref, ref, 0.03f, 0.03f);
}
__global__ void ck_yb(Args a, int l, int stage) {
    const unsigned hsh = hash_u(blockIdx.x * 64 + threadIdx.x + 99); int t = hsh % T; if (threadIdx.x < 4) t = (t & ~(SEQ - 1)) + threadIdx.x; const int c = hash_u(hsh + 1) % 512, s = t % SEQ; const bf16_t* Z = (const bf16_t*)(a.ws + WS_Z);
    float acc = 0.f; for (int w = 0; w < 3; ++w) { const int back = 2 - w; if (s - back < 0) continue; const bf16_t* zr = Z + (size_t)(t - back) * WIN + ZB; acc += a.in[I_CONV_W][l * 1536 + w * 512 + c] * bf2f(zr[512 + c]) * bf2f(zr[1024 + c]); }
    const float ref = bf2f(Z[(size_t)t * WIN + ZB + c]) * acc;
    diag_put(a.ws, stage, bf2f(((const bf16_t*)(a.ws + WS_Y))[(size_t)t * D + 512 + c]) - ref, ref, 0.02f, 0.02f);
}
__global__ void ck_yc(Args a, int l, int stage) {
    __shared__ float sc[132]; __shared__ float red[2]; __shared__ float og[3][128]; __shared__ float lse[3];
    const unsigned hsh = hash_u(blockIdx.x + 555); int t = hsh % T; if (blockIdx.x < 6) t = (t & ~(SEQ - 1)) + blockIdx.x * 37; const int j = hash_u(hsh + 1) % 4; const int s = t % SEQ, d = threadIdx.x; const bf16_t* Z = (const bf16_t*)(a.ws + WS_Z);
    for (int g = 0; g < 3; ++g) { const int dil = g == 0 ? 1 : (g == 1 ? 4 : 16);
        const bf16_t* q = Z + (size_t)t * WIN + ZC + ((0 * 3 + g) * 4 + j) * 128;
        for (int kk = d; kk < 129; kk += 128) { const int sk = s - kk * dil; float v = -1e30f; if (sk >= 0) { const bf16_t* kp = Z + (size_t)(t - kk * dil) * WIN + ZC + ((1 * 3 + g) * 4 + j) * 128; float dd = 0.f; for (int e = 0; e < 128; ++e) dd += bf2f(q[e]) * bf2f(kp[e]); v = dd * 0.08838834764831845f; } sc[kk] = v; }
        __syncthreads();
        if (d == 0) { float mx = -1e30f; for (int kk = 0; kk < 129; ++kk) mx = fmaxf(mx, sc[kk]); float sm = 0.f; for (int kk = 0; kk < 129; ++kk) sm += (sc[kk] > -1e29f) ? expf(sc[kk] - mx) : 0.f; red[0] = mx; red[1] = sm; lse[g] = mx + logf(sm); }
        __syncthreads();
        float o = 0.f; for (int kk = 0; kk < 129; ++kk) { if (sc[kk] > -1e29f) o += expf(sc[kk] - red[0]) / red[1] * bf2f(Z[(size_t)(t - kk * dil) * WIN + ZC + ((2 * 3 + g) * 4 + j) * 128 + d]); }
        og[g][d] = o; __syncthreads(); }
    const float mx = fmaxf(lse[0], fmaxf(lse[1], lse[2])); const float e0 = expf(lse[0] - mx), e1 = expf(lse[1] - mx), e2 = expf(lse[2] - mx); const float ref = (e0 * og[0][d] + e1 * og[1][d] + e2 * og[2][d]) / (e0 + e1 + e2);
    diag_put(a.ws, stage, bf2f(((const bf16_t*)(a.ws + WS_Y))[(size_t)t * D + 1024 + j * 128 + d]) - ref, ref, 0.03f, 0.02f);
}
__global__ void ck_yd(Args a, int l, int stage) {
    __shared__ float sc[SEQ]; __shared__ float red[256]; __shared__ float o1s[128];
    const unsigned hsh = hash_u(blockIdx.x + 888); const int b = hsh % NB, h = hash_u(hsh + 1) % 4; int s = hash_u(hsh + 2) % SEQ; if (blockIdx.x < 8) { const int sp[8] = {0, 1, 31, 255, 256, 2047, 2048, 4095}; s = sp[blockIdx.x]; }
    const int d = threadIdx.x, t = b * SEQ + s; const bf16_t* Z = (const bf16_t*)(a.ws + WS_Z);
    const float lam_init = (l == 0) ? 0.2f : 0.35550906759096926f; float s1 = 0.f, s2 = 0.f; for (int i = 0; i < 64; ++i) { s1 += a.in[I_LQ1][l * 64 + i] * a.in[I_LK1][l * 64 + i]; s2 += a.in[I_LQ2][l * 64 + i] * a.in[I_LK2][l * 64 + i]; }
    const float lam = expf(s1) - expf(s2) + lam_init; float outv = 0.f;
    for (int map = 0; map < 2; ++map) { const bf16_t* q = Z + (size_t)t * WIN + ZD + (h * 2 + map) * 64;
        for (int k = d; k <= s; k += 128) { const bf16_t* kp = Z + (size_t)(b * SEQ + k) * WIN + ZD + 512 + (h * 2 + map) * 64; float dd = 0.f; for (int e = 0; e < 64; ++e) dd += bf2f(q[e]) * bf2f(kp[e]); sc[k] = dd * 0.125f; }
        __syncthreads();
        float mx = -1e30f; for (int k = d; k <= s; k += 128) mx = fmaxf(mx, sc[k]); red[d] = mx; __syncthreads(); if (d == 0) { float m = -1e30f; for (int i = 0; i < 128; ++i) m = fmaxf(m, red[i]); red[128] = m; } __syncthreads(); mx = red[128];
        float sm = 0.f; for (int k = d; k <= s; k += 128) sm += expf(sc[k] - mx); __syncthreads(); red[d] = sm; __syncthreads(); if (d == 0) { float m = 0.f; for (int i = 0; i < 128; ++i) m += red[i]; red[129] = m; } __syncthreads(); sm = red[129];
        float o = 0.f; for (int k = 0; k <= s; ++k) o += expf(sc[k] - mx) / sm * bf2f(Z[(size_t)(b * SEQ + k) * WIN + ZD + 1024 + h * 128 + d]);
        if (map == 0) outv = o; else outv -= lam * o; __syncthreads(); }
    o1s[d] = outv * outv; __syncthreads(); if (d == 0) { float m = 0.f; for (int i = 0; i < 128; ++i) m += o1s[i]; red[130] = m; } __syncthreads();
    const float ref = outv / sqrtf(red[130] / 128.f + EPS) * a.in[I_SUBLN][l * 128 + d] * (1.0f - lam_init);
    diag_put(a.ws, stage, bf2f(((const bf16_t*)(a.ws + WS_Y))[(size_t)t * D + 1536 + h * 128 + d]) - ref, ref, 0.04f, 0.04f);
}
__global__ void ck_p(Args a, int l, int stage) {
    const unsigned hsh = hash_u(blockIdx.x * 64 + threadIdx.x + 31337); const int t = hsh % T, k = hash_u(hsh + 1) % 4, c = hash_u(hsh + 2) % D; const bf16_t* y = (const bf16_t*)(a.ws + WS_Y) + (size_t)t * D + 512 * k;
    const float ref = dot_hw(y, a.in[I_W_BRANCH] + ((size_t)(l * 4 + k) * 512) * D + c, D, 512);
    diag_put(a.ws, stage, bf2f(((const bf16_t*)(a.ws + WS_Z))[(size_t)t * 8192 + k * D + c]) - ref, ref, 0.02f, 0.02f);
}
__global__ void ck_merged(Args a, int l, int stage) {
    const unsigned hsh = hash_u(blockIdx.x * 64 + threadIdx.x + 4242); const int t = hsh % T, c = hash_u(hsh + 2) % D; const bf16_t* h = (const bf16_t*)(a.ws + WS_H) + (size_t)t * D; float ref = 0.f;
    for (int k = 0; k < 4; ++k) { const float gl = dot_hw(h, a.in[I_W_GATE] + ((size_t)(l * 4 + k) * D) * D + c, D, D) + a.in[I_B_GATE][(l * 4 + k) * D + c]; ref += 1.0f / (1.0f + expf(-gl)) * bf2f(((const bf16_t*)(a.ws + WS_Z))[(size_t)t * 8192 + k * D + c]); }
    diag_put(a.ws, stage, bf2f(((const bf16_t*)(a.ws + WS_Y))[(size_t)t * D + c]) - ref, ref, 0.05f, 0.12f);
}
__global__ void ck_x1(Args a, int l, int stage) {
    const unsigned hsh = hash_u(blockIdx.x * 64 + threadIdx.x + 777); const int t = hsh % T, c = hash_u(hsh + 2) % D; const bf16_t* mg = (const bf16_t*)(a.ws + WS_Y) + (size_t)t * D;
    const float ref = a.in[I_X][(size_t)t * D + c] + dot_hw(mg, a.in[I_W_OUT] + (size_t)l * D * D + c, D, D);
    diag_put(a.ws, stage, bf2f(((const bf16_t*)(a.ws + WS_XB))[(size_t)t * D + c]) - ref, ref, 0.01f, 0.02f);
}
__global__ void ck_route(Args a, int l, int stage) {
    __shared__ float lg[36];
    const int t = hash_u(blockIdx.x + 9091) % T, lane = threadIdx.x; const bf16_t* xb_ = (const bf16_t*)(a.ws + WS_XB) + (size_t)t * D; const float* g = a.in[I_NORM_FFN] + l * D;
#define x(c) bf2f(xb_[c])
    float ss = 0.f; for (int c = lane; c < D; c += 64) ss += x(c) * x(c); ss = wave_sum(ss); const float rstd = 1.0f / sqrtf(ss / D + EPS);
    const bf16_t* h2 = (const bf16_t*)(a.ws + WS_H) + (size_t)t * D;
    if (!(MK_MOE8 && l >= 0)) for (int c = lane; c < D; c += 64) { const float ref = x(c) * g[c]; diag_put(a.ws, stage, bf2f(h2[c]) - ref, ref, 0.01f, 0.01f); }
    for (int n = 0; n < 36; ++n) { float s = 0.f; for (int c = lane; c < D; c += 64) { const float hv = x(c) * rstd * g[c]; s += hv * (n < 4 ? a.in[I_W_RG][(size_t)l * D * 4 + c * 4 + n] : a.in[I_W_RE][(size_t)l * D * 32 + c * 32 + (n - 4)]); } s = wave_sum(s); if (lane == 0) lg[n] = s + (n < 4 ? a.in[I_B_RG][l * 4 + n] : a.in[I_B_RE][l * 32 + n - 4]); }
    __syncthreads();
    if (lane == 0) { int gi = 0; for (int i = 1; i < 4; ++i) if (lg[i] > lg[gi]) gi = i; float gs = 0.f; for (int i = 0; i < 4; ++i) gs += expf(lg[i] - lg[gi]); const float gp = 1.0f / gs;
        int i1 = 0; for (int i = 1; i < 8; ++i) if (lg[4 + 8 * gi + i] > lg[4 + 8 * gi + i1]) i1 = i; int i2 = (i1 == 0) ? 1 : 0; for (int i = 0; i < 8; ++i) if (i != i1 && lg[4 + 8 * gi + i] > lg[4 + 8 * gi + i2]) i2 = i;
        const float v1 = lg[4 + 8 * gi + i1], v2 = lg[4 + 8 * gi + i2]; const float ex = expf(v2 - v1); const float w1 = gp / (1.f + ex), w2 = gp * ex / (1.f + ex);
        const u32x4 r = ((const u32x4*)(a.ws + WS_ROUTE))[t]; const int e1 = gi * 8 + i1, e2 = gi * 8 + i2;
        if ((int)r.x == e1 && (int)r.y == e2) { diag_put(a.ws, stage, __uint_as_float(r.z) - w1, w1, 0.03f, 0.003f); diag_put(a.ws, stage, __uint_as_float(r.w) - w2, w2, 0.03f, 0.003f); }
        else {
            float gap = 1e9f; const int me1 = (int)r.x, me2 = (int)r.y;
            if (me1 / 8 != gi) gap = lg[gi] - lg[me1 / 8]; else { const float a1 = lg[4 + me1], a2 = lg[4 + me2]; gap = fmaxf(fabsf(fminf(v1, v2) - fminf(a1, a2)), fabsf(fmaxf(v1, v2) - fmaxf(a1, a2))); }
            diag_put(a.ws, stage, gap, 0.f, 0.f, 0.02f); } }
}
#undef x
__global__ void ck_moe(Args a, int l, int stage) {
    __shared__ float hid[512]; __shared__ float hx[D];
    const unsigned hsh = hash_u(blockIdx.x + 6006); const int t = hsh % T, k = blockIdx.x & 1; const u32x4 r = ((const u32x4*)(a.ws + WS_ROUTE))[t]; const int e = k ? (int)r.y : (int)r.x; const float w = __uint_as_float(k ? r.w : r.z);
    const bf16_t* xb = (const bf16_t*)(a.ws + WS_XB) + (size_t)t * D; const float* g = a.in[I_NORM_FFN] + l * D; const float* Wu = a.in[I_W_UP] + ((size_t)(l * NEXP + e) * D) * 1024;
    for (int c = threadIdx.x; c < D; c += 256) hx[c] = bf2f(xb[c]) * g[c];
    __syncthreads();
    float rs_; { float s_ = 0.f; for (int c = 0; c < D; ++c) { const float xv = bf2f(xb[c]); s_ += xv * xv; } rs_ = 1.0f / sqrtf(s_ / D + EPS); }
    for (int j = threadIdx.x; j < 512; j += 256) { float av = 0.f, cv = 0.f; for (int c = 0; c < D; ++c) { av += hx[c] * Wu[(size_t)c * 1024 + j]; cv += hx[c] * Wu[(size_t)c * 1024 + 512 + j]; } av *= rs_; cv *= rs_; hid[j] = av / (1.0f + expf(-av)) * cv; }
    __syncthreads();
    const int c = (threadIdx.x * 8 + 3) % D; const float* Wd = a.in[I_W_DOWN] + ((size_t)(l * NEXP + e) * 512) * D + c; float s = 0.f; for (int j = 0; j < 512; ++j) s += hid[j] * Wd[(size_t)j * D];
    const float ref = w * s; const bf16_t* ys = (const bf16_t*)(a.ws + (k ? WS_Y1 : WS_Y0));
    if (MK_MOE8 && l >= 0) diag_put(a.ws, stage, bf2f(ys[(size_t)t * D + c]) - ref, ref, 0.10f, 0.15f); else diag_put(a.ws, stage, bf2f(ys[(size_t)t * D + c]) - ref, ref, 0.03f, 0.02f);
}
__global__ void ck_report(Args a) {
    const float* dg = (const float*)(a.ws + WS_CTL) + CW_DIAG; int bad = 0; for (int s = 1; s < 64; ++s) if (dg[s] > 1.0f) { bad = s; break; }
    if (!bad) return;
    const float v = powf(10.0f, 2.0f + 0.5f * (float)bad) * (dg[bad] > 30.f ? 2.0f : 1.0f);
    for (size_t i = (size_t)blockIdx.x * blockDim.x + threadIdx.x; i < (size_t)T * D; i += (size_t)gridDim.x * blockDim.x) a.out[i] = v;
}
#endif

extern "C" void kernel_launch(void* const* d_in, const int* in_sizes, int n_in, void* d_out, int out_size, void* d_ws, size_t ws_size, hipStream_t stream) {
    static int grid = 0;
    if (grid == 0) {
        if (n_in != 27 || out_size != T * D || ws_size < WS_END) { fprintf(stderr, "kernel_launch: unexpected shapes (n_in %d out %d ws %zu)\n", n_in, out_size, ws_size); grid = -1; return; }
        (void)hipFuncSetAttribute((const void*)mk_fwd, hipFuncAttributeMaxDynamicSharedMemorySize, LDS_BYTES);
        int dev = 0, cus = 0; (void)hipGetDevice(&dev); (void)hipDeviceGetAttribute(&cus, hipDeviceAttributeMultiprocessorCount, dev);
        grid = cus > 0 ? cus : 256;
    }
    if (grid < 0) return;
    (void)hipMemsetAsync((char*)d_ws + WS_CTL, 0, CTL_BYTES, stream);
    Args a{};
    for (int i = 0; i < 27; ++i) a.in[i] = (const float*)d_in[i];
    a.out = (float*)d_out; a.ws = (unsigned char*)d_ws; a.mix_mask = 15;
#if MK_DEBUG
#define CK(kern, nblk, nthr, ...) hipLaunchKernelGGL(kern, dim3(nblk), dim3(nthr), 0, stream, a, __VA_ARGS__)
#endif
#if MK_FUSED && !MK_DEBUG
    if (MK_PROBE_LO < 0) {
        a.ph_lo = 0; a.ph_hi = N_PHASES;
        hipLaunchKernelGGL(mk_fwd, dim3(grid), dim3(NTHR), LDS_BYTES, stream, a);
#if MK_XPROBE
        a.ph_lo = 50; a.ph_hi = 51; hipLaunchKernelGGL(mk_fwd, dim3(grid), dim3(NTHR), LDS_BYTES, stream, a);
#endif
    } else {
        const int cuts[4] = {0, MK_PROBE_HI, MK_PROBE_LO, N_PHASES};
        const int los[3] = {0, MK_PROBE_LO, MK_PROBE_HI}, his[3] = {MK_PROBE_HI, MK_PROBE_HI, N_PHASES}; (void)cuts;
        for (int i = 0; i < 3; ++i) { if (los[i] >= his[i]) continue;
            if (i) (void)hipMemsetAsync((char*)d_ws + WS_CTL + CW_BAR * 4, 0, XCD_BAR_WORDS * 4, stream);
            a.ph_lo = los[i]; a.ph_hi = his[i]; a.mix_mask = (i == 1) ? MK_PROBE_MIX : 15;
            hipLaunchKernelGGL(mk_fwd, dim3(grid), dim3(NTHR), LDS_BYTES, stream, a); }
    }
    return;
#endif
    for (int ph = 0; ph < N_PHASES; ++ph) {
        a.ph_lo = ph; a.ph_hi = ph + 1;
        hipLaunchKernelGGL(mk_fwd, dim3(grid), dim3(NTHR), LDS_BYTES, stream, a);
#if MK_DEBUG
        if (ph >= 1 && ph < N_PHASES - 1) { const int l = (ph - 1) / PH_PER_LAYER, p = (ph - 1) % PH_PER_LAYER, sb = l * 13;
            if (p == 0) CK(ck_h, 64, 64, l, sb + 1);
            if (p == 1) { CK(ck_z_ident, 16, 64, l, sb + 2); CK(ck_z_qk, 128, 128, l, sb + 3, 0); CK(ck_z_qk, 128, 128, l, sb + 4, 1); }
            if (p == 2) { CK(ck_ya, 64, 128, l, sb + 5); CK(ck_yb, 16, 64, l, sb + 6); CK(ck_yd, 40, 128, l, sb + 8); }
            if (p == 3) CK(ck_yc, 64, 128, l, sb + 7);
            if (p == 4) CK(ck_p, 16, 64, l, sb + 9);
            if (p == 5) CK(ck_merged, 8, 64, l, sb + 10);
            if (p == 6 && l == 0) CK(ck_x1, 16, 64, l, sb + 11);
            if (p == 7) CK(ck_route, 128, 64, l, sb + 12);
            if (p == 9) CK(ck_moe, 32, 256, l, sb + 13);
        }
#endif
    }
#if MK_DEBUG
    hipLaunchKernelGGL(ck_report, dim3(1024), dim3(256), 0, stream, a);
#endif
}
```

```cpp
#include <hip/hip_runtime.h>
#include <cstdio>
#include <cstdint>

#ifndef MK_XPROBE
#define MK_XPROBE 0
#define MK_XPROBE_W W_G
#define MK_XPROBE_K 2048
#define MK_XPROBE_N 8192
#endif
#ifndef MK_PROBE_MIX
#define MK_PROBE_MIX 15
#endif
#ifndef MK_PROBE_LO
#define MK_PROBE_LO -1
#define MK_PROBE_HI -1
#endif
#ifndef MK_MOE8
#define MK_MOE8 1
#endif
#ifndef MK_Z8
#define MK_Z8 2
#endif
#ifndef MK_WO8
#define MK_WO8 0
#endif
#ifndef MK_Y8
#define MK_Y8 1
#endif
#ifndef MK_FUSED
#define MK_FUSED 1
#endif
#ifndef MK_DEBUG
#define MK_DEBUG 0
#endif

#define LAS __attribute__((address_space(3)))
typedef unsigned short bf16_t;
typedef short bf16x8 __attribute__((ext_vector_type(8)));
typedef short s16x4 __attribute__((ext_vector_type(4)));
typedef float f32x4 __attribute__((ext_vector_type(4)));
typedef float f32x2 __attribute__((ext_vector_type(2)));
typedef float f32x16 __attribute__((ext_vector_type(16)));
typedef unsigned u32x4 __attribute__((ext_vector_type(4)));
typedef unsigned u32x2 __attribute__((ext_vector_type(2)));

constexpr int NB = 8, SEQ = 4096, T = NB * SEQ, D = 2048, WIN = 8704;
constexpr int ZA = 0, ZB = 1024, ZC = 2560, ZD = 7168;
constexpr int NEXP = 32;
constexpr float EPS = 1e-6f;
constexpr int NWAVES = 8, NTHR = 512;
constexpr int LDS_BYTES = 147456;

constexpr size_t MiB = 1u << 20;
constexpr size_t WS_CTL = 0, CTL_BYTES = 1 * MiB;
constexpr size_t WS_COSC = 1 * MiB, WS_SINC = 2 * MiB, WS_COSD = 3 * MiB, WS_SIND = 3 * MiB + 512 * 1024;
constexpr size_t WS_LIST = 8 * MiB;
constexpr size_t WS_ROUTE = 24 * MiB;
constexpr size_t WS_LSE = 25 * MiB;
constexpr size_t WS_W = 32 * MiB, W_LAYER = 276 * MiB;
constexpr size_t W_IN = 0, W_G = 34 * MiB, W_B = 66 * MiB, W_O = 74 * MiB, W_UP = 82 * MiB, W_DN = 210 * MiB, W_R = 274 * MiB;
constexpr size_t WS_H = 584 * MiB;
constexpr size_t WS_Z = 712 * MiB;
constexpr size_t WS_HID = WS_Z;
constexpr size_t WS_Y0 = WS_Z + 80 * MiB, WS_Y1 = WS_Z + 208 * MiB;
constexpr size_t WS_Y = 1256 * MiB;
constexpr size_t WS_CO = 1384 * MiB;
constexpr size_t WS_H8 = 1480 * MiB;
constexpr size_t WS_XB = 1544 * MiB;
constexpr size_t WS_END = 1672 * MiB;
constexpr int CW_CNT = 64;
constexpr int CW_DIAG = 256;
constexpr int CW_BAR = 4096;

__device__ __forceinline__ unsigned cvt_pk_bf16(float lo, float hi) { unsigned r; asm("v_cvt_pk_bf16_f32 %0, %1, %2" : "=v"(r) : "v"(lo), "v"(hi)); return r; }
__device__ __forceinline__ float bf_lo(unsigned w) { return __uint_as_float(w << 16); }
__device__ __forceinline__ float bf_hi(unsigned w) { return __uint_as_float(w & 0xffff0000u); }
__device__ __forceinline__ float bf2f(bf16_t b) { return __uint_as_float(((unsigned)b) << 16); }
__device__ __forceinline__ float fast_exp(float x) { return __builtin_amdgcn_exp2f(x * 1.4426950408889634f); }
__device__ __forceinline__ float sigmoidf_(float x) { return __builtin_amdgcn_rcpf(1.0f + fast_exp(-x)); }
__device__ __forceinline__ float gelu_tanh(float x) { const float u = 0.7978845608028654f * (x + 0.044715f * x * x * x); return x * sigmoidf_(2.0f * u); }
__device__ __forceinline__ float wave_sum(float v) {
#pragma unroll
    for (int o = 1; o < 64; o <<= 1) v += __shfl_xor(v, o);
    return v;
}
#define LDS_WAIT() asm volatile("s_waitcnt lgkmcnt(0)" ::: "memory")
#define VM_WAIT() asm volatile("s_waitcnt vmcnt(0)" ::: "memory")
__device__ __forceinline__ int opaque_tid() { int t = threadIdx.x; asm volatile("" : "+v"(t)); return t; }

namespace gm {
constexpr int BM = 256, BK = 64, HALF = 128, HTB = HALF * BK * 2, STAGE_BYTES = 8 * HTB;
constexpr int NXCD = 8, WGM = 8;
constexpr int XCH_OFF = STAGE_BYTES;
constexpr int TAB_OFF = STAGE_BYTES + 8192;
__host__ __device__ __forceinline__ int lds_byte(int r, int c) { const int st = (r >> 4) * 2 + (c >> 5), rr = r & 15, cc = c & 31, ob = rr * 64 + cc * 2; return st * 1024 + (ob ^ (((ob >> 9) & 1) << 5)); }
__host__ __device__ __forceinline__ void stage_rc(int b, int& R, int& C) { const int st = b / 1024, sb = b % 1024, swz = sb ^ (((sb >> 9) & 1) << 5); R = (st >> 1) * 16 + swz / 64; C = (st & 1) * 32 + (swz % 64) / 2; }
__host__ __device__ __forceinline__ int perm32(int rho) { const int n = rho >> 4, i = rho & 15; return 8 * (i >> 2) + 4 * n + (i & 3); }

struct Unit { int pm, pn, aux; };
typedef int v8i32 __attribute__((ext_vector_type(8)));
__device__ __forceinline__ void mfma8(f32x4& acc, v8i32 a, v8i32 b, int sa, int sb) {
    asm volatile("v_mfma_scale_f32_16x16x128_f8f6f4 %0, %1, %2, %0, %3, %4 op_sel_hi:[0,0,0]" : "+v"(acc) : "v"(a), "v"(b), "v"(sa), "v"(sb)); }
__device__ __forceinline__ v8i32 cat8(bf16x8 lo, bf16x8 hi) { const u32x4 a = __builtin_bit_cast(u32x4, lo), b = __builtin_bit_cast(u32x4, hi); return (v8i32){(int)a.x, (int)a.y, (int)a.z, (int)a.w, (int)b.x, (int)b.y, (int)b.z, (int)b.w}; }
struct Desc { const void* A; const void* Bt; int lda, ldb, K; int sw = 121, sa = 127; };

struct StaticOrder {
    static constexpr bool GATHER = false;
    int nM, nN, nwg, G, c, i0 = 0, iend = 1 << 30;
    __device__ void init(int M, int N, int G_, int c_) { nM = M / BM; nN = N / BM; nwg = nM * nN; G = G_; c = c_; }
    __device__ __forceinline__ bool next(int i, Unit& u) const {
        if (i + i0 >= iend) return false;
        const long L = (long)(i + i0) * G + c; if (L >= nwg) return false;
        int wgid = (int)L; { const int q = nwg / NXCD, r = nwg % NXCD, xcd = wgid % NXCD, off = wgid / NXCD; wgid = (xcd < r ? xcd * (q + 1) : r * (q + 1) + (xcd - r) * q) + off; }
        const int nig = WGM * nN, gid = wgid / nig, fm = gid * WGM, gsz = (nM - fm) < WGM ? (nM - fm) : WGM;
        u.pm = fm + ((wgid % nig) % gsz); u.pn = (wgid % nig) / gsz; u.aux = 0; return true;
    }
    __device__ __forceinline__ const char* a_base(const Desc& g, const Unit& u) const { return (const char*)g.A + (size_t)u.pm * BM * g.lda; }
    __device__ __forceinline__ const char* b_base(const Desc& g, const Unit& u) const { return (const char*)g.Bt + (size_t)u.pn * BM * g.ldb; }
    __device__ __forceinline__ void a_off(const Desc& g, const Unit&, const int (&R)[2], const int (&C)[2], unsigned (&v)[2][2]) const {
#pragma unroll
        for (int h = 0; h < 2; ++h)
#pragma unroll
            for (int i = 0; i < 2; ++i) v[h][i] = (unsigned)((R[i] + HALF * h) * g.lda + C[i] * 2);
    }
};
struct BranchOrder : StaticOrder {
    __device__ __forceinline__ const char* a_base(const Desc& g, const Unit& u) const { return (const char*)g.A + (size_t)u.pm * BM * g.lda + (size_t)(u.pn >> 3) * 512 * 2; }
};

template <bool FP8 = false, class Epi, class Sched>
__device__ __forceinline__ void gemm_phase(LAS unsigned char* lds, const Desc g, const Sched& S, const Epi& E) {
    const int tid = opaque_tid(), wid = __builtin_amdgcn_readfirstlane(tid >> 6), lane = tid & 63, wr = wid >> 2, wc = wid & 3, fr = lane & 15, fq = lane >> 4;
    const int nt = g.K / (BK * 2);
    int Rr[2], Cc[2]; unsigned voffB[2];
#pragma unroll
    for (int i = 0; i < 2; ++i) { int R, C; stage_rc(tid * 16 + i * 8192, R, C); Rr[i] = R; Cc[i] = C; const int Rb = (R & ~31) + perm32(R & 31); voffB[i] = (unsigned)(Rb * g.ldb + C * 2); }
    const size_t kstep = (size_t)(BK * 2);
    const size_t hstepB = (size_t)HALF * g.ldb;
    const unsigned ldsw = (unsigned)wid * 1024u;
    const int aoff = lds_byte(wr * 64 + fr, FP8 ? fq * 16 : fq * 8), boff = lds_byte(wc * 32 + fr, FP8 ? fq * 16 : fq * 8);
    constexpr int KSTR = FP8 ? 16 : 1024;
#define GM_SA(b, h) (((b) * 2 + (h)) * HTB)
#define GM_SB(b, h) ((4 + (b) * 2 + (h)) * HTB)
#define GM_STAGE(bufoff, gbase, voff) do { _Pragma("unroll") for (int _i = 0; _i < 2; ++_i) \
        __builtin_amdgcn_global_load_lds((const unsigned*)((const char*)(gbase) + (voff)[_i]), (LAS unsigned*)(lds + (bufoff) + ldsw + _i * 8192), 16, 0, 0); } while (0)
#define GM_LDA(dst, b, h) do { _Pragma("unroll") for (int m = 0; m < 4; ++m) _Pragma("unroll") for (int k = 0; k < 2; ++k) dst[m][k] = *(const LAS bf16x8*)(lds + GM_SA(b, h) + aoff + m * 2048 + k * KSTR); } while (0)
#define GM_LDB(dst, b, h) do { _Pragma("unroll") for (int n = 0; n < 2; ++n) _Pragma("unroll") for (int k = 0; k < 2; ++k) dst[n][k] = *(const LAS bf16x8*)(lds + GM_SB(b, h) + boff + n * 2048 + k * KSTR); } while (0)
#define GM_MMA(ai, bj, At, Bt) do { __builtin_amdgcn_s_setprio(1); \
        if constexpr (FP8) { _Pragma("unroll") for (int m = 0; m < 4; ++m) _Pragma("unroll") for (int n = 0; n < 2; ++n) \
            mfma8(acc[ai][bj][m][n], cat8(Bt[n][0], Bt[n][1]), cat8(At[m][0], At[m][1]), sc_w, sc_1); } \
        else { _Pragma("unroll") for (int m = 0; m < 4; ++m) _Pragma("unroll") for (int n = 0; n < 2; ++n) _Pragma("unroll") for (int k = 0; k < 2; ++k) \
            acc[ai][bj][m][n] = __builtin_amdgcn_mfma_f32_16x16x32_bf16(Bt[n][k], At[m][k], acc[ai][bj][m][n], 0, 0, 0); } \
        __builtin_amdgcn_s_setprio(0); } while (0)
#define GM_WAIT_V(n) asm volatile("s_waitcnt vmcnt(" #n ")" ::: "memory")
#define GM_WAIT_L(n) asm volatile("s_waitcnt lgkmcnt(" #n ")" ::: "memory")
#define GM_BAR __builtin_amdgcn_s_barrier()
#define GM_SCHED __builtin_amdgcn_sched_barrier(0)
    Unit cur, nxt; int ui = 0;
    if (!S.next(0, cur)) return;
    int sc_w = g.sw, sc_1 = g.sa; asm volatile("" : "+v"(sc_w), "+v"(sc_1));
    f32x4 acc[2][2][4][2];
#pragma unroll
    for (int a = 0; a < 2; ++a)
#pragma unroll
        for (int b = 0; b < 2; ++b)
#pragma unroll
            for (int m = 0; m < 4; ++m)
#pragma unroll
                for (int n = 0; n < 2; ++n) acc[a][b][m][n] = (f32x4){0.f, 0.f, 0.f, 0.f};
    bf16x8 At[4][2], B0[2][2], B1[2][2];
    unsigned vc[2][2], vn[2][2];
    S.a_off(g, cur, Rr, Cc, vc);
    const char* cA = S.a_base(g, cur); const char* cB = S.b_base(g, cur);
    GM_STAGE(GM_SB(0, 0), cB, voffB); GM_STAGE(GM_SB(0, 1), cB + hstepB, voffB); GM_STAGE(GM_SA(0, 0), cA, vc[0]); GM_STAGE(GM_SA(0, 1), cA, vc[1]);
    if (wr == 1) GM_BAR;
    GM_WAIT_V(2); GM_BAR;
    GM_STAGE(GM_SB(1, 0), cB + kstep, voffB); GM_STAGE(GM_SA(1, 0), cA + kstep, vc[0]); GM_STAGE(GM_SB(1, 1), cB + hstepB + kstep, voffB);
    GM_WAIT_V(6); GM_BAR;
    for (;;) {
        const bool has_next = S.next(ui + 1, nxt);
        const char* nA = cA; const char* nB = cB;
#pragma unroll
        for (int h = 0; h < 2; ++h)
#pragma unroll
            for (int i = 0; i < 2; ++i) vn[h][i] = vc[h][i];
        if (has_next) { nA = S.a_base(g, nxt); nB = S.b_base(g, nxt); if constexpr (Sched::GATHER) S.a_off(g, nxt, Rr, Cc, vn); }
        for (int t = 0; t < nt; t += 2) {
            const bool last = (t == nt - 2);
            const char* a1 = cA + (size_t)(t + 1) * kstep;
            const char* a2 = last ? nA : cA + (size_t)(t + 2) * kstep; const char* b2 = last ? nB : cB + (size_t)(t + 2) * kstep;
            const char* a3 = a2 + kstep; const char* b3 = b2 + kstep;
            unsigned v2[2][2];
#pragma unroll
            for (int h = 0; h < 2; ++h)
#pragma unroll
                for (int i = 0; i < 2; ++i) v2[h][i] = (Sched::GATHER && last) ? vn[h][i] : vc[h][i];
            GM_LDB(B0, 0, 0); GM_LDB(B1, 0, 1); GM_SCHED; GM_LDA(At, 0, 0); GM_STAGE(GM_SA(1, 1), a1, vc[1]);
            GM_WAIT_V(8); GM_WAIT_L(0); GM_BAR; GM_MMA(0, 0, At, B0); GM_MMA(0, 1, At, B1); GM_BAR; GM_SCHED;
            GM_LDA(At, 0, 1); GM_STAGE(GM_SB(0, 0), b2, voffB); GM_STAGE(GM_SB(0, 1), b2 + hstepB, voffB); GM_STAGE(GM_SA(0, 0), a2, v2[0]);
            GM_WAIT_V(8); GM_WAIT_L(0); GM_BAR; GM_MMA(1, 0, At, B0); GM_MMA(1, 1, At, B1); GM_BAR; GM_SCHED;
            GM_LDB(B0, 1, 0); GM_LDB(B1, 1, 1); GM_SCHED; GM_LDA(At, 1, 0); GM_STAGE(GM_SA(0, 1), a2, v2[1]);
            GM_WAIT_V(8); GM_WAIT_L(0); GM_BAR; GM_MMA(0, 0, At, B0); GM_MMA(0, 1, At, B1); GM_BAR; GM_SCHED;
            GM_LDA(At, 1, 1); GM_STAGE(GM_SB(1, 0), b3, voffB); GM_STAGE(GM_SB(1, 1), b3 + hstepB, voffB); GM_STAGE(GM_SA(1, 0), a3, v2[0]);
            GM_WAIT_V(8); GM_WAIT_L(0); GM_BAR; GM_MMA(1, 0, At, B0); GM_MMA(1, 1, At, B1); GM_BAR; GM_SCHED;
        }
        if (wr == 0) GM_BAR;
        if constexpr (FP8) { asm volatile("s_nop 15\n\ts_nop 15\n\ts_nop 15" ::: "memory"); }
        { int fr_e = fr, fq_e = fq; asm volatile("" : "+v"(fr_e), "+v"(fq_e));
          E(acc, cur, lds, wr, wc, fr_e, fq_e); }
        if (!has_next) break;
#pragma unroll
        for (int a = 0; a < 2; ++a)
#pragma unroll
            for (int b = 0; b < 2; ++b)
#pragma unroll
                for (int m = 0; m < 4; ++m)
#pragma unroll
                    for (int n = 0; n < 2; ++n) acc[a][b][m][n] = (f32x4){0.f, 0.f, 0.f, 0.f};
        cur = nxt; cA = nA; cB = nB; ++ui;
#pragma unroll
        for (int h = 0; h < 2; ++h)
#pragma unroll
            for (int i = 0; i < 2; ++i) vc[h][i] = vn[h][i];
        if (wr == 1) GM_BAR;
    }
    GM_WAIT_V(0);
    GM_BAR;
#undef GM_SA
#undef GM_SB
#undef GM_STAGE
#undef GM_LDA
#undef GM_LDB
#undef GM_MMA
#undef GM_WAIT_V
#undef GM_WAIT_L
#undef GM_BAR
#undef GM_SCHED
}

struct EpiZ {
    bf16_t* Z; const float *qn_c, *kn_c, *qn_d, *kn_d; const float *cosC, *sinC, *cosD, *sinD;
    __device__ __forceinline__ void operator()(f32x4 (&acc)[2][2][4][2], const Unit& u, LAS unsigned char* lds, int wr, int wc, int fr, int fq) const {
        const int pn = u.pn; const int row0 = u.pm * BM + wr * 64 + fr;
        if (pn >= 10 && pn < 22) {
            LAS float* xch = (LAS float*)(lds + XCH_OFF);
            const int hh = 2 * (pn - 10) + (wc >> 1); const float* gn = (hh >= 12) ? kn_c : qn_c;
            const int i0 = 32 * (wc & 1) + 8 * fq;
#pragma unroll
            for (int ai = 0; ai < 2; ++ai)
#pragma unroll
                for (int m = 0; m < 4; ++m) { float ss = 0.f;
#pragma unroll
                    for (int bj = 0; bj < 2; ++bj)
#pragma unroll
                        for (int n = 0; n < 2; ++n) { const f32x4 x = acc[ai][bj][m][n]; ss += (x[0] * x[0] + x[1] * x[1]) + (x[2] * x[2] + x[3] * x[3]); }
                    ss += __shfl_xor(ss, 16); ss += __shfl_xor(ss, 32);
                    if (fq == 0) xch[(ai * HALF + wr * 64 + m * 16 + fr) * 4 + wc] = ss; }
            LDS_WAIT(); __builtin_amdgcn_s_barrier(); asm volatile("" ::: "memory");
            f32x4 ivr[2];
#pragma unroll
            for (int n = 0; n < 2; ++n) {
#pragma unroll
                for (int j = 0; j < 4; ++j) ivr[n][j] = __builtin_amdgcn_exp2f(-(float)(i0 + 4 * n + j) * (13.287712379549449f / 64.0f)) * 0.15915494309189535f; }
#pragma unroll
            for (int ai = 0; ai < 2; ++ai)
#pragma unroll
                for (int m = 0; m < 4; ++m) { const int rl = ai * HALF + wr * 64 + m * 16 + fr; const int row = u.pm * BM + rl;
                    const float tot = xch[rl * 4 + wc] + xch[rl * 4 + (wc ^ 1)];
                    const float rstd = 1.0f / sqrtf(tot * (1.0f / 128.0f) + EPS);
                    const float posf = (float)(row & (SEQ - 1));
                    u32x4 w0, w1;
#pragma unroll
                    for (int n = 0; n < 2; ++n) { f32x4 cs, sn;
#pragma unroll
                        for (int j = 0; j < 4; ++j) { const float xr = __builtin_amdgcn_fractf(posf * ivr[n][j]); cs[j] = __builtin_amdgcn_cosf(xr); sn[j] = __builtin_amdgcn_sinf(xr); }
                        const f32x4 g0 = *(const f32x4*)(gn + i0 + 4 * n), g1 = *(const f32x4*)(gn + 64 + i0 + 4 * n);
                        const f32x4 x1 = acc[ai][0][m][n] * rstd * g0, x2 = acc[ai][1][m][n] * rstd * g1;
                        const f32x4 o1 = x1 * cs - x2 * sn, o2 = x2 * cs + x1 * sn;
                        w0[2 * n] = cvt_pk_bf16(o1[0], o1[1]); w0[2 * n + 1] = cvt_pk_bf16(o1[2], o1[3]);
                        w1[2 * n] = cvt_pk_bf16(o2[0], o2[1]); w1[2 * n + 1] = cvt_pk_bf16(o2[2], o2[3]); }
                    bf16_t* rp = Z + (size_t)row * WIN + ZC + hh * 128 + i0;
                    *(u32x4*)rp = w0; *(u32x4*)(rp + 64) = w1; }
        } else if (pn >= 28 && pn < 32) {
            const float* gn = (pn >= 30) ? kn_d : qn_d;
            const int i0 = 8 * fq;
            f32x4 ivr[2];
#pragma unroll
            for (int n = 0; n < 2; ++n) {
#pragma unroll
                for (int j = 0; j < 4; ++j) ivr[n][j] = __builtin_amdgcn_exp2f(-(float)(i0 + 4 * n + j) * (13.287712379549449f / 32.0f)) * 0.15915494309189535f; }
#pragma unroll
            for (int ai = 0; ai < 2; ++ai)
#pragma unroll
                for (int m = 0; m < 4; ++m) { const int row = row0 + ai * HALF + m * 16; float ss = 0.f;
#pragma unroll
                    for (int bj = 0; bj < 2; ++bj)
#pragma unroll
                        for (int n = 0; n < 2; ++n) { const f32x4 x = acc[ai][bj][m][n]; ss += (x[0] * x[0] + x[1] * x[1]) + (x[2] * x[2] + x[3] * x[3]); }
                    ss += __shfl_xor(ss, 16); ss += __shfl_xor(ss, 32);
                    const float rstd = 1.0f / sqrtf(ss * (1.0f / 64.0f) + EPS);
                    const float posf = (float)(row & (SEQ - 1));
                    u32x4 w0, w1;
#pragma unroll
                    for (int n = 0; n < 2; ++n) { f32x4 cs, sn;
#pragma unroll
                        for (int j = 0; j < 4; ++j) { const float xr = __builtin_amdgcn_fractf(posf * ivr[n][j]); cs[j] = __builtin_amdgcn_cosf(xr); sn[j] = __builtin_amdgcn_sinf(xr); }
                        const f32x4 g0 = *(const f32x4*)(gn + i0 + 4 * n), g1 = *(const f32x4*)(gn + 32 + i0 + 4 * n);
                        const f32x4 x1 = acc[ai][0][m][n] * rstd * g0, x2 = acc[ai][1][m][n] * rstd * g1;
                        const f32x4 o1 = x1 * cs - x2 * sn, o2 = x2 * cs + x1 * sn;
                        w0[2 * n] = cvt_pk_bf16(o1[0], o1[1]); w0[2 * n + 1] = cvt_pk_bf16(o1[2], o1[3]);
                        w1[2 * n] = cvt_pk_bf16(o2[0], o2[1]); w1[2 * n + 1] = cvt_pk_bf16(o2[2], o2[3]); }
                    bf16_t* rp = Z + (size_t)row * WIN + ZD + (pn - 28) * 256 + wc * 64 + i0;
                    *(u32x4*)rp = w0; *(u32x4*)(rp + 32) = w1; }
        } else {
            const bool do_gelu = pn < 4;
#pragma unroll
            for (int ai = 0; ai < 2; ++ai)
#pragma unroll
                for (int m = 0; m < 4; ++m) { bf16_t* rp = Z + (size_t)(row0 + ai * HALF + m * 16) * WIN + pn * BM + wc * 32 + 8 * fq;
#pragma unroll
                    for (int bj = 0; bj < 2; ++bj) { f32x4 v0 = acc[ai][bj][m][0], v1 = acc[ai][bj][m][1];
                        if (do_gelu) {
#pragma unroll
                            for (int j = 0; j < 4; ++j) { v0[j] = gelu_tanh(v0[j]); v1[j] = gelu_tanh(v1[j]); } }
                        u32x4 w; w.x = cvt_pk_bf16(v0[0], v0[1]); w.y = cvt_pk_bf16(v0[2], v0[3]); w.z = cvt_pk_bf16(v1[0], v1[1]); w.w = cvt_pk_bf16(v1[2], v1[3]);
                        *(u32x4*)(rp + bj * HALF) = w; } }
        }
    }
};
struct EpiBf16 {
    bf16_t* O; int ldc;
    __device__ __forceinline__ void operator()(f32x4 (&acc)[2][2][4][2], const Unit& u, LAS unsigned char*, int wr, int wc, int fr, int fq) const {
        const int row0 = u.pm * BM + wr * 64 + fr;
#pragma unroll
        for (int ai = 0; ai < 2; ++ai)
#pragma unroll
            for (int m = 0; m < 4; ++m) { bf16_t* rp = O + (size_t)(row0 + ai * HALF + m * 16) * ldc + u.pn * BM + wc * 32 + 8 * fq;
#pragma unroll
                for (int bj = 0; bj < 2; ++bj) { const f32x4 v0 = acc[ai][bj][m][0], v1 = acc[ai][bj][m][1];
                    u32x4 w; w.x = cvt_pk_bf16(v0[0], v0[1]); w.y = cvt_pk_bf16(v0[2], v0[3]); w.z = cvt_pk_bf16(v1[0], v1[1]); w.w = cvt_pk_bf16(v1[2], v1[3]);
                    __builtin_nontemporal_store(w, (u32x4*)(rp + bj * HALF)); } }
    }
};
template <bool OUT8> struct EpiGateT {
    void* Mg; const bf16_t* P; const float* bg;
    __device__ __forceinline__ void operator()(f32x4 (&acc)[2][2][4][2], const Unit& u, LAS unsigned char*, int wr, int wc, int fr, int fq) const {
        const int row0 = u.pm * BM + wr * 64 + fr; const int c = 64 * u.pn + 16 * wc + 4 * fq;
        constexpr float NL2E = -1.4426950408889634f;
        f32x4 bl[4];
#pragma unroll
        for (int k = 0; k < 4; ++k) bl[k] = *(const f32x4*)(bg + k * D + c) * NL2E;
#pragma unroll
        for (int ai = 0; ai < 2; ++ai) {
            u32x2 pw[4][4];
#pragma unroll
            for (int m = 0; m < 4; ++m) { const bf16_t* pr = P + (size_t)(row0 + ai * HALF + m * 16) * 8192 + c;
#pragma unroll
                for (int k = 0; k < 4; ++k) pw[m][k] = *(const u32x2*)(pr + k * D); }
            asm volatile("" ::: "memory");
#pragma unroll
            for (int m = 0; m < 4; ++m) { const size_t row = (size_t)(row0 + ai * HALF + m * 16); f32x4 s = (f32x4){0.f, 0.f, 0.f, 0.f};
#pragma unroll
                for (int k = 0; k < 4; ++k) { const f32x4 e = acc[ai][k >> 1][m][k & 1] * NL2E + bl[k]; const u32x2 p = pw[m][k];
                    f32x4 t; t[0] = __builtin_amdgcn_exp2f(e[0]); t[1] = __builtin_amdgcn_exp2f(e[1]); t[2] = __builtin_amdgcn_exp2f(e[2]); t[3] = __builtin_amdgcn_exp2f(e[3]);
                    t = t + 1.0f;
                    f32x4 r; r[0] = __builtin_amdgcn_rcpf(t[0]); r[1] = __builtin_amdgcn_rcpf(t[1]); r[2] = __builtin_amdgcn_rcpf(t[2]); r[3] = __builtin_amdgcn_rcpf(t[3]);
                    const f32x4 pv = (f32x4){bf_lo(p.x), bf_hi(p.x), bf_lo(p.y), bf_hi(p.y)};
                    s = r * pv + s; }
                if constexpr (OUT8) { int p = __builtin_amdgcn_cvt_pk_fp8_f32(s[0], s[1], 0, false); p = __builtin_amdgcn_cvt_pk_fp8_f32(s[2], s[3], p, true); *(unsigned*)((unsigned char*)Mg + row * D + c) = (unsigned)p; }
                else { u32x2 w; w.x = cvt_pk_bf16(s[0], s[1]); w.y = cvt_pk_bf16(s[2], s[3]); *(u32x2*)((bf16_t*)Mg + row * D + c) = w; } }
        }
    }
};
struct EpiResid {
    const float* XF; bf16_t* XB;
    __device__ __forceinline__ void operator()(f32x4 (&acc)[2][2][4][2], const Unit& u, LAS unsigned char*, int wr, int wc, int fr, int fq) const {
        const int row0 = u.pm * BM + wr * 64 + fr;
#pragma unroll
        for (int ai = 0; ai < 2; ++ai)
#pragma unroll
            for (int m = 0; m < 4; ++m) { const size_t off = (size_t)(row0 + ai * HALF + m * 16) * D + u.pn * BM + wc * 32 + 8 * fq;
#pragma unroll
                for (int bj = 0; bj < 2; ++bj) { f32x4 x0, x1;
                    if (XF) { x0 = *(const f32x4*)(XF + off + bj * HALF); x1 = *(const f32x4*)(XF + off + bj * HALF + 4); }
                    else { const u32x4 r = *(const u32x4*)(XB + off + bj * HALF); x0 = (f32x4){bf_lo(r.x), bf_hi(r.x), bf_lo(r.y), bf_hi(r.y)}; x1 = (f32x4){bf_lo(r.z), bf_hi(r.z), bf_lo(r.w), bf_hi(r.w)}; }
                    x0 += acc[ai][bj][m][0]; x1 += acc[ai][bj][m][1];
                    u32x4 w; w.x = cvt_pk_bf16(x0[0], x0[1]); w.y = cvt_pk_bf16(x0[2], x0[3]); w.z = cvt_pk_bf16(x1[0], x1[1]); w.w = cvt_pk_bf16(x1[2], x1[3]);
                    *(u32x4*)(XB + off + bj * HALF) = w; } }
    }
};
struct MoeOrder {
    static constexpr bool GATHER = false;
    int nN, G, c; LAS const int* tab; const u32x4* list; int nexp_rows;
    __device__ __forceinline__ bool next(int i, Unit& u) const {
        const int L = i * G + c; const int TT = tab[32]; const int rt = L / nN;
        if (rt >= TT) return false;
        int e = 0;
#pragma unroll 1
        for (int k = 1; k < 32; ++k) e = (tab[k] <= rt) ? k : e;
        u.pm = rt; u.pn = L - rt * nN; u.aux = e; return true;
    }
    __device__ __forceinline__ const char* b_base(const Desc& g, const Unit& u) const { return (const char*)g.Bt + ((size_t)u.aux * nexp_rows + (size_t)u.pn * BM) * g.ldb; }
};
struct MoeUpOrder : MoeOrder {
    static constexpr bool GATHER = true;
    __device__ __forceinline__ const char* a_base(const Desc& g, const Unit&) const { return (const char*)g.A; }
    __device__ __forceinline__ void a_off(const Desc& g, const Unit& u, const int (&R)[2], const int (&C)[2], unsigned (&v)[2][2]) const {
        const int e = u.aux, base = (u.pm - tab[e]) * BM, cnt = tab[40 + e];
#pragma unroll
        for (int h = 0; h < 2; ++h)
#pragma unroll
            for (int i = 0; i < 2; ++i) { const int idx = base + R[i] + HALF * h; int tok = 0; if (idx < cnt) tok = (int)(list[(size_t)e * T + idx].x & 0x7fffu);
                v[h][i] = (unsigned)(tok * g.lda + C[i] * 2); }
    }
};
struct MoeDownOrder : MoeOrder {
    __device__ __forceinline__ const char* a_base(const Desc& g, const Unit& u) const { return (const char*)g.A + (size_t)u.pm * BM * g.lda; }
    __device__ __forceinline__ void a_off(const Desc& g, const Unit&, const int (&R)[2], const int (&C)[2], unsigned (&v)[2][2]) const {
#pragma unroll
        for (int h = 0; h < 2; ++h)
#pragma unroll
            for (int i = 0; i < 2; ++i) v[h][i] = (unsigned)((R[i] + HALF * h) * g.lda + C[i] * 2);
    }
};
template <bool OUT8> struct EpiUpT {
    void* Hid; const u32x4* list;
    __device__ __forceinline__ void operator()(f32x4 (&acc)[2][2][4][2], const Unit& u, LAS unsigned char* lds, int wr, int wc, int fr, int fq) const {
        LAS const int* tab = (LAS const int*)(lds + TAB_OFF);
        const int e = u.aux, base = (u.pm - tab[e]) * BM, cnt = tab[40 + e];
        const int row0 = u.pm * BM + wr * 64 + fr;
        float rs[2][4];
#pragma unroll
        for (int ai = 0; ai < 2; ++ai)
#pragma unroll
            for (int m = 0; m < 4; ++m) { const int idx = base + ai * HALF + wr * 64 + m * 16 + fr; rs[ai][m] = (idx < cnt) ? __uint_as_float(list[(size_t)e * T + idx].z) : 0.f; }
#pragma unroll
        for (int ai = 0; ai < 2; ++ai)
#pragma unroll
            for (int m = 0; m < 4; ++m) { const size_t eo = (size_t)(row0 + ai * HALF + m * 16) * 512 + u.pn * 128 + wc * 32 + 8 * fq; f32x4 o[2]; const float r = rs[ai][m];
#pragma unroll
                for (int n = 0; n < 2; ++n)
#pragma unroll
                    for (int j = 0; j < 4; ++j) { const float a = acc[ai][0][m][n][j] * r; o[n][j] = a * sigmoidf_(a) * (acc[ai][1][m][n][j] * r); }
                if constexpr (OUT8) { u32x2 w; int p = __builtin_amdgcn_cvt_pk_fp8_f32(o[0][0] * 16.f, o[0][1] * 16.f, 0, false); p = __builtin_amdgcn_cvt_pk_fp8_f32(o[0][2] * 16.f, o[0][3] * 16.f, p, true); w.x = (unsigned)p;
                    p = __builtin_amdgcn_cvt_pk_fp8_f32(o[1][0] * 16.f, o[1][1] * 16.f, 0, false); p = __builtin_amdgcn_cvt_pk_fp8_f32(o[1][2] * 16.f, o[1][3] * 16.f, p, true); w.y = (unsigned)p;
                    *(u32x2*)((unsigned char*)Hid + eo) = w; }
                else { u32x4 w; w.x = cvt_pk_bf16(o[0][0], o[0][1]); w.y = cvt_pk_bf16(o[0][2], o[0][3]); w.z = cvt_pk_bf16(o[1][0], o[1][1]); w.w = cvt_pk_bf16(o[1][2], o[1][3]);
                    *(u32x4*)((bf16_t*)Hid + eo) = w; } }
    }
};
template <bool OUT8> struct EpiDownT {
    void *Y0, *Y1; const u32x4* list;
    __device__ __forceinline__ void operator()(f32x4 (&acc)[2][2][4][2], const Unit& u, LAS unsigned char* lds, int wr, int wc, int fr, int fq) const {
        LAS const int* tab = (LAS const int*)(lds + TAB_OFF);
        const int e = u.aux, base = (u.pm - tab[e]) * BM, cnt = tab[40 + e];
#pragma unroll
        for (int ai = 0; ai < 2; ++ai)
#pragma unroll
            for (int m = 0; m < 4; ++m) { const int idx = base + ai * HALF + wr * 64 + m * 16 + fr;
                if (idx < cnt) { const u32x4 en = list[(size_t)e * T + idx]; const int tok = (int)(en.x & 0x7fffu); const float w = __uint_as_float(en.y);
                    const size_t eo = (size_t)tok * D + u.pn * BM + wc * 32 + 8 * fq; void* yb = (en.x >> 16) ? Y1 : Y0;
#pragma unroll
                    for (int bj = 0; bj < 2; ++bj) { const f32x4 v0 = acc[ai][bj][m][0] * w, v1 = acc[ai][bj][m][1] * w;
                        if constexpr (OUT8) { int p0 = __builtin_amdgcn_cvt_pk_fp8_f32(v0[0] * 16.f, v0[1] * 16.f, 0, false); p0 = __builtin_amdgcn_cvt_pk_fp8_f32(v0[2] * 16.f, v0[3] * 16.f, p0, true);
                            int p1 = __builtin_amdgcn_cvt_pk_fp8_f32(v1[0] * 16.f, v1[1] * 16.f, 0, false); p1 = __builtin_amdgcn_cvt_pk_fp8_f32(v1[2] * 16.f, v1[3] * 16.f, p1, true);
                            *(u32x2*)((unsigned char*)yb + eo + bj * HALF) = (u32x2){(unsigned)p0, (unsigned)p1}; }
                        else { u32x4 ww; ww.x = cvt_pk_bf16(v0[0], v0[1]); ww.y = cvt_pk_bf16(v0[2], v0[3]); ww.z = cvt_pk_bf16(v1[0], v1[1]); ww.w = cvt_pk_bf16(v1[2], v1[3]);
                            *(u32x4*)((bf16_t*)yb + eo + bj * HALF) = ww; } } } }
    }
};
struct EpiProbe {
    float* dummy;
    __device__ __forceinline__ void operator()(f32x4 (&acc)[2][2][4][2], const Unit& u, LAS unsigned char*, int wr, int wc, int fr, int fq) const {
        f32x4 s = (f32x4){0.f, 0.f, 0.f, 0.f};
#pragma unroll
        for (int ai = 0; ai < 2; ++ai)
#pragma unroll
            for (int bj = 0; bj < 2; ++bj)
#pragma unroll
                for (int m = 0; m < 4; ++m)
#pragma unroll
                    for (int n = 0; n < 2; ++n) s += acc[ai][bj][m][n];
        if (s[0] + s[1] + s[2] + s[3] == 12345.678f) dummy[u.pm * 64 + fr] = s[0];
    }
};
}

namespace at {
#define SBAR() __builtin_amdgcn_sched_barrier(0)
__device__ __forceinline__ int crow(int r, int hi) { return (r & 3) + 8 * (r >> 2) + 4 * hi; }
template <int DQK> __device__ __forceinline__ int kswz(int row, int colB) { if (DQK == 128) return row * 256 + (colB ^ ((row & 7) << 4)); else return row * 128 + (colB ^ (((row >> 1) & 7) << 4)); }
constexpr int SHM_V = 64 * 128 * 2;
constexpr int LDS_WS = 131072;
__device__ __forceinline__ int v_st(int k, int c) { const int kk = (k & ~0xC) | ((k & 4) << 1) | ((k & 8) >> 1); return ((kk >> 3) * 4 + (c >> 5)) * 512 + ((kk & 7) * 32 + (c & 31)) * 2; }
__device__ __forceinline__ int v_rd_base(int lane) { return ((lane & 3) << 3) | (((lane >> 2) & 3) << 6) | (((lane >> 4) & 1) << 5) | (((lane >> 5) & 1) << 8); }
constexpr int v_rd_off(int d0, int ks, int half) { return d0 * 512 + ks * 4096 + half * 2048; }
template <int OFF> __device__ __forceinline__ s16x4 tr_read(unsigned vb) { s16x4 r; asm volatile("ds_read_b64_tr_b16 %0, %1 offset:%2" : "=&v"(r) : "v"(vb), "i"(OFF) : "memory"); return r; }
template <int D0> __device__ __forceinline__ void v_read8(s16x4 (&v)[8], unsigned vb) {
    v[0] = tr_read<v_rd_off(D0, 0, 0)>(vb); v[1] = tr_read<v_rd_off(D0, 0, 1)>(vb); v[2] = tr_read<v_rd_off(D0, 1, 0)>(vb); v[3] = tr_read<v_rd_off(D0, 1, 1)>(vb);
    v[4] = tr_read<v_rd_off(D0, 2, 0)>(vb); v[5] = tr_read<v_rd_off(D0, 2, 1)>(vb); v[6] = tr_read<v_rd_off(D0, 3, 0)>(vb); v[7] = tr_read<v_rd_off(D0, 3, 1)>(vb);
}
__device__ __forceinline__ void pv_mma4(f32x16& od, const s16x4 (&v)[8], bf16x8 pa0, bf16x8 pa1, bf16x8 pa2, bf16x8 pa3) {
#define AT_PK(L, H) (bf16x8){L[0], L[1], L[2], L[3], H[0], H[1], H[2], H[3]}
    od = __builtin_amdgcn_mfma_f32_32x32x16_bf16(pa0, AT_PK(v[0], v[1]), od, 0, 0, 0);
    od = __builtin_amdgcn_mfma_f32_32x32x16_bf16(pa1, AT_PK(v[2], v[3]), od, 0, 0, 0);
    od = __builtin_amdgcn_mfma_f32_32x32x16_bf16(pa2, AT_PK(v[4], v[5]), od, 0, 0, 0);
    od = __builtin_amdgcn_mfma_f32_32x32x16_bf16(pa3, AT_PK(v[6], v[7]), od, 0, 0, 0);
#undef AT_PK
}
__device__ __forceinline__ void pv_d0(f32x16* o, unsigned vb, bf16x8 pa0, bf16x8 pa1, bf16x8 pa2, bf16x8 pa3) {
    s16x4 va[8], vb8[8];
    v_read8<0>(va, vb);
    v_read8<1>(vb8, vb); asm volatile("s_waitcnt lgkmcnt(8)" ::: "memory"); SBAR(); pv_mma4(o[0], va, pa0, pa1, pa2, pa3);
    v_read8<2>(va, vb);  asm volatile("s_waitcnt lgkmcnt(8)" ::: "memory"); SBAR(); pv_mma4(o[1], vb8, pa0, pa1, pa2, pa3);
    v_read8<3>(vb8, vb); asm volatile("s_waitcnt lgkmcnt(8)" ::: "memory"); SBAR(); pv_mma4(o[2], va, pa0, pa1, pa2, pa3);
    asm volatile("s_waitcnt lgkmcnt(0)" ::: "memory"); SBAR(); pv_mma4(o[3], vb8, pa0, pa1, pa2, pa3);
}
template <int DQK> struct SmC { static constexpr float SCALE = (DQK == 128) ? 0.08838834764831845f : 0.125f; static constexpr float MNAT = (DQK == 128) ? 16.f : 12.f; };
template <int DQK> __device__ __forceinline__ void softmax_tile(f32x16& p0, f32x16& p1, float& l_reg, bf16x8& pa0, bf16x8& pa1, bf16x8& pa2, bf16x8& pa3) {
    constexpr float C = SmC<DQK>::SCALE * 1.4426950408889634f, MC = -SmC<DQK>::MNAT * 1.4426950408889634f;
#pragma unroll
    for (int r = 0; r < 16; ++r) p0[r] = __builtin_amdgcn_exp2f(fmaf(p0[r], C, MC));
#pragma unroll
    for (int r = 0; r < 16; ++r) p1[r] = __builtin_amdgcn_exp2f(fmaf(p1[r], C, MC));
    float ps = 0;
#pragma unroll
    for (int r = 0; r < 16; ++r) ps += p0[r];
#pragma unroll
    for (int r = 0; r < 16; ++r) ps += p1[r];
    { auto rr = __builtin_amdgcn_permlane32_swap(__float_as_uint(ps), __float_as_uint(ps), false, false);
      ps = __uint_as_float(rr[0]) + __uint_as_float(rr[1]); }
    l_reg += ps;
#define AT_PK4(P, BASE, OUT) do { unsigned a0 = cvt_pk_bf16(P[BASE + 0], P[BASE + 1]), a1 = cvt_pk_bf16(P[BASE + 2], P[BASE + 3]);   \
    unsigned b0 = cvt_pk_bf16(P[BASE + 4], P[BASE + 5]), b1 = cvt_pk_bf16(P[BASE + 6], P[BASE + 7]);                              \
    auto r0 = __builtin_amdgcn_permlane32_swap(a0, b0, false, false); auto r1 = __builtin_amdgcn_permlane32_swap(a1, b1, false, false); \
    u32x4 w = {r0[0], r1[0], r0[1], r1[1]}; OUT = __builtin_bit_cast(bf16x8, w); } while (0)
    AT_PK4(p0, 0, pa0); AT_PK4(p0, 8, pa1); AT_PK4(p1, 0, pa2); AT_PK4(p1, 8, pa3);
#undef AT_PK4
}
template <int DQK> __device__ __forceinline__ void qkt(f32x16& p0, f32x16& p1, LAS const unsigned char* Ks, const bf16x8* qr, int r32, int hi) {
#pragma unroll
    for (int r = 0; r < 16; ++r) { p0[r] = 0.f; p1[r] = 0.f; }
#pragma unroll
    for (int d0 = 0; d0 < DQK / 16; ++d0) { const int cb = (d0 * 16 + hi * 8) * 2;
        const bf16x8 b0 = *(LAS const bf16x8*)(Ks + kswz<DQK>(r32, cb));
        const bf16x8 b1 = *(LAS const bf16x8*)(Ks + kswz<DQK>(32 + r32, cb));
        p0 = __builtin_amdgcn_mfma_f32_32x32x16_bf16(b0, qr[d0], p0, 0, 0, 0);
        p1 = __builtin_amdgcn_mfma_f32_32x32x16_bf16(b1, qr[d0], p1, 0, 0, 0); }
}
struct AttnP {
    const bf16_t *zq, *zk, *zv;
    int tokbase, stride;
    int q0;
    int kstart;
    int NT;
    int W;
};
__device__ __forceinline__ void mask_tile(f32x16& p0, f32x16& p1, int qm, int kb, int W, int hi, int qw0) {
    const bool full = (qw0 - (kb + 63) >= 0) && (qw0 + 31 - kb <= W) && (kb >= 0);
    if (full) return;
    const float ninf = -__builtin_inff();
#pragma unroll
    for (int r = 0; r < 16; ++r) { const int km = kb + crow(r, hi); const int d0 = qm - km, d1 = d0 - 32;
        p0[r] = (d0 >= 0 && d0 <= W && km >= 0) ? p0[r] : ninf;
        p1[r] = (d1 >= 0 && d1 <= W && km + 32 >= 0) ? p1[r] : ninf; }
}
template <int DQK>
__device__ __forceinline__ void attn_run(const AttnP& P, LAS unsigned char* lds, f32x16 (&o)[4], float& l_reg, float& m_reg) {
    const int tid = opaque_tid(), wid = __builtin_amdgcn_readfirstlane(tid >> 6), lane = tid & 63, r32 = lane & 31, hi = lane >> 5;
    constexpr int KSUB = 64 * DQK * 2, KBUF = 2 * KSUB, VSUB = 16384, VBUF = 2 * VSUB;
    LAS unsigned char* K_lds = lds; LAS unsigned char* V_lds = lds + 2 * KBUF;
    m_reg = SmC<DQK>::MNAT / SmC<DQK>::SCALE; l_reg = 0.f;
#pragma unroll
    for (int d = 0; d < 4; ++d)
#pragma unroll
        for (int r = 0; r < 16; ++r) o[d][r] = 0.f;
    const int qw0 = P.q0 + wid * 32, qm = qw0 + r32;
    bf16x8 qr[DQK / 16];
    { const bf16_t* Qw = P.zq + (size_t)(P.tokbase + qm * P.stride) * WIN + hi * 8;
#pragma unroll
      for (int d0 = 0; d0 < DQK / 16; ++d0) qr[d0] = *(const bf16x8*)(Qw + d0 * 16); }
    int vkey[2], vcol[2], kkey[2], kcol[2];
#pragma unroll
    for (int i = 0; i < 2; ++i) { const int off = (tid + 512 * i) * 16; const int sub = off >> 9, within = off & 511, kk = (sub >> 2) * 8 + (within >> 6);
        vkey[i] = (kk & ~0xC) | ((kk & 4) << 1) | ((kk & 8) >> 1); vcol[i] = (sub & 3) * 32 + ((within & 63) >> 1);
        if (DQK == 128) { const int row = off >> 8, cs = off & 255; kkey[i] = row; kcol[i] = (cs ^ ((row & 7) << 4)) >> 1; }
        else { const int row = off >> 7, cs = off & 127; kkey[i] = row; kcol[i] = (cs ^ (((row >> 1) & 7) << 4)) >> 1; } }
    const unsigned vb0 = (unsigned)(size_t)V_lds + v_rd_base(lane);
#define AT_ROW(km) ((size_t)(P.tokbase + ((km) < 0 ? 0 : (km)) * P.stride) * WIN)
#define AT_DMA(jp, b) do { _Pragma("unroll") for (int s_ = 0; s_ < 2; ++s_) { const int k0_ = P.kstart + (2 * (jp) + s_) * 64; \
        _Pragma("unroll") for (int i_ = 0; i_ < 2; ++i_) __builtin_amdgcn_global_load_lds((const unsigned*)(P.zv + AT_ROW(k0_ + vkey[i_]) + vcol[i_]), (LAS unsigned*)(V_lds + (b) * VBUF + s_ * VSUB + wid * 1024 + i_ * 8192), 16, 0, 0); \
        _Pragma("unroll") for (int i_ = 0; i_ < (DQK == 128 ? 2 : 1); ++i_) __builtin_amdgcn_global_load_lds((const unsigned*)(P.zk + AT_ROW(k0_ + kkey[i_]) + kcol[i_]), (LAS unsigned*)(K_lds + (b) * KBUF + s_ * KSUB + wid * 1024 + i_ * 8192), 16, 0, 0); } } while (0)
    f32x16 pA0, pA1, pB0, pB1; bf16x8 pa0, pa1, pa2, pa3; const int NT2 = P.NT >> 1;
    AT_DMA(0, 0); VM_WAIT(); __syncthreads();
#pragma unroll 1
    for (int jp = 0; jp < NT2; ++jp) {
        const int b = jp & 1;
        if (jp + 1 < NT2) AT_DMA(jp + 1, b ^ 1);
        SBAR();
        const int kbA = P.kstart + jp * 128, kbB = kbA + 64;
        const bool noneA = (qw0 + 31 - kbA < 0) || (qw0 - (kbA + 63) > P.W) || (kbA + 63 < 0);
        const bool noneB = (qw0 + 31 - kbB < 0) || (qw0 - (kbB + 63) > P.W) || (kbB + 63 < 0);
        if (!noneA) qkt<DQK>(pA0, pA1, K_lds + b * KBUF, qr, r32, hi);
        if (!noneB) qkt<DQK>(pB0, pB1, K_lds + b * KBUF + KSUB, qr, r32, hi);
        SBAR();
        if (!noneA) { mask_tile(pA0, pA1, qm, kbA, P.W, hi, qw0); softmax_tile<DQK>(pA0, pA1, l_reg, pa0, pa1, pa2, pa3); SBAR(); pv_d0(o, vb0 + b * VBUF, pa0, pa1, pa2, pa3); }
        if (!noneB) { mask_tile(pB0, pB1, qm, kbB, P.W, hi, qw0); softmax_tile<DQK>(pB0, pB1, l_reg, pa0, pa1, pa2, pa3); SBAR(); pv_d0(o, vb0 + b * VBUF + VSUB, pa0, pa1, pa2, pa3); }
        VM_WAIT(); __syncthreads();
    }
#undef AT_ROW
#undef AT_DMA
}
__device__ __forceinline__ void attn_normalise(LAS unsigned char* lds, f32x16 (&o)[4], float l_reg) {
    const int tid = opaque_tid(), wid = tid >> 6, lane = tid & 63, r32 = lane & 31, hi = lane >> 5;
    LAS float* li_l = (LAS float*)(lds + LDS_WS) + wid * 64;
    if (hi == 0) li_l[r32] = l_reg; asm volatile("s_waitcnt lgkmcnt(0)" ::: "memory");
#pragma unroll
    for (int r = 0; r < 16; ++r) { const float rl = __builtin_amdgcn_rcpf(li_l[crow(r, hi)]);
#pragma unroll
        for (int d = 0; d < 4; ++d) o[d][r] *= rl; }
    asm volatile("s_waitcnt lgkmcnt(0)" ::: "memory");
}
}

#define XB_TMO      128
#define XB_XCNT(j)  (256  + 64 * (j))
#define XB_XSUB(j)  (1280 + 64 * (j))
#define XB_XGEN(j)  (2304 + 64 * (j))
#define XB_TOP      3328
#define XB_TOPGEN   3392
#define XCD_BAR_WORDS 3456
#define XB_SPIN_CAP (1u << 18)

__device__ __forceinline__ unsigned xb_ld(unsigned* p)              { return __hip_atomic_load(p, __ATOMIC_RELAXED, __HIP_MEMORY_SCOPE_AGENT); }
__device__ __forceinline__ unsigned xb_add(unsigned* p, unsigned v) { return __hip_atomic_fetch_add(p, v, __ATOMIC_RELAXED, __HIP_MEMORY_SCOPE_AGENT); }
__device__ __forceinline__ unsigned xb_xcc_id() { return (unsigned)__builtin_amdgcn_s_getreg((3 << 11) | 20) & 0xFu; }
#define XB_SPIN(cond, bar) do { unsigned _sp = 0; while (cond) { __builtin_amdgcn_s_sleep(1); \
    if ((++_sp & 255u) == 0u) { if (xb_ld(&(bar)[XB_TMO])) break; if (_sp > XB_SPIN_CAP) { atomicAdd(&(bar)[XB_TMO], 1u); break; } } } } while (0)

struct XcdBarrier {
    unsigned* bar; unsigned x;
    volatile LAS unsigned* st;
};

__device__ __forceinline__ XcdBarrier xcd_barrier_post(unsigned* bar, volatile LAS unsigned* st) {
    XcdBarrier b; b.bar = bar; b.x = xb_xcc_id(); b.st = st;
    if (threadIdx.x == 0) (void)xb_add(&bar[XB_XCNT(b.x)], 1u);
    return b;
}
__device__ __forceinline__ void xcd_barrier_complete(unsigned* bar, unsigned x, unsigned& nloc, unsigned& nx) {
    const unsigned G = gridDim.x * gridDim.y * gridDim.z;
    unsigned sum, cnt, mine, sp = 0u;
    for (;;) {
        sum = 0u; cnt = 0u; mine = 0u;
#pragma unroll
        for (unsigned j = 0; j < 16; ++j) { const unsigned c = xb_ld(&bar[XB_XCNT(j)]); sum += c; cnt += (c > 0u) ? 1u : 0u; mine = (j == x) ? c : mine; }
        if (sum == G) break;
        __builtin_amdgcn_s_sleep(1);
        if ((++sp & 255u) == 0u) { if (xb_ld(&bar[XB_TMO])) break; if (sp > XB_SPIN_CAP) { atomicAdd(&bar[XB_TMO], 1u); break; } }
    }
    nloc = mine > 0u ? mine : 1u; nx = cnt > 0u ? cnt : 1u;
}

__device__ __forceinline__ void xcd_barrier(const XcdBarrier& b) {
    asm volatile("s_waitcnt vmcnt(0)" ::: "memory");
    __syncthreads();
    if (threadIdx.x == 0) {
        unsigned* bar = b.bar;
        __builtin_amdgcn_s_waitcnt(0);
        unsigned nloc = b.st[0], nx = b.st[1];
        if (nloc == 0u) { xcd_barrier_complete(bar, b.x, nloc, nx); b.st[0] = nloc; b.st[1] = nx; }
        const unsigned old = xb_add(&bar[XB_XSUB(b.x)], 1u);
        const unsigned gen = old / nloc;
        if (old + 1u == (gen + 1u) * nloc) {
            __builtin_amdgcn_fence(__ATOMIC_RELEASE, "agent");
            asm volatile("s_waitcnt vmcnt(0)" ::: "memory");
            const unsigned og = xb_add(&bar[XB_TOP], 1u);
            const unsigned tg = og / nx;
            if (og + 1u == (tg + 1u) * nx) xb_add(&bar[XB_TOPGEN], 1u);
            else XB_SPIN(xb_ld(&bar[XB_TOPGEN]) == tg, bar);
            __builtin_amdgcn_fence(__ATOMIC_ACQUIRE, "agent");
            xb_add(&bar[XB_XGEN(b.x)], 1u);
            asm volatile("s_waitcnt vmcnt(0)" ::: "memory");
        } else {
            XB_SPIN(xb_ld(&bar[XB_XGEN(b.x)]) == gen, bar);
            __builtin_amdgcn_fence(__ATOMIC_ACQUIRE, "agent");
            asm volatile("s_waitcnt vmcnt(0)" ::: "memory");
        }
    }
    __syncthreads();
}

struct Args { const float* in[27]; float* out; unsigned char* ws; int ph_lo, ph_hi, mix_mask, pad; };
enum { I_X = 0, I_NORM_MIX, I_W_IN, I_SG_NORM, I_SG_W, I_SG_B, I_CONV_W, I_QN_C, I_KN_C, I_QN_D, I_KN_D, I_LQ1, I_LK1, I_LQ2, I_LK2, I_SUBLN, I_W_GATE, I_B_GATE, I_W_BRANCH, I_W_OUT,
       I_NORM_FFN, I_W_RG, I_B_RG, I_W_RE, I_B_RE, I_W_UP, I_W_DOWN };

__device__ __forceinline__ int perm_in(int n) {
    const int pn = n >> 8, tc = n & 255, bj = tc >> 7, wc = (tc >> 5) & 3, x = tc & 31;
    if (pn >= 10 && pn < 22) return ZC + (2 * (pn - 10) + (wc >> 1)) * 128 + 64 * bj + 32 * (wc & 1) + x;
    if (pn >= 28 && pn < 32) return ZD + (pn - 28) * 256 + wc * 64 + 32 * bj + x;
    return n;
}
__device__ __forceinline__ void tr_item(const float* colp, size_t ld, bf16_t* WT, int ldk, int n0, int k0, LAS float* scr, int lane) {
#pragma unroll 8
    for (int i = 0; i < 32; ++i) { const int kk = 2 * i + (lane >> 5); scr[kk * 33 + (lane & 31)] = colp[(size_t)(k0 + kk) * ld]; }
    LDS_WAIT(); asm volatile("" ::: "memory");
    const int c = lane & 7;
#pragma unroll
    for (int j = 0; j < 4; ++j) { const int n = (lane >> 3) + 8 * j; const LAS float* s = scr + (8 * c) * 33 + n;
        u32x4 o; o.x = cvt_pk_bf16(s[0 * 33], s[1 * 33]); o.y = cvt_pk_bf16(s[2 * 33], s[3 * 33]); o.z = cvt_pk_bf16(s[4 * 33], s[5 * 33]); o.w = cvt_pk_bf16(s[6 * 33], s[7 * 33]);
        *(u32x4*)(WT + (size_t)(n0 + n) * ldk + k0 + 8 * c) = o; }
    LDS_WAIT(); asm volatile("" ::: "memory");
}
__device__ __forceinline__ void tr_item_fp8(const float* colp, size_t ld, unsigned char* WT, int ldk, int n0, int k0, LAS float* scr, int lane, float scale) {
#pragma unroll 8
    for (int i = 0; i < 32; ++i) { const int kk = 2 * i + (lane >> 5); scr[kk * 33 + (lane & 31)] = colp[(size_t)(k0 + kk) * ld]; }
    LDS_WAIT(); asm volatile("" ::: "memory");
    const int n = lane >> 1, kh = (lane & 1) * 32; const LAS float* s = scr + kh * 33 + n;
    u32x4 o[2];
#pragma unroll
    for (int q = 0; q < 8; ++q) { int p = __builtin_amdgcn_cvt_pk_fp8_f32(s[(4 * q) * 33] * scale, s[(4 * q + 1) * 33] * scale, 0, false); p = __builtin_amdgcn_cvt_pk_fp8_f32(s[(4 * q + 2) * 33] * scale, s[(4 * q + 3) * 33] * scale, p, true); o[q >> 2][q & 3] = (unsigned)p; }
    *(u32x4*)(WT + (size_t)(n0 + n) * ldk + k0 + kh) = o[0]; *(u32x4*)(WT + (size_t)(n0 + n) * ldk + k0 + kh + 16) = o[1];
    LDS_WAIT(); asm volatile("" ::: "memory");
}
struct TrItem { const float* ub; unsigned vo; unsigned char* dst; };
template <bool F8>
__device__ __forceinline__ void tr_finish(unsigned char* dst, const int ldk, LAS float* scr, const int lane) {
    LDS_WAIT(); asm volatile("" ::: "memory");
    if constexpr (F8) {
        const int nn = lane >> 1, k32 = (lane & 1) * 32; const LAS float* s = scr + k32 * 33 + nn;
        u32x4 o[2];
#pragma unroll
        for (int q = 0; q < 8; ++q) { int p = __builtin_amdgcn_cvt_pk_fp8_f32(s[(4 * q) * 33] * 64.f, s[(4 * q + 1) * 33] * 64.f, 0, false); p = __builtin_amdgcn_cvt_pk_fp8_f32(s[(4 * q + 2) * 33] * 64.f, s[(4 * q + 3) * 33] * 64.f, p, true); o[q >> 2][q & 3] = (unsigned)p; }
        unsigned char* d = dst + (size_t)nn * ldk + k32;
        *(u32x4*)d = o[0]; *(u32x4*)(d + 16) = o[1];
    } else {
        const int c = lane & 7;
#pragma unroll
        for (int j = 0; j < 4; ++j) { const int nn = (lane >> 3) + 8 * j; const LAS float* s = scr + (8 * c) * 33 + nn;
            u32x4 o; o.x = cvt_pk_bf16(s[0 * 33], s[1 * 33]); o.y = cvt_pk_bf16(s[2 * 33], s[3 * 33]); o.z = cvt_pk_bf16(s[4 * 33], s[5 * 33]); o.w = cvt_pk_bf16(s[6 * 33], s[7 * 33]);
            *(u32x4*)(dst + (size_t)nn * ldk + 16 * c) = o; }
    }
    LDS_WAIT(); asm volatile("" ::: "memory");
}
#define TR_LOAD(v, t) do { _Pragma("unroll") for (int i = 0; i < 32; ++i) v[i] = __builtin_nontemporal_load((const float*)((const char*)((t).ub + (size_t)(2 * i) * ld) + ((t).vo + khb))); } while (0)
#define TR_PUT(v) do { _Pragma("unroll") for (int i = 0; i < 32; ++i) scr[(2 * i + kh) * 33 + l32] = v[i]; } while (0)
template <bool F8, class F>
__device__ __forceinline__ void tr_loop(const int n, const int gw, const int NGW, const size_t ld, const int ldk  , LAS float* scr, const int lane, F f) {
    int itA = __builtin_amdgcn_readfirstlane(gw); if (itA >= n) return;
    int itB = itA + NGW; bool hB = itB < n;
    const int kh = lane >> 5, l32 = lane & 31; const unsigned khb = (unsigned)(kh * ld * 4);
    TrItem A = f(itA), B = f(hB ? itB : itA);
    float va[32], vb[32];
    TR_LOAD(va, A);
    if (hB) TR_LOAD(vb, B);
    for (;;) {
        TR_PUT(va); const int nA = itA + 2 * NGW; const bool hnA = nA < n; unsigned char* dA = A.dst; if (hnA) { A = f(nA); TR_LOAD(va, A); }
        tr_finish<F8>(dA, ldk, scr, lane); itA = nA;
        if (!hB) break;
        TR_PUT(vb); const int nB = itB + 2 * NGW; const bool hnB = nB < n; unsigned char* dB = B.dst; if (hnB) { B = f(nB); TR_LOAD(vb, B); }
        tr_finish<F8>(dB, ldk, scr, lane); itB = nB;
        if (!hnA) break;
        hB = hnB;
    }
}
__device__ __forceinline__ void phase_prologue(const Args& a, LAS unsigned char* lds, const int part) {
    const int tid = opaque_tid(), wave = tid >> 6, lane = tid & 63, gw = blockIdx.x * NWAVES + wave, NGW = gridDim.x * NWAVES;
    LAS float* scr = (LAS float*)(lds + wave * 8704);
    const int l32 = lane & 31;
    for (int l = 0; l < 2; ++l) {
        unsigned char* wb = a.ws + WS_W + (size_t)l * W_LAYER;
        if ((l == 0) == (part == 0)) {
            const float* W = a.in[I_W_IN] + (size_t)l * D * WIN; unsigned char* WT = wb + W_IN; const int nblk = WIN / 32;
            if ((MK_Z8 >> l) & 1) tr_loop<true>((D / 64) * nblk, gw, NGW, WIN, D, scr, lane, [=](int it) { const int kb = it / nblk, nb = it % nblk;
                return TrItem{W + (size_t)kb * 64 * WIN, (unsigned)perm_in(nb * 32 + l32) * 4u, WT + (size_t)nb * 32 * D + kb * 64}; });
            else tr_loop<false>((D / 64) * nblk, gw, NGW, WIN, 2 * D, scr, lane, [=](int it) { const int kb = it / nblk, nb = it % nblk;
                return TrItem{W + (size_t)kb * 64 * WIN, (unsigned)perm_in(nb * 32 + l32) * 4u, WT + ((size_t)nb * 32 * D + kb * 64) * 2}; }); }
        if (part == 1) {
            const float* W = a.in[I_W_GATE] + (size_t)l * 4 * D * D; unsigned char* WT = wb + W_G; const int nblk = 8192 / 32;
            tr_loop<true>((D / 64) * nblk, gw, NGW, D, D, scr, lane, [=](int it) { const int kb = it / nblk, nb = it % nblk; const int n = nb * 32 + l32, pn = n >> 8, tc = n & 255;
                const int bj = tc >> 7, wc = (tc >> 5) & 3, fq = (tc >> 3) & 3, nn = (tc >> 2) & 1, j = tc & 3, k = 2 * bj + nn, c = 64 * pn + 16 * wc + 4 * fq + j;
                return TrItem{W + (size_t)kb * 64 * D, (unsigned)(k * D * D + c) * 4u, WT + (size_t)nb * 32 * D + kb * 64}; }); }
        if (part == 1) {
            const float* W = a.in[I_W_BRANCH] + (size_t)l * 4 * 512 * D; unsigned char* WT = wb + W_B; const int nblk = D / 32, per = (512 / 64) * nblk;
            tr_loop<false>(4 * per, gw, NGW, D, 1024, scr, lane, [=](int it) { const int k = it / per, r = it % per, kb = r / nblk, nb = r % nblk;
                return TrItem{W + (size_t)k * 512 * D + nb * 32 + (size_t)kb * 64 * D, (unsigned)l32 * 4u, WT + ((size_t)k * D * 512 + (size_t)nb * 32 * 512 + kb * 64) * 2}; }); }
        if (part == 1) {
            const float* W = a.in[I_W_OUT] + (size_t)l * D * D; unsigned char* WT = wb + W_O; const int nblk = D / 32;
            if (((MK_WO8 >> l) & 1) && !MK_DEBUG) tr_loop<true>((D / 64) * nblk, gw, NGW, D, D, scr, lane, [=](int it) { const int kb = it / nblk, nb = it % nblk;
                return TrItem{W + nb * 32 + (size_t)kb * 64 * D, (unsigned)l32 * 4u, WT + (size_t)nb * 32 * D + kb * 64}; });
            else tr_loop<false>((D / 64) * nblk, gw, NGW, D, 2 * D, scr, lane, [=](int it) { const int kb = it / nblk, nb = it % nblk;
                return TrItem{W + nb * 32 + (size_t)kb * 64 * D, (unsigned)l32 * 4u, WT + ((size_t)nb * 32 * D + kb * 64) * 2}; }); }
        if (part == 1) {
            const float* W = a.in[I_W_UP] + (size_t)l * NEXP * D * 1024; unsigned char* WT = wb + W_UP; const int nblk = 1024 / 32, per = (D / 64) * nblk;
            if (MK_MOE8 && l >= 0) tr_loop<true>(NEXP * per, gw, NGW, 1024, D, scr, lane, [=](int it) { const int e = it / per, r = it % per, kb = r / nblk, nb = r % nblk; const int n = nb * 32 + l32, pn = n >> 8, tc = n & 255;
                const int sc = (tc >> 7) * 512 + 128 * pn + (tc & 127);
                return TrItem{W + (size_t)e * D * 1024 + (size_t)kb * 64 * 1024, (unsigned)sc * 4u, WT + (size_t)e * 1024 * D + (size_t)nb * 32 * D + kb * 64}; });
            else tr_loop<false>(NEXP * per, gw, NGW, 1024, 2 * D, scr, lane, [=](int it) { const int e = it / per, r = it % per, kb = r / nblk, nb = r % nblk; const int n = nb * 32 + l32, pn = n >> 8, tc = n & 255;
                const int sc = (tc >> 7) * 512 + 128 * pn + (tc & 127);
                return TrItem{W + (size_t)e * D * 1024 + (size_t)kb * 64 * 1024, (unsigned)sc * 4u, WT + ((size_t)e * 1024 * D + (size_t)nb * 32 * D + kb * 64) * 2}; }); }
        if (part == 1) {
            const float* W = a.in[I_W_DOWN] + (size_t)l * NEXP * 512 * D; unsigned char* WT = wb + W_DN; const int nblk = D / 32, per = (512 / 64) * nblk;
            if (MK_MOE8 && l >= 0) tr_loop<true>(NEXP * per, gw, NGW, D, 512, scr, lane, [=](int it) { const int e = it / per, r = it % per, kb = r / nblk, nb = r % nblk;
                return TrItem{W + (size_t)e * 512 * D + nb * 32 + (size_t)kb * 64 * D, (unsigned)l32 * 4u, WT + (size_t)e * D * 512 + (size_t)nb * 32 * 512 + kb * 64}; });
            else tr_loop<false>(NEXP * per, gw, NGW, D, 1024, scr, lane, [=](int it) { const int e = it / per, r = it % per, kb = r / nblk, nb = r % nblk;
                return TrItem{W + (size_t)e * 512 * D + nb * 32 + (size_t)kb * 64 * D, (unsigned)l32 * 4u, WT + ((size_t)e * D * 512 + (size_t)nb * 32 * 512 + kb * 64) * 2}; }); }
        if (part == 0) {
            bf16_t* WT = (bf16_t*)(wb + W_R); const float* wrg = a.in[I_W_RG] + (size_t)l * D * 4; const float* wre = a.in[I_W_RE] + (size_t)l * D * 32;
            for (int i = blockIdx.x * NTHR + tid; i < 48 * D; i += gridDim.x * NTHR) { const int n = i / D, k = i % D; float v = 0.f;
                if (n < 4) v = wrg[k * 4 + n]; else if (n < 36) v = wre[k * 32 + (n - 4)];
                WT[i] = (bf16_t)(cvt_pk_bf16(v, 0.f) & 0xffffu); } }
    }
    if (part != 0) return;
    float* cosC = (float*)(a.ws + WS_COSC); float* sinC = (float*)(a.ws + WS_SINC); float* cosD = (float*)(a.ws + WS_COSD); float* sinD = (float*)(a.ws + WS_SIND);
    for (int i = blockIdx.x * NTHR + tid; i < SEQ * 96; i += gridDim.x * NTHR) {
        if (i < SEQ * 64) { const int p = i >> 6, k = i & 63; const float inv = (float)pow(10000.0, -(double)k / 64.0); const float ang = (float)p * inv; double s, c; sincos((double)ang, &s, &c); cosC[i] = (float)c; sinC[i] = (float)s; }
        else { const int q = i - SEQ * 64, p = q >> 5, k = q & 31; const float inv = (float)pow(10000.0, -(double)k / 32.0); const float ang = (float)p * inv; double s, c; sincos((double)ang, &s, &c); cosD[q] = (float)c; sinD[q] = (float)s; }
    }
}
__device__ __forceinline__ void phase_norm(const float* xf, const bf16_t* xb, const bf16_t* y0, const bf16_t* y1, bf16_t* xb_out, float* xf_out, const float* gain, bf16_t* h, unsigned* h8, const bool y8 = false) {
    const int tid = opaque_tid(), wave = tid >> 6, lane = tid & 63, gw = blockIdx.x * NWAVES + wave, NGW = gridDim.x * NWAVES;
    for (int m0 = gw; m0 < T; m0 += 2 * NGW) {
        f32x4 v[2][8];
#pragma unroll
        for (int r = 0; r < 2; ++r) { const int m = m0 + r * NGW; if (m < T) {
            if (xf) { const f32x4* xr = (const f32x4*)(xf + (size_t)m * D) + lane;
#pragma unroll
                for (int j = 0; j < 8; ++j) v[r][j] = __builtin_nontemporal_load(xr + 64 * j); }
            else { const u32x2* xr = (const u32x2*)(xb + (size_t)m * D) + lane;
#pragma unroll
                for (int j = 0; j < 8; ++j) { const u32x2 p = xr[64 * j]; v[r][j] = (f32x4){bf_lo(p.x), bf_hi(p.x), bf_lo(p.y), bf_hi(p.y)}; } } } }
        if (y0) {
#pragma unroll
            for (int r = 0; r < 2; ++r) { const int m = m0 + r * NGW; if (m < T) {
                if (y8) { const unsigned* a0 = (const unsigned*)((const unsigned char*)y0 + (size_t)m * D) + lane; const unsigned* a1 = (const unsigned*)((const unsigned char*)y1 + (size_t)m * D) + lane;
#pragma unroll
                    for (int j = 0; j < 8; ++j) { const int p = (int)__builtin_nontemporal_load(a0 + 64 * j), q = (int)__builtin_nontemporal_load(a1 + 64 * j);
                        v[r][j][0] += (__builtin_amdgcn_cvt_f32_fp8(p, 0) + __builtin_amdgcn_cvt_f32_fp8(q, 0)) * 0.0625f; v[r][j][1] += (__builtin_amdgcn_cvt_f32_fp8(p, 1) + __builtin_amdgcn_cvt_f32_fp8(q, 1)) * 0.0625f;
                        v[r][j][2] += (__builtin_amdgcn_cvt_f32_fp8(p, 2) + __builtin_amdgcn_cvt_f32_fp8(q, 2)) * 0.0625f; v[r][j][3] += (__builtin_amdgcn_cvt_f32_fp8(p, 3) + __builtin_amdgcn_cvt_f32_fp8(q, 3)) * 0.0625f; } }
                else {
                const u32x2* a0 = (const u32x2*)(y0 + (size_t)m * D) + lane; const u32x2* a1 = (const u32x2*)(y1 + (size_t)m * D) + lane;
#pragma unroll
                for (int j = 0; j < 8; ++j) { const u32x2 p = __builtin_nontemporal_load(a0 + 64 * j), q = __builtin_nontemporal_load(a1 + 64 * j);
                    v[r][j][0] += bf_lo(p.x) + bf_lo(q.x); v[r][j][1] += bf_hi(p.x) + bf_hi(q.x); v[r][j][2] += bf_lo(p.y) + bf_lo(q.y); v[r][j][3] += bf_hi(p.y) + bf_hi(q.y); } } } }
        }
        if (xb_out) {
#pragma unroll
            for (int r = 0; r < 2; ++r) { const int m = m0 + r * NGW; if (m < T) { u32x2* xo = (u32x2*)(xb_out + (size_t)m * D) + lane;
#pragma unroll
                for (int j = 0; j < 8; ++j) { u32x2 w; w.x = cvt_pk_bf16(v[r][j][0], v[r][j][1]); w.y = cvt_pk_bf16(v[r][j][2], v[r][j][3]); xo[64 * j] = w; } } }
        }
        if (xf_out) {
#pragma unroll
            for (int r = 0; r < 2; ++r) { const int m = m0 + r * NGW; if (m < T) { f32x4* xo = (f32x4*)(xf_out + (size_t)m * D) + lane;
#pragma unroll
                for (int j = 0; j < 8; ++j) xo[64 * j] = v[r][j]; } }
        }
        if (h || h8) {
#pragma unroll
            for (int r = 0; r < 2; ++r) { const int m = m0 + r * NGW; if (m < T) { float ss = 0.f;
#pragma unroll
                for (int j = 0; j < 8; ++j) ss += (v[r][j][0] * v[r][j][0] + v[r][j][1] * v[r][j][1]) + (v[r][j][2] * v[r][j][2] + v[r][j][3] * v[r][j][3]);
                const float rstd = 1.0f / sqrtf(wave_sum(ss) * (1.0f / D) + EPS);
                u32x2* ho = (u32x2*)(h + (size_t)m * D) + lane; const f32x4* gr = (const f32x4*)gain + lane;
#pragma unroll
                for (int j = 0; j < 8; ++j) { const f32x4 g = gr[64 * j]; const float h0 = v[r][j][0] * rstd * g[0], h1 = v[r][j][1] * rstd * g[1], h2 = v[r][j][2] * rstd * g[2], h3 = v[r][j][3] * rstd * g[3];
                    if (h) { u32x2 w; w.x = cvt_pk_bf16(h0, h1); w.y = cvt_pk_bf16(h2, h3); ho[64 * j] = w; }
                    if (h8) { int p = __builtin_amdgcn_cvt_pk_fp8_f32(h0, h1, 0, false); p = __builtin_amdgcn_cvt_pk_fp8_f32(h2, h3, p, true); h8[(size_t)m * (D / 4) + lane + 64 * j] = (unsigned)p; } } } }
        }
    }
}
__device__ __forceinline__ void mixer_a_unit(const Args& a, int l, int chunk, LAS unsigned char* lds) {
    const int tid = opaque_tid(), wid = tid >> 6, lane = tid & 63, r32 = lane & 31, hi = lane >> 5;
    const bf16_t* Z = (const bf16_t*)(a.ws + WS_Z); bf16_t* Y = (bf16_t*)(a.ws + WS_Y);
    const int t0 = chunk * 128;
    {
        const int j = tid >> 2, g = tid & 3; const bf16_t* vp = Z + (size_t)(t0 + j) * WIN + 512 + g * 128; const float* gn = a.in[I_SG_NORM] + l * 512 + g * 128;
        u32x4 raw[16]; float ss = 0.f;
#pragma unroll
        for (int c = 0; c < 16; ++c) { raw[c] = *(const u32x4*)(vp + c * 8);
#pragma unroll
            for (int q = 0; q < 4; ++q) { const float x0 = bf_lo(raw[c][q]), x1 = bf_hi(raw[c][q]); ss += x0 * x0 + x1 * x1; } }
        ss += __shfl_xor(ss, 1); ss += __shfl_xor(ss, 2);
        const float rstd = 1.0f / sqrtf(ss * (1.0f / 512.0f) + EPS);
        LAS unsigned char* img = lds + g * 32768 + (j >> 6) * 16384;
#pragma unroll
        for (int c = 0; c < 16; ++c) { const f32x4 g0 = *(const f32x4*)(gn + c * 8), g1 = *(const f32x4*)(gn + c * 8 + 4); u32x4 w;
            w.x = cvt_pk_bf16(bf_lo(raw[c].x) * rstd * g0[0], bf_hi(raw[c].x) * rstd * g0[1]); w.y = cvt_pk_bf16(bf_lo(raw[c].y) * rstd * g0[2], bf_hi(raw[c].y) * rstd * g0[3]);
            w.z = cvt_pk_bf16(bf_lo(raw[c].z) * rstd * g1[0], bf_hi(raw[c].z) * rstd * g1[1]); w.w = cvt_pk_bf16(bf_lo(raw[c].w) * rstd * g1[2], bf_hi(raw[c].w) * rstd * g1[3]);
            *(LAS u32x4*)(img + at::v_st(j & 63, c * 8)) = w; }
    }
    __syncthreads();
    f32x16 o2[2][4];
    const int g = wid >> 1;
    { const float* Wg = a.in[I_SG_W] + ((size_t)(l * 4 + g) * 128) * 128;
#pragma unroll
      for (int ibs = 0; ibs < 2; ++ibs) { const int ib = 2 * (wid & 1) + ibs; const int i = 32 * ib + r32;
#pragma unroll
        for (int d = 0; d < 4; ++d)
#pragma unroll
            for (int r = 0; r < 16; ++r) o2[ibs][d][r] = 0.f;
        for (int jt = 0; jt < 2; ++jt) {
            if (64 * jt > 32 * ib + 31) continue;
            bf16x8 pa[4];
#pragma unroll
            for (int ks = 0; ks < 4; ++ks) { const int j0 = 64 * jt + 16 * ks + 8 * hi; const f32x4 w0 = *(const f32x4*)(Wg + (size_t)i * 128 + j0), w1 = *(const f32x4*)(Wg + (size_t)i * 128 + j0 + 4);
                float w[8] = {w0[0], w0[1], w0[2], w0[3], w1[0], w1[1], w1[2], w1[3]};
#pragma unroll
                for (int q = 0; q < 8; ++q) w[q] = (j0 + q <= i) ? w[q] : 0.f;
                u32x4 pk; pk.x = cvt_pk_bf16(w[0], w[1]); pk.y = cvt_pk_bf16(w[2], w[3]); pk.z = cvt_pk_bf16(w[4], w[5]); pk.w = cvt_pk_bf16(w[6], w[7]); pa[ks] = __builtin_bit_cast(bf16x8, pk); }
            const unsigned vb = (unsigned)(size_t)(lds + g * 32768 + jt * 16384) + at::v_rd_base(lane);
            at::pv_d0(o2[ibs], vb, pa[0], pa[1], pa[2], pa[3]);
        }
      } }
    __syncthreads();
    { const float* bs = a.in[I_SG_B] + (l * 4 + g) * 128;
#pragma unroll
      for (int ibs = 0; ibs < 2; ++ibs) { const int ib = 2 * (wid & 1) + ibs;
#pragma unroll
        for (int r = 0; r < 16; ++r) { const int ii = 32 * ib + at::crow(r, hi); const float b = bs[ii];
#pragma unroll
            for (int d = 0; d < 4; ++d) *(LAS bf16_t*)(lds + g * 32768 + ii * 256 + (32 * d + r32) * 2) = (bf16_t)(cvt_pk_bf16(o2[ibs][d][r] + b, 0.f) & 0xffffu); } } }
    __syncthreads();
#pragma unroll 4
    for (int k = 0; k < 16; ++k) { const int chunk = tid + 512 * k, i = chunk >> 6, c8 = (chunk & 63) * 8;
        const u32x4 mx = *(const LAS u32x4*)(lds + (c8 >> 7) * 32768 + i * 256 + (c8 & 127) * 2); const u32x4 uu = *(const u32x4*)(Z + (size_t)(t0 + i) * WIN + c8); u32x4 y;
#pragma unroll
        for (int q = 0; q < 4; ++q) y[q] = cvt_pk_bf16(bf_lo(uu[q]) * bf_lo(mx[q]), bf_hi(uu[q]) * bf_hi(mx[q]));
        *(u32x4*)(Y + (size_t)(t0 + i) * D + c8) = y; }
    __syncthreads();
}
__device__ __forceinline__ void mixer_b(const Args& a, int l) {
    const int tid = opaque_tid(), wave = tid >> 6, lane = tid & 63, gw = blockIdx.x * NWAVES + wave, NGW = gridDim.x * NWAVES;
    const bf16_t* Z = (const bf16_t*)(a.ws + WS_Z); bf16_t* Y = (bf16_t*)(a.ws + WS_Y); const float* cw = a.in[I_CONV_W] + l * 3 * 512; const int c = lane * 8;
    float kw[3][8];
#pragma unroll
    for (int w = 0; w < 3; ++w) { const f32x4 k0 = *(const f32x4*)(cw + w * 512 + c), k1 = *(const f32x4*)(cw + w * 512 + c + 4);
        kw[w][0] = k0[0]; kw[w][1] = k0[1]; kw[w][2] = k0[2]; kw[w][3] = k0[3]; kw[w][4] = k1[0]; kw[w][5] = k1[1]; kw[w][6] = k1[2]; kw[w][7] = k1[3]; }
    for (int blk = gw; blk < T / 8; blk += NGW) { const int t0 = blk * 8; const bool first = (t0 & (SEQ - 1)) == 0;
        const bf16_t* zr = Z + (size_t)t0 * WIN + ZB + c;
        u32x4 cg[10], hb[10], bg[8];
#pragma unroll
        for (int i = 0; i < 10; ++i) { if (i < 2 && first) { cg[i] = (u32x4){0u, 0u, 0u, 0u}; hb[i] = cg[i]; } else { const bf16_t* zz = zr + (ptrdiff_t)(i - 2) * WIN; cg[i] = *(const u32x4*)(zz + 512); hb[i] = *(const u32x4*)(zz + 1024); } }
#pragma unroll
        for (int i = 0; i < 8; ++i) bg[i] = *(const u32x4*)(zr + (size_t)i * WIN);
        float p2[8], p1[8];
#pragma unroll
        for (int q = 0; q < 4; ++q) { p2[2 * q] = bf_lo(cg[0][q]) * bf_lo(hb[0][q]); p2[2 * q + 1] = bf_hi(cg[0][q]) * bf_hi(hb[0][q]); p1[2 * q] = bf_lo(cg[1][q]) * bf_lo(hb[1][q]); p1[2 * q + 1] = bf_hi(cg[1][q]) * bf_hi(hb[1][q]); }
#pragma unroll
        for (int i = 0; i < 8; ++i) { float p0[8]; u32x4 o;
#pragma unroll
            for (int q = 0; q < 4; ++q) { p0[2 * q] = bf_lo(cg[i + 2][q]) * bf_lo(hb[i + 2][q]); p0[2 * q + 1] = bf_hi(cg[i + 2][q]) * bf_hi(hb[i + 2][q]); }
#pragma unroll
            for (int q = 0; q < 4; ++q) { const float y0 = kw[0][2 * q] * p2[2 * q] + kw[1][2 * q] * p1[2 * q] + kw[2][2 * q] * p0[2 * q], y1 = kw[0][2 * q + 1] * p2[2 * q + 1] + kw[1][2 * q + 1] * p1[2 * q + 1] + kw[2][2 * q + 1] * p0[2 * q + 1];
                o[q] = cvt_pk_bf16(bf_lo(bg[i][q]) * y0, bf_hi(bg[i][q]) * y1); }
            *(u32x4*)(Y + (size_t)(t0 + i) * D + 512 + c) = o;
#pragma unroll
            for (int q = 0; q < 8; ++q) { p2[q] = p1[q]; p1[q] = p0[q]; } }
    }
}
__device__ __forceinline__ void mixer_c_unit(const Args& a, int unit, LAS unsigned char* lds) {
    const int tid = opaque_tid(), wid = tid >> 6, lane = tid & 63, r32 = lane & 31, hi = lane >> 5;
    const int sub = unit & 15, h = (unit >> 4) & 3, g = (unit >> 6) % 3, b = unit / 192;
    const int dil = (g == 0) ? 1 : (g == 1 ? 4 : 16); const int r = (g == 0) ? 0 : (g == 1 ? (sub & 3) : sub); const int n2 = (g == 0) ? sub : (g == 1 ? (sub >> 2) : 0);
    const bf16_t* Z = (const bf16_t*)(a.ws + WS_Z);
    at::AttnP P; P.zq = Z + ZC + ((0 * 3 + g) * 4 + h) * 128; P.zk = Z + ZC + ((1 * 3 + g) * 4 + h) * 128; P.zv = Z + ZC + ((2 * 3 + g) * 4 + h) * 128;
    P.tokbase = b * SEQ + r; P.stride = dil; P.q0 = 256 * n2; P.kstart = 256 * n2 - 128; P.NT = 6; P.W = 128;
    f32x16 o[4]; float l_reg, m_reg;
    at::attn_run<128>(P, lds, o, l_reg, m_reg);
    at::attn_normalise(lds, o, l_reg);
    bf16_t* CO = (bf16_t*)(a.ws + WS_CO) + (size_t)g * T * 512; float* LSE = (float*)(a.ws + WS_LSE) + (size_t)g * T * 4;
    const int qw0 = P.q0 + wid * 32;
    if (hi == 0) { const int tok = P.tokbase + (qw0 + r32) * dil; LSE[(size_t)tok * 4 + h] = m_reg * 0.08838834764831845f + __logf(l_reg); }
#pragma unroll
    for (int rr = 0; rr < 16; ++rr) { const size_t tok = (size_t)(P.tokbase + (qw0 + at::crow(rr, hi)) * dil);
#pragma unroll
        for (int d = 0; d < 4; ++d) CO[tok * 512 + h * 128 + 32 * d + r32] = (bf16_t)(cvt_pk_bf16(o[d][rr], 0.f) & 0xffffu); }
    __syncthreads();
}
__device__ __forceinline__ void mixer_c_merge(const Args& a) {
    const bf16_t* CO = (const bf16_t*)(a.ws + WS_CO); const float* LSE = (const float*)(a.ws + WS_LSE); bf16_t* Y = (bf16_t*)(a.ws + WS_Y);
    for (int it = blockIdx.x * NTHR + opaque_tid(); it < T * 64; it += gridDim.x * NTHR) { const int t = it >> 6, c = (it & 63) * 8, h = c >> 7;
        const float l0 = LSE[(size_t)t * 4 + h], l1 = LSE[(size_t)(T + t) * 4 + h], l2 = LSE[(size_t)(2 * T + t) * 4 + h]; const float mx = fmaxf(l0, fmaxf(l1, l2));
        float e0 = __expf(l0 - mx), e1 = __expf(l1 - mx), e2 = __expf(l2 - mx); const float inv = 1.0f / (e0 + e1 + e2); e0 *= inv; e1 *= inv; e2 *= inv;
        const u32x4 a0 = *(const u32x4*)(CO + (size_t)t * 512 + c), a1 = *(const u32x4*)(CO + ((size_t)T + t) * 512 + c), a2 = *(const u32x4*)(CO + ((size_t)2 * T + t) * 512 + c); u32x4 o;
#pragma unroll
        for (int q = 0; q < 4; ++q) o[q] = cvt_pk_bf16(e0 * bf_lo(a0[q]) + e1 * bf_lo(a1[q]) + e2 * bf_lo(a2[q]), e0 * bf_hi(a0[q]) + e1 * bf_hi(a1[q]) + e2 * bf_hi(a2[q]));
        *(u32x4*)(Y + (size_t)t * D + 1024 + c) = o; }
}
__device__ __forceinline__ float diff_lambda(const Args& a, int l, float lam_init) {
    const int lane = opaque_tid() & 63;
    const float s1 = wave_sum(a.in[I_LQ1][l * 64 + lane] * a.in[I_LK1][l * 64 + lane]), s2 = wave_sum(a.in[I_LQ2][l * 64 + lane] * a.in[I_LK2][l * 64 + lane]);
    return expf(s1) - expf(s2) + lam_init;
}
__device__ __forceinline__ void mixer_d_unit(const Args& a, int l, int unit, LAS unsigned char* lds) {
    const int tid = opaque_tid(), wid = tid >> 6, lane = tid & 63, r32 = lane & 31, hi = lane >> 5;
    const int pr = unit & 7, h = (unit >> 3) & 3, b = unit >> 5;
    const float lam_init = (l == 0) ? 0.2f : 0.35550906759096926f;
    const bf16_t* Z = (const bf16_t*)(a.ws + WS_Z); bf16_t* Y = (bf16_t*)(a.ws + WS_Y);
#pragma unroll 1
    for (int it = 0; it < 4; ++it) { const int qb = (it >> 1) ? 15 - pr : pr, map = it & 1;
        at::AttnP P; P.zq = Z + ZD + (h * 2 + map) * 64; P.zk = Z + ZD + 512 + (h * 2 + map) * 64; P.zv = Z + ZD + 1024 + h * 128;
        P.tokbase = b * SEQ; P.stride = 1; P.q0 = 256 * qb; P.kstart = 0; P.NT = 4 * (qb + 1); P.W = 1 << 29;
        f32x16 o[4]; float l_reg, m_reg;
        at::attn_run<64>(P, lds, o, l_reg, m_reg);
        at::attn_normalise(lds, o, l_reg);
        const int qw0 = P.q0 + wid * 32;
        if (map == 0) {
#pragma unroll
            for (int rr = 0; rr < 16; ++rr) { const size_t tok = (size_t)(P.tokbase + qw0 + at::crow(rr, hi));
#pragma unroll
                for (int d = 0; d < 4; ++d) Y[tok * D + 1536 + h * 128 + 32 * d + r32] = (bf16_t)(cvt_pk_bf16(o[d][rr], 0.f) & 0xffffu); }
            VM_WAIT();
        } else {
            const float lam = diff_lambda(a, l, lam_init); const float* sub = a.in[I_SUBLN] + l * 128;
            float sg[4];
#pragma unroll
            for (int d = 0; d < 4; ++d) sg[d] = sub[32 * d + r32] * (1.0f - lam_init);
#pragma unroll
            for (int rr = 0; rr < 16; ++rr) { const size_t tok = (size_t)(P.tokbase + qw0 + at::crow(rr, hi)); float ss = 0.f; float v[4];
#pragma unroll
                for (int d = 0; d < 4; ++d) { const float o1 = bf2f(Y[tok * D + 1536 + h * 128 + 32 * d + r32]); v[d] = o1 - lam * o[d][rr]; ss += v[d] * v[d]; }
                ss += __shfl_xor(ss, 1); ss += __shfl_xor(ss, 2); ss += __shfl_xor(ss, 4); ss += __shfl_xor(ss, 8); ss += __shfl_xor(ss, 16);
                const float rstd = 1.0f / sqrtf(ss * (1.0f / 128.0f) + EPS);
#pragma unroll
                for (int d = 0; d < 4; ++d) Y[tok * D + 1536 + h * 128 + 32 * d + r32] = (bf16_t)(cvt_pk_bf16(v[d] * rstd * sg[d], 0.f) & 0xffffu); }
        }
    }
}
__device__ __forceinline__ void phase_route(const Args& a, int l, LAS unsigned char* lds) {
    const int tid = opaque_tid(), wave = tid >> 6, lane = tid & 63, gw = blockIdx.x * NWAVES + wave, NGW = gridDim.x * NWAVES;
    const bf16_t* X = (const bf16_t*)(a.ws + WS_XB); bf16_t* H = (bf16_t*)(a.ws + WS_H); const bf16_t* WR = (const bf16_t*)(a.ws + WS_W + (size_t)l * W_LAYER + W_R);
    const float* gain = a.in[I_NORM_FFN] + l * D; const float* brg = a.in[I_B_RG] + l * 4; const float* bre = a.in[I_B_RE] + l * 32;
    unsigned* cnt = (unsigned*)(a.ws + WS_CTL) + CW_CNT + l * 32; u32x4* list = (u32x4*)(a.ws + WS_LIST); u32x4* route = (u32x4*)(a.ws + WS_ROUTE);
    LAS float* lg = (LAS float*)(lds + wave * 3072);
    const int rw = lane & 15, kg = lane >> 4;
    for (int grp = gw; grp < T / 16; grp += NGW) { const int row = grp * 16 + rw; const bf16_t* xr = X + (size_t)row * D + 8 * kg; bf16_t* hr = H + (size_t)row * D + 8 * kg; unsigned char* h8r = a.ws + WS_H8 + (size_t)row * D + 8 * kg;
        f32x4 acc[3];
#pragma unroll
        for (int nb = 0; nb < 3; ++nb) acc[nb] = (f32x4){0.f, 0.f, 0.f, 0.f};
        float ss = 0.f;
#pragma unroll 8
        for (int k0 = 0; k0 < D; k0 += 32) { const u32x4 xr4 = *(const u32x4*)(xr + k0); const f32x4 x0 = (f32x4){bf_lo(xr4.x), bf_hi(xr4.x), bf_lo(xr4.y), bf_hi(xr4.y)}, x1 = (f32x4){bf_lo(xr4.z), bf_hi(xr4.z), bf_lo(xr4.w), bf_hi(xr4.w)}; const f32x4 g0 = *(const f32x4*)(gain + k0 + 8 * kg), g1 = *(const f32x4*)(gain + k0 + 8 * kg + 4);
            ss += (x0[0] * x0[0] + x0[1] * x0[1]) + (x0[2] * x0[2] + x0[3] * x0[3]) + (x1[0] * x1[0] + x1[1] * x1[1]) + (x1[2] * x1[2] + x1[3] * x1[3]);
            u32x4 pk; pk.x = cvt_pk_bf16(x0[0] * g0[0], x0[1] * g0[1]); pk.y = cvt_pk_bf16(x0[2] * g0[2], x0[3] * g0[3]); pk.z = cvt_pk_bf16(x1[0] * g1[0], x1[1] * g1[1]); pk.w = cvt_pk_bf16(x1[2] * g1[2], x1[3] * g1[3]);
            if (MK_MOE8 && l >= 0) { int p0 = __builtin_amdgcn_cvt_pk_fp8_f32(x0[0] * g0[0], x0[1] * g0[1], 0, false); p0 = __builtin_amdgcn_cvt_pk_fp8_f32(x0[2] * g0[2], x0[3] * g0[3], p0, true);
                int p1 = __builtin_amdgcn_cvt_pk_fp8_f32(x1[0] * g1[0], x1[1] * g1[1], 0, false); p1 = __builtin_amdgcn_cvt_pk_fp8_f32(x1[2] * g1[2], x1[3] * g1[3], p1, true);
                *(u32x2*)(h8r + k0) = (u32x2){(unsigned)p0, (unsigned)p1}; }
            else *(u32x4*)(hr + k0) = pk;
            const bf16x8 af = __builtin_bit_cast(bf16x8, pk);
#pragma unroll
            for (int nb = 0; nb < 3; ++nb) { const bf16x8 bfr = *(const bf16x8*)(WR + (size_t)(16 * nb + rw) * D + k0 + 8 * kg); acc[nb] = __builtin_amdgcn_mfma_f32_16x16x32_bf16(af, bfr, acc[nb], 0, 0, 0); } }
        ss += __shfl_xor(ss, 16); ss += __shfl_xor(ss, 32);
        const float rstd = 1.0f / sqrtf(ss * (1.0f / D) + EPS);
#pragma unroll
        for (int nb = 0; nb < 3; ++nb)
#pragma unroll
            for (int rg = 0; rg < 4; ++rg) lg[(4 * kg + rg) * 48 + 16 * nb + rw] = acc[nb][rg];
        LDS_WAIT();
        if (lane < 16) { const LAS float* lr = lg + lane * 48;
            float gl[4]; int gi = 0; float gmx = -1e30f;
#pragma unroll
            for (int i = 0; i < 4; ++i) { gl[i] = lr[i] * rstd + brg[i]; if (gl[i] > gmx) { gmx = gl[i]; gi = i; } }
            float gs = 0.f;
#pragma unroll
            for (int i = 0; i < 4; ++i) gs += __expf(gl[i] - gmx);
            const float gp = 1.0f / gs;
            float v1 = -1e30f, v2 = -1e30f; int i1 = 0, i2 = 0;
            for (int i = 0; i < 8; ++i) { const float v = lr[4 + 8 * gi + i] * rstd + bre[8 * gi + i];
                if (v > v1) { v2 = v1; i2 = i1; v1 = v; i1 = i; } else if (v > v2) { v2 = v; i2 = i; } }
            const float ex = __expf(v2 - v1); const float w1 = gp / (1.0f + ex), w2 = gp * ex / (1.0f + ex);
            const int e1 = gi * 8 + i1, e2 = gi * 8 + i2;
            if (!(a.mix_mask & 16)) {
            const unsigned p1 = atomicAdd(cnt + e1, 1u), p2 = atomicAdd(cnt + e2, 1u);
            list[(size_t)e1 * T + p1] = (u32x4){(unsigned)row, __float_as_uint(w1), __float_as_uint(rstd), 0u};
            list[(size_t)e2 * T + p2] = (u32x4){(unsigned)row | 0x10000u, __float_as_uint(w2), __float_as_uint(rstd), 0u}; }
            route[row] = (u32x4){(unsigned)e1, (unsigned)e2, __float_as_uint(w1), __float_as_uint(w2)};
        }
        LDS_WAIT();
    }
}
__device__ __forceinline__ void moe_tables(const Args& a, int l, LAS unsigned char* lds) {
    LAS int* tab = (LAS int*)(lds + gm::TAB_OFF); const unsigned* cnt = (const unsigned*)(a.ws + WS_CTL) + CW_CNT + l * 32;
    if (threadIdx.x == 0) { int off = 0; for (int e = 0; e < 32; ++e) { const int c = (int)__hip_atomic_load(cnt + e, __ATOMIC_RELAXED, __HIP_MEMORY_SCOPE_AGENT); tab[e] = off; tab[40 + e] = c; off += (c + 255) >> 8; } tab[32] = off; }
    __syncthreads();
}
__device__ __forceinline__ void phase_final(const Args& a) { phase_norm(nullptr, (const bf16_t*)(a.ws + WS_XB), (const bf16_t*)(a.ws + WS_Y0), (const bf16_t*)(a.ws + WS_Y1), nullptr, a.out, nullptr, nullptr, nullptr, MK_Y8 && !MK_DEBUG); }

constexpr int PH_PER_LAYER = 10, N_PHASES = 2 + 2 * PH_PER_LAYER;
template <int l> __device__ __forceinline__ void layer_phases(const Args& a, LAS unsigned char* lds, const int lo, const int hi, const XcdBarrier& bar) {
#define IN(k) (lo <= (k) && (k) < hi)
#define SEAM(k) do { if (IN(k) && IN((k) + 1)) xcd_barrier(bar); } while (0)
    {
        const int pb = 1 + l * PH_PER_LAYER;
        unsigned char* wb = a.ws + WS_W + (size_t)l * W_LAYER;
        bf16_t* H = (bf16_t*)(a.ws + WS_H); bf16_t* Z = (bf16_t*)(a.ws + WS_Z); bf16_t* Y = (bf16_t*)(a.ws + WS_Y);
        if (IN(pb + 0)) {
            if (l == 0) phase_norm(a.in[I_X], nullptr, nullptr, nullptr, nullptr, nullptr, a.in[I_NORM_MIX], H, (unsigned*)(a.ws + WS_H8));
            else phase_norm(nullptr, (const bf16_t*)(a.ws + WS_XB), (const bf16_t*)(a.ws + WS_Y0), (const bf16_t*)(a.ws + WS_Y1), (bf16_t*)(a.ws + WS_XB), nullptr, a.in[I_NORM_MIX] + D, ((MK_Z8 >> 1) & 1) && !MK_DEBUG ? nullptr : H, (unsigned*)(a.ws + WS_H8));
        }
        SEAM(pb + 0);
        if (IN(pb + 1)) {
            gm::Desc g{H, wb + W_IN, 2 * D, 2 * D, 2 * D}; if ((MK_Z8 >> l) & 1) g = gm::Desc{a.ws + WS_H8, wb + W_IN, D, D, D, 121, 127}; gm::StaticOrder S; S.init(T, WIN, gridDim.x, blockIdx.x);
            gm::EpiZ E{Z, a.in[I_QN_C] + l * 128, a.in[I_KN_C] + l * 128, a.in[I_QN_D] + l * 64, a.in[I_KN_D] + l * 64,
                       (const float*)(a.ws + WS_COSC), (const float*)(a.ws + WS_SINC), (const float*)(a.ws + WS_COSD), (const float*)(a.ws + WS_SIND)};
            if constexpr (l == 0) {
                const int split = (int)((blockIdx.x * 17u) >> 8);
#pragma unroll 1
                for (int seg = 0; seg < 2; ++seg) {
                    S.i0 = seg ? split : 0; S.iend = seg ? (1 << 30) : split;
                    if constexpr ((MK_Z8 >> l) & 1) gm::gemm_phase<true>(lds, g, S, E); else gm::gemm_phase(lds, g, S, E);
                    if (seg == 0) { __syncthreads(); phase_prologue(a, lds, 1); __syncthreads(); }
                }
            } else {
                if constexpr ((MK_Z8 >> l) & 1) gm::gemm_phase<true>(lds, g, S, E); else gm::gemm_phase(lds, g, S, E);
            }
        }
        SEAM(pb + 1);
        if (IN(pb + 2)) {
            const int vbx = (gridDim.x == 256) ? (int)((blockIdx.x & 7) * 32 + (blockIdx.x >> 3)) : (int)blockIdx.x;
            if (a.mix_mask & 1) for (int u = vbx; u < 256; u += gridDim.x) mixer_d_unit(a, l, u, lds);
            if (a.mix_mask & 2) for (int u = vbx; u < 1536; u += gridDim.x) mixer_c_unit(a, u, lds);
            if (a.mix_mask & 4) for (int u = blockIdx.x; u < T / 128; u += gridDim.x) mixer_a_unit(a, l, u, lds);
            if (a.mix_mask & 8) mixer_b(a, l);
        }
        SEAM(pb + 2);
        if (IN(pb + 3)) mixer_c_merge(a);
        SEAM(pb + 3);
        if (IN(pb + 4)) {
            gm::Desc g{Y, wb + W_B, 2 * D, 1024, 1024}; gm::BranchOrder S; S.init(T, 8192, gridDim.x, blockIdx.x);
            gm::EpiBf16 E{Z, 8192};
            gm::gemm_phase(lds, g, S, E);
        }
        SEAM(pb + 4);
        if (IN(pb + 5)) {
            gm::Desc g{a.ws + WS_H8, wb + W_G, D, D, D};     gm::StaticOrder S; S.init(T, 8192, gridDim.x, blockIdx.x);
            gm::EpiGateT<((MK_WO8 >> l) & 1) && !MK_DEBUG> E{Y, Z, a.in[I_B_GATE] + (size_t)l * 4 * D};
            gm::gemm_phase<true>(lds, g, S, E);
        }
        SEAM(pb + 5);
        if (IN(pb + 6)) {
            gm::Desc g{Y, wb + W_O, 2 * D, 2 * D, 2 * D}; if (((MK_WO8 >> l) & 1) && !MK_DEBUG) g = gm::Desc{Y, wb + W_O, D, D, D, 121, 127}; gm::StaticOrder S; S.init(T, D, gridDim.x, blockIdx.x);
            gm::EpiResid E{l == 0 ? a.in[I_X] : nullptr, (bf16_t*)(a.ws + WS_XB)};
            if constexpr (((MK_WO8 >> l) & 1) && !MK_DEBUG) gm::gemm_phase<true>(lds, g, S, E); else gm::gemm_phase(lds, g, S, E);
        }
        SEAM(pb + 6);
        if (IN(pb + 7)) phase_route(a, l, lds);
        SEAM(pb + 7);
        if (IN(pb + 8)) {
            moe_tables(a, l, lds);
            gm::Desc g{H, wb + W_UP, 2 * D, 2 * D, 2 * D}; if (MK_MOE8 && l >= 0) g = gm::Desc{a.ws + WS_H8, wb + W_UP, D, D, D, 121, 127}; gm::MoeUpOrder S; S.nN = 4; S.G = gridDim.x; S.c = blockIdx.x; S.tab = (LAS const int*)(lds + gm::TAB_OFF); S.list = (const u32x4*)(a.ws + WS_LIST); S.nexp_rows = 1024;
            if constexpr (MK_MOE8 && l >= 0) { gm::EpiUpT<true> E{a.ws + WS_HID, (const u32x4*)(a.ws + WS_LIST)}; gm::gemm_phase<true>(lds, g, S, E); }
            else { gm::EpiUpT<false> E{a.ws + WS_HID, (const u32x4*)(a.ws + WS_LIST)}; gm::gemm_phase(lds, g, S, E); }
        }
        SEAM(pb + 8);
        if (IN(pb + 9)) {
            moe_tables(a, l, lds);
            gm::Desc g{a.ws + WS_HID, wb + W_DN, 1024, 1024, 1024}; if (MK_MOE8 && l >= 0) g = gm::Desc{a.ws + WS_HID, wb + W_DN, 512, 512, 512, 121, 123}; gm::MoeDownOrder S; S.nN = 8; S.G = gridDim.x; S.c = blockIdx.x; S.tab = (LAS const int*)(lds + gm::TAB_OFF); S.list = (const u32x4*)(a.ws + WS_LIST); S.nexp_rows = 2048;
            gm::EpiDownT<(MK_Y8 && l == 1 && !MK_DEBUG)> E{a.ws + WS_Y0, a.ws + WS_Y1, (const u32x4*)(a.ws + WS_LIST)};
            if constexpr (MK_MOE8 && l >= 0) gm::gemm_phase<true>(lds, g, S, E); else gm::gemm_phase(lds, g, S, E);
        }
        SEAM(pb + 9);
    }
#undef SEAM
#undef IN
}
constexpr int MISC_OFF = 143360;
__global__ void __launch_bounds__(NTHR, 2) mk_fwd(Args a) {
    extern __shared__ __attribute__((aligned(16))) unsigned char lds_raw[];
    LAS unsigned char* lds = (LAS unsigned char*)lds_raw;
    const int lo = a.ph_lo, hi = a.ph_hi;
    volatile LAS unsigned* misc = (volatile LAS unsigned*)(lds + MISC_OFF);
    if (threadIdx.x < 4) misc[threadIdx.x] = 0u;
    __syncthreads();
    XcdBarrier bar; bar.bar = (unsigned*)(a.ws + WS_CTL) + CW_BAR; bar.x = 0; bar.st = misc;
    if (hi - lo > 1) bar = xcd_barrier_post((unsigned*)(a.ws + WS_CTL) + CW_BAR, misc);
    if (lo <= 0 && 0 < hi) phase_prologue(a, lds, 0);
    layer_phases<0>(a, lds, lo, hi, bar);
    layer_phases<1>(a, lds, lo, hi, bar);
    if (lo <= N_PHASES - 1 && N_PHASES - 1 < hi) phase_final(a);
#if MK_XPROBE
    if (lo <= 50 && 50 < hi) {
        unsigned char* wb = a.ws + WS_W;
        gm::Desc g{a.ws + WS_H, wb + MK_XPROBE_W, 2 * D, 2 * MK_XPROBE_K, 2 * MK_XPROBE_K}; gm::StaticOrder S; S.init(T, MK_XPROBE_N, gridDim.x, blockIdx.x);
        gm::EpiProbe E{(float*)(a.ws + WS_CO)};
        gm::gemm_phase(lds, g, S, E);
    }
#endif
}

#if MK_DEBUG
__device__ __forceinline__ void diag_put(unsigned char* ws, int stage, float err, float ref, float rel, float absf) {
    float ratio = fabsf(err) / (rel * fabsf(ref) + absf); if (!(ratio == ratio) || !(fabsf(err) < 1e30f)) ratio = 1e9f;
    atomicMax((unsigned*)(ws + WS_CTL) + CW_DIAG + stage, __float_as_uint(ratio));
}
__device__ __forceinline__ unsigned hash_u(unsigned x) { x ^= x >> 16; x *= 0x7feb352du; x ^= x >> 15; x *= 0x846ca68bu; x ^= x >> 16; return x; }
__global__ void ck_h(Args a, int l, int stage) {
    const int row = hash_u(blockIdx.x * 7 + 1) % T; const float* g = a.in[I_NORM_MIX] + l * D; const bf16_t* h = (const bf16_t*)(a.ws + WS_H) + (size_t)row * D;
#define CKX(c) (l == 0 ? a.in[I_X][(size_t)row * D + (c)] : bf2f(((const bf16_t*)(a.ws + WS_XB))[(size_t)row * D + (c)]))
    float ss = 0.f; for (int c = threadIdx.x; c < D; c += 64) ss += CKX(c) * CKX(c); ss = wave_sum(ss); const float rstd = 1.0f / sqrtf(ss / D + EPS);
    for (int c = threadIdx.x; c < D; c += 64) { const float ref = CKX(c) * rstd * g[c]; diag_put(a.ws, stage, bf2f(h[c]) - ref, ref, 0.01f, 0.01f); }
#undef CKX
}
__device__ float dot_hw(const bf16_t* hrow, const float* W, size_t ld, int K) { float s = 0.f; for (int k = 0; k < K; ++k) s += bf2f(hrow[k]) * W[(size_t)k * ld]; return s; }
__global__ void ck_z_ident(Args a, int l, int stage) {
    const unsigned hsh = hash_u(blockIdx.x * 64 + threadIdx.x + 77); const int row = hsh % T; int col; { const unsigned q = hash_u(hsh + 5) % 4096; col = q < 2560 ? q : (q < 3328 ? ZC + 3072 + (q - 2560) * 2 : ZD + 1024 + (q - 3328) % 512); }
    const bf16_t* h = (const bf16_t*)(a.ws + WS_H) + (size_t)row * D; float ref = dot_hw(h, a.in[I_W_IN] + (size_t)l * D * WIN + col, WIN, D);
    if (col < 1024) { const float u = 0.7978845608028654f * (ref + 0.044715f * ref * ref * ref); ref = 0.5f * ref * (1.0f + tanhf(u)); }
    diag_put(a.ws, stage, bf2f(((const bf16_t*)(a.ws + WS_Z))[(size_t)row * WIN + col]) - ref, ref, 0.02f, 0.02f);
}
__global__ void ck_z_qk(Args a, int l, int stage, int isD) {
    __shared__ float v[128]; __shared__ float ssum;
    const unsigned hsh = hash_u(blockIdx.x + 1234 + isD * 999); const int row = hsh % T; const int nd = isD ? 64 : 128; const int grp = hash_u(hsh + 3) % (isD ? 16 : 24);
    const int d = threadIdx.x; const int colbase = isD ? ZD + grp * 64 : ZC + grp * 128;
    const bf16_t* h = (const bf16_t*)(a.ws + WS_H) + (size_t)row * D;
    if (d < nd) v[d] = dot_hw(h, a.in[I_W_IN] + (size_t)l * D * WIN + colbase + d, WIN, D);
    __syncthreads();
    if (d == 0) { float s = 0.f; for (int i = 0; i < nd; ++i) s += v[i] * v[i]; ssum = s; }
    __syncthreads();
    if (d < nd) { const float rstd = 1.0f / sqrtf(ssum / nd + EPS); const float* gn = isD ? ((grp >= 8 ? a.in[I_KN_D] : a.in[I_QN_D]) + l * 64) : ((grp >= 12 ? a.in[I_KN_C] : a.in[I_QN_C]) + l * 128);
        const int half = nd / 2, i = d % half; const float inv = powf(10000.0f, -(float)i / (float)half); const float ang = (float)(row % SEQ) * inv; const float cs = cosf(ang), sn = sinf(ang);
        const float x1 = v[i] * rstd * gn[i], x2 = v[i + half] * rstd * gn[i + half]; const float ref = (d < half) ? (x1 * cs - x2 * sn) : (x2 * cs + x1 * sn);
        diag_put(a.ws, stage, bf2f(((const bf16_t*)(a.ws + WS_Z))[(size_t)row * WIN + colbase + d]) - ref, ref, 0.02f, 0.03f); }
}
__global__ void ck_ya(Args a, int l, int stage) {
    __shared__ float rstd[128];
    const unsigned hsh = hash_u(blockIdx.x + 4321); const int chunk = hsh % (T / 128), i = (blockIdx.x < 4) ? (blockIdx.x * 42 + 1) % 128 : hash_u(hsh + 1) % 128, g = hash_u(hsh + 2) % 4; const int c = threadIdx.x; const int t0 = chunk * 128;
    const bf16_t* Z = (const bf16_t*)(a.ws + WS_Z);
    { float s = 0.f; const bf16_t* vr = Z + (size_t)(t0 + c) * WIN + 512; for (int k = 0; k < 512; ++k) s += bf2f(vr[k]) * bf2f(vr[k]); rstd[c] = 1.0f / sqrtf(s / 512.f + EPS); }
    __syncthreads();
    const float gn = a.in[I_SG_NORM][l * 512 + g * 128 + c]; const float* W = a.in[I_SG_W] + ((size_t)(l * 4 + g) * 128 + i) * 128; float mix = 0.f;
    for (int j = 0; j <= i; ++j) mix += W[j] * bf2f(Z[(size_t)(t0 + j) * WIN + 512 + g * 128 + c]) * rstd[j] * gn;
    mix += a.in[I_SG_B][(l * 4 + g) * 128 + i];
    const float ref = bf2f(Z[(size_t)(t0 + i) * WIN + g * 128 + c]) * mix;
    diag_put(a.ws, stage, bf2f(((const bf16_t*)(a.ws + WS_Y))[(size_t)(t0 + i) * D + g * 128 + c]) - ref, ref, 0.03f, 0.03f);
}
__global__ void ck_yb(Args a, int l, int stage) {
    const unsigned hsh = hash_u(blockIdx.x * 64 + threadIdx.x + 99); int t = hsh % T; if (threadIdx.x < 4) t = (t & ~(SEQ - 1)) + threadIdx.x; const int c = hash_u(hsh + 1) % 512, s = t % SEQ; const bf16_t* Z = (const bf16_t*)(a.ws + WS_Z);
    float acc = 0.f; for (int w = 0; w < 3; ++w) { const int back = 2 - w; if (s - back < 0) continue; const bf16_t* zr = Z + (size_t)(t - back) * WIN + ZB; acc += a.in[I_CONV_W][l * 1536 + w * 512 + c] * bf2f(zr[512 + c]) * bf2f(zr[1024 + c]); }
    const float ref = bf2f(Z[(size_t)t * WIN + ZB + c]) * acc;
    diag_put(a.ws, stage, bf2f(((const bf16_t*)(a.ws + WS_Y))[(size_t)t * D + 512 + c]) - ref, ref, 0.02f, 0.02f);
}
__global__ void ck_yc(Args a, int l, int stage) {
    __shared__ float sc[132]; __shared__ float red[2]; __shared__ float og[3][128]; __shared__ float lse[3];
    const unsigned hsh = hash_u(blockIdx.x + 555); int t = hsh % T; if (blockIdx.x < 6) t = (t & ~(SEQ - 1)) + blockIdx.x * 37; const int j = hash_u(hsh + 1) % 4; const int s = t % SEQ, d = threadIdx.x; const bf16_t* Z = (const bf16_t*)(a.ws + WS_Z);
    for (int g = 0; g < 3; ++g) { const int dil = g == 0 ? 1 : (g == 1 ? 4 : 16);
        const bf16_t* q = Z + (size_t)t * WIN + ZC + ((0 * 3 + g) * 4 + j) * 128;
        for (int kk = d; kk < 129; kk += 128) { const int sk = s - kk * dil; float v = -1e30f; if (sk >= 0) { const bf16_t* kp = Z + (size_t)(t - kk * dil) * WIN + ZC + ((1 * 3 + g) * 4 + j) * 128; float dd = 0.f; for (int e = 0; e < 128; ++e) dd += bf2f(q[e]) * bf2f(kp[e]); v = dd * 0.08838834764831845f; } sc[kk] = v; }
        __syncthreads();
        if (d == 0) { float mx = -1e30f; for (int kk = 0; kk < 129; ++kk) mx = fmaxf(mx, sc[kk]); float sm = 0.f; for (int kk = 0; kk < 129; ++kk) sm += (sc[kk] > -1e29f) ? expf(sc[kk] - mx) : 0.f; red[0] = mx; red[1] = sm; lse[g] = mx + logf(sm); }
        __syncthreads();
        float o = 0.f; for (int kk = 0; kk < 129; ++kk) { if (sc[kk] > -1e29f) o += expf(sc[kk] - red[0]) / red[1] * bf2f(Z[(size_t)(t - kk * dil) * WIN + ZC + ((2 * 3 + g) * 4 + j) * 128 + d]); }
        og[g][d] = o; __syncthreads(); }
    const float mx = fmaxf(lse[0], fmaxf(lse[1], lse[2])); const float e0 = expf(lse[0] - mx), e1 = expf(lse[1] - mx), e2 = expf(lse[2] - mx); const float ref = (e0 * og[0][d] + e1 * og[1][d] + e2 * og[2][d]) / (e0 + e1 + e2);
    diag_put(a.ws, stage, bf2f(((const bf16_t*)(a.ws + WS_Y))[(size_t)t * D + 1024 + j * 128 + d]) - ref, ref, 0.03f, 0.02f);
}
__global__ void ck_yd(Args a, int l, int stage) {
    __shared__ float sc[SEQ]; __shared__ float red[256]; __shared__ float o1s[128];
    const unsigned hsh = hash_u(blockIdx.x + 888); const int b = hsh % NB, h = hash_u(hsh + 1) % 4; int s = hash_u(hsh + 2) % SEQ; if (blockIdx.x < 8) { const int sp[8] = {0, 1, 31, 255, 256, 2047, 2048, 4095}; s = sp[blockIdx.x]; }
    const int d = threadIdx.x, t = b * SEQ + s; const bf16_t* Z = (const bf16_t*)(a.ws + WS_Z);
    const float lam_init = (l == 0) ? 0.2f : 0.35550906759096926f; float s1 = 0.f, s2 = 0.f; for (int i = 0; i < 64; ++i) { s1 += a.in[I_LQ1][l * 64 + i] * a.in[I_LK1][l * 64 + i]; s2 += a.in[I_LQ2][l * 64 + i] * a.in[I_LK2][l * 64 + i]; }
    const float lam = expf(s1) - expf(s2) + lam_init; float outv = 0.f;
    for (int map = 0; map < 2; ++map) { const bf16_t* q = Z + (size_t)t * WIN + ZD + (h * 2 + map) * 64;
        for (int k = d; k <= s; k += 128) { const bf16_t* kp = Z + (size_t)(b * SEQ + k) * WIN + ZD + 512 + (h * 2 + map) * 64; float dd = 0.f; for (int e = 0; e < 64; ++e) dd += bf2f(q[e]) * bf2f(kp[e]); sc[k] = dd * 0.125f; }
        __syncthreads();
        float mx = -1e30f; for (int k = d; k <= s; k += 128) mx = fmaxf(mx, sc[k]); red[d] = mx; __syncthreads(); if (d == 0) { float m = -1e30f; for (int i = 0; i < 128; ++i) m = fmaxf(m, red[i]); red[128] = m; } __syncthreads(); mx = red[128];
        float sm = 0.f; for (int k = d; k <= s; k += 128) sm += expf(sc[k] - mx); __syncthreads(); red[d] = sm; __syncthreads(); if (d == 0) { float m = 0.f; for (int i = 0; i < 128; ++i) m += red[i]; red[129] = m; } __syncthreads(); sm = red[129];
        float o = 0.f; for (int k = 0; k <= s; ++k) o += expf(sc[k] - mx) / sm * bf2f(Z[(size_t)(b * SEQ + k) * WIN + ZD + 1024 + h * 128 + d]);
        if (map == 0) outv = o; else outv -= lam * o; __syncthreads(); }
    o1s[d] = outv * outv; __syncthreads(); if (d == 0) { float m = 0.f; for (int i = 0; i < 128; ++i) m += o1s[i]; red[130] = m; } __syncthreads();
    const float ref = outv / sqrtf(red[130] / 128.f + EPS) * a.in[I_SUBLN][l * 128 + d] * (1.0f - lam_init);
    diag_put(a.ws, stage, bf2f(((const bf16_t*)(a.ws + WS_Y))[(size_t)t * D + 1536 + h * 128 + d]) - ref, ref, 0.04f, 0.04f);
}
__global__ void ck_p(Args a, int l, int stage) {
    const unsigned hsh = hash_u(blockIdx.x * 64 + threadIdx.x + 31337); const int t = hsh % T, k = hash_u(hsh + 1) % 4, c = hash_u(hsh + 2) % D; const bf16_t* y = (const bf16_t*)(a.ws + WS_Y) + (size_t)t * D + 512 * k;
    const float ref = dot_hw(y, a.in[I_W_BRANCH] + ((size_t)(l * 4 + k) * 512) * D + c, D, 512);
    diag_put(a.ws, stage, bf2f(((const bf16_t*)(a.ws + WS_Z))[(size_t)t * 8192 + k * D + c]) - ref, ref, 0.02f, 0.02f);
}
__global__ void ck_merged(Args a, int l, int stage) {
    const unsigned hsh = hash_u(blockIdx.x * 64 + threadIdx.x + 4242); const int t = hsh % T, c = hash_u(hsh + 2) % D; const bf16_t* h = (const bf16_t*)(a.ws + WS_H) + (size_t)t * D; float ref = 0.f;
    for (int k = 0; k < 4; ++k) { const float gl = dot_hw(h, a.in[I_W_GATE] + ((size_t)(l * 4 + k) * D) * D + c, D, D) + a.in[I_B_GATE][(l * 4 + k) * D + c]; ref += 1.0f / (1.0f + expf(-gl)) * bf2f(((const bf16_t*)(a.ws + WS_Z))[(size_t)t * 8192 + k * D + c]); }
    diag_put(a.ws, stage, bf2f(((const bf16_t*)(a.ws + WS_Y))[(size_t)t * D + c]) - ref, ref, 0.05f, 0.12f);
}
__global__ void ck_x1(Args a, int l, int stage) {
    const unsigned hsh = hash_u(blockIdx.x * 64 + threadIdx.x + 777); const int t = hsh % T, c = hash_u(hsh + 2) % D; const bf16_t* mg = (const bf16_t*)(a.ws + WS_Y) + (size_t)t * D;
    const float ref = a.in[I_X][(size_t)t * D + c] + dot_hw(mg, a.in[I_W_OUT] + (size_t)l * D * D + c, D, D);
    diag_put(a.ws, stage, bf2f(((const bf16_t*)(a.ws + WS_XB))[(size_t)t * D + c]) - ref, ref, 0.01f, 0.02f);
}
__global__ void ck_route(Args a, int l, int stage) {
    __shared__ float lg[36];
    const int t = hash_u(blockIdx.x + 9091) % T, lane = threadIdx.x; const bf16_t* xb_ = (const bf16_t*)(a.ws + WS_XB) + (size_t)t * D; const float* g = a.in[I_NORM_FFN] + l * D;
#define x(c) bf2f(xb_[c])
    float ss = 0.f; for (int c = lane; c < D; c += 64) ss += x(c) * x(c); ss = wave_sum(ss); const float rstd = 1.0f / sqrtf(ss / D + EPS);
    const bf16_t* h2 = (const bf16_t*)(a.ws + WS_H) + (size_t)t * D;
    if (!(MK_MOE8 && l >= 0)) for (int c = lane; c < D; c += 64) { const float ref = x(c) * g[c]; diag_put(a.ws, stage, bf2f(h2[c]) - ref, ref, 0.01f, 0.01f); }
    for (int n = 0; n < 36; ++n) { float s = 0.f; for (int c = lane; c < D; c += 64) { const float hv = x(c) * rstd * g[c]; s += hv * (n < 4 ? a.in[I_W_RG][(size_t)l * D * 4 + c * 4 + n] : a.in[I_W_RE][(size_t)l * D * 32 + c * 32 + (n - 4)]); } s = wave_sum(s); if (lane == 0) lg[n] = s + (n < 4 ? a.in[I_B_RG][l * 4 + n] : a.in[I_B_RE][l * 32 + n - 4]); }
    __syncthreads();
    if (lane == 0) { int gi = 0; for (int i = 1; i < 4; ++i) if (lg[i] > lg[gi]) gi = i; float gs = 0.f; for (int i = 0; i < 4; ++i) gs += expf(lg[i] - lg[gi]); const float gp = 1.0f / gs;
        int i1 = 0; for (int i = 1; i < 8; ++i) if (lg[4 + 8 * gi + i] > lg[4 + 8 * gi + i1]) i1 = i; int i2 = (i1 == 0) ? 1 : 0; for (int i = 0; i < 8; ++i) if (i != i1 && lg[4 + 8 * gi + i] > lg[4 + 8 * gi + i2]) i2 = i;
        const float v1 = lg[4 + 8 * gi + i1], v2 = lg[4 + 8 * gi + i2]; const float ex = expf(v2 - v1); const float w1 = gp / (1.f + ex), w2 = gp * ex / (1.f + ex);
        const u32x4 r = ((const u32x4*)(a.ws + WS_ROUTE))[t]; const int e1 = gi * 8 + i1, e2 = gi * 8 + i2;
        if ((int)r.x == e1 && (int)r.y == e2) { diag_put(a.ws, stage, __uint_as_float(r.z) - w1, w1, 0.03f, 0.003f); diag_put(a.ws, stage, __uint_as_float(r.w) - w2, w2, 0.03f, 0.003f); }
        else {
            float gap = 1e9f; const int me1 = (int)r.x, me2 = (int)r.y;
            if (me1 / 8 != gi) gap = lg[gi] - lg[me1 / 8]; else { const float a1 = lg[4 + me1], a2 = lg[4 + me2]; gap = fmaxf(fabsf(fminf(v1, v2) - fminf(a1, a2)), fabsf(fmaxf(v1, v2) - fmaxf(a1, a2))); }
            diag_put(a.ws, stage, gap, 0.f, 0.f, 0.02f); } }
}
#undef x
__global__ void ck_moe(Args a, int l, int stage) {
    __shared__ float hid[512]; __shared__ float hx[D];
    const unsigned hsh = hash_u(blockIdx.x + 6006); const int t = hsh % T, k = blockIdx.x & 1; const u32x4 r = ((const u32x4*)(a.ws + WS_ROUTE))[t]; const int e = k ? (int)r.y : (int)r.x; const float w = __uint_as_float(k ? r.w : r.z);
    const bf16_t* xb = (const bf16_t*)(a.ws + WS_XB) + (size_t)t * D; const float* g = a.in[I_NORM_FFN] + l * D; const float* Wu = a.in[I_W_UP] + ((size_t)(l * NEXP + e) * D) * 1024;
    for (int c = threadIdx.x; c < D; c += 256) hx[c] = bf2f(xb[c]) * g[c];
    __syncthreads();
    float rs_; { float s_ = 0.f; for (int c = 0; c < D; ++c) { const float xv = bf2f(xb[c]); s_ += xv * xv; } rs_ = 1.0f / sqrtf(s_ / D + EPS); }
    for (int j = threadIdx.x; j < 512; j += 256) { float av = 0.f, cv = 0.f; for (int c = 0; c < D; ++c) { av += hx[c] * Wu[(size_t)c * 1024 + j]; cv += hx[c] * Wu[(size_t)c * 1024 + 512 + j]; } av *= rs_; cv *= rs_; hid[j] = av / (1.0f + expf(-av)) * cv; }
    __syncthreads();
    const int c = (threadIdx.x * 8 + 3) % D; const float* Wd = a.in[I_W_DOWN] + ((size_t)(l * NEXP + e) * 512) * D + c; float s = 0.f; for (int j = 0; j < 512; ++j) s += hid[j] * Wd[(size_t)j * D];
    const float ref = w * s; const bf16_t* ys = (const bf16_t*)(a.ws + (k ? WS_Y1 : WS_Y0));
    if (MK_MOE8 && l >= 0) diag_put(a.ws, stage, bf2f(ys[(size_t)t * D + c]) - ref, ref, 0.10f, 0.15f); else diag_put(a.ws, stage, bf2f(ys[(size_t)t * D + c]) - ref, ref, 0.03f, 0.02f);
}
__global__ void ck_report(Args a) {
    const float* dg = (const float*)(a.ws + WS_CTL) + CW_DIAG; int bad = 0; for (int s = 1; s < 64; ++s) if (dg[s] > 1.0f) { bad = s; break; }
    if (!bad) return;
    const float v = powf(10.0f, 2.0f + 0.5f * (float)bad) * (dg[bad] > 30.f ? 2.0f : 1.0f);
    for (size_t i = (size_t)blockIdx.x * blockDim.x + threadIdx.x; i < (size_t)T * D; i += (size_t)gridDim.x * blockDim.x) a.out[i] = v;
}
#endif

extern "C" void kernel_launch(void* const* d_in, const int* in_sizes, int n_in, void* d_out, int out_size, void* d_ws, size_t ws_size, hipStream_t stream) {
    static int grid = 0;
    if (grid == 0) {
        if (n_in != 27 || out_size != T * D || ws_size < WS_END) { fprintf(stderr, "kernel_launch: unexpected shapes (n_in %d out %d ws %zu)\n", n_in, out_size, ws_size); grid = -1; return; }
        (void)hipFuncSetAttribute((const void*)mk_fwd, hipFuncAttributeMaxDynamicSharedMemorySize, LDS_BYTES);
        int dev = 0, cus = 0; (void)hipGetDevice(&dev); (void)hipDeviceGetAttribute(&cus, hipDeviceAttributeMultiprocessorCount, dev);
        grid = cus > 0 ? cus : 256;
    }
    if (grid < 0) return;
    (void)hipMemsetAsync((char*)d_ws + WS_CTL, 0, CTL_BYTES, stream);
    Args a{};
    for (int i = 0; i < 27; ++i) a.in[i] = (const float*)d_in[i];
    a.out = (float*)d_out; a.ws = (unsigned char*)d_ws; a.mix_mask = 15;
#if MK_DEBUG
#define CK(kern, nblk, nthr, ...) hipLaunchKernelGGL(kern, dim3(nblk), dim3(nthr), 0, stream, a, __VA_ARGS__)
#endif
#if MK_FUSED && !MK_DEBUG
    if (MK_PROBE_LO < 0) {
        a.ph_lo = 0; a.ph_hi = N_PHASES;
        hipLaunchKernelGGL(mk_fwd, dim3(grid), dim3(NTHR), LDS_BYTES, stream, a);
#if MK_XPROBE
        a.ph_lo = 50; a.ph_hi = 51; hipLaunchKernelGGL(mk_fwd, dim3(grid), dim3(NTHR), LDS_BYTES, stream, a);
#endif
    } else {
        const int cuts[4] = {0, MK_PROBE_HI, MK_PROBE_LO, N_PHASES};
        const int los[3] = {0, MK_PROBE_LO, MK_PROBE_HI}, his[3] = {MK_PROBE_HI, MK_PROBE_HI, N_PHASES}; (void)cuts;
        for (int i = 0; i < 3; ++i) { if (los[i] >= his[i]) continue;
            if (i) (void)hipMemsetAsync((char*)d_ws + WS_CTL + CW_BAR * 4, 0, XCD_BAR_WORDS * 4, stream);
            a.ph_lo = los[i]; a.ph_hi = his[i]; a.mix_mask = (i == 1) ? MK_PROBE_MIX : 15;
            hipLaunchKernelGGL(mk_fwd, dim3(grid), dim3(NTHR), LDS_BYTES, stream, a); }
    }
    return;
#endif
    for (int ph = 0; ph < N_PHASES; ++ph) {
        a.ph_lo = ph; a.ph_hi = ph + 1;
        hipLaunchKernelGGL(mk_fwd, dim3(grid), dim3(NTHR), LDS_BYTES, stream, a);
#if MK_DEBUG
        if (ph >= 1 && ph < N_PHASES - 1) { const int l = (ph - 1) / PH_PER_LAYER, p = (ph - 1) % PH_PER_LAYER, sb = l * 13;
            if (p == 0) CK(ck_h, 64, 64, l, sb + 1);
            if (p == 1) { CK(ck_z_ident, 16, 64, l, sb + 2); CK(ck_z_qk, 128, 128, l, sb + 3, 0); CK(ck_z_qk, 128, 128, l, sb + 4, 1); }
            if (p == 2) { CK(ck_ya, 64, 128, l, sb + 5); CK(ck_yb, 16, 64, l, sb + 6); CK(ck_yd, 40, 128, l, sb + 8); }
            if (p == 3) CK(ck_yc, 64, 128, l, sb + 7);
            if (p == 4) CK(ck_p, 16, 64, l, sb + 9);
            if (p == 5) CK(ck_merged, 8, 64, l, sb + 10);
            if (p == 6 && l == 0) CK(ck_x1, 16, 64, l, sb + 11);
            if (p == 7) CK(ck_route, 128, 64, l, sb + 12);
            if (p == 9) CK(ck_moe, 32, 256, l, sb + 13);
        }
#endif
    }
#if MK_DEBUG
    hipLaunchKernelGGL(ck_report, dim3(1024), dim3(256), 0, stream, a);
#endif
}
```

```cpp
#include <hip/hip_runtime.h>
#include <cstdio>
#include <cstdint>

#ifndef MK_XPROBE
#define MK_XPROBE 0
#define MK_XPROBE_W W_G
#define MK_XPROBE_K 2048
#define MK_XPROBE_N 8192
#endif
#ifndef MK_PROBE_MIX
#define MK_PROBE_MIX 15
#endif
#ifndef MK_PROBE_LO
#define MK_PROBE_LO -1
#define MK_PROBE_HI -1
#endif
#ifndef MK_MOE8
#define MK_MOE8 1
#endif
#ifndef MK_Z8
#define MK_Z8 2
#endif
#ifndef MK_WO8
#define MK_WO8 0
#endif
#ifndef MK_Y8
#define MK_Y8 1
#endif
#ifndef MK_FUSED
#define MK_FUSED 1
#endif
#ifndef MK_DEBUG
#define MK_DEBUG 0
#endif
#define MK_PTILE (!MK_DEBUG)

#define LAS __attribute__((address_space(3)))
typedef unsigned short bf16_t;
typedef short bf16x8 __attribute__((ext_vector_type(8)));
typedef short s16x4 __attribute__((ext_vector_type(4)));
typedef float f32x4 __attribute__((ext_vector_type(4)));
typedef float f32x2 __attribute__((ext_vector_type(2)));
typedef float f32x16 __attribute__((ext_vector_type(16)));
typedef unsigned u32x4 __attribute__((ext_vector_type(4)));
typedef unsigned u32x2 __attribute__((ext_vector_type(2)));

constexpr int NB = 8, SEQ = 4096, T = NB * SEQ, D = 2048, WIN = 8704;
constexpr int ZA = 0, ZB = 1024, ZC = 2560, ZD = 7168;
constexpr int NEXP = 32;
constexpr float EPS = 1e-6f;
constexpr int NWAVES = 8, NTHR = 512;
constexpr int LDS_BYTES = 147456;

constexpr size_t MiB = 1u << 20;
constexpr size_t WS_CTL = 0, CTL_BYTES = 1 * MiB;
constexpr size_t WS_COSC = 1 * MiB, WS_SINC = 2 * MiB, WS_COSD = 3 * MiB, WS_SIND = 3 * MiB + 512 * 1024;
constexpr size_t WS_LIST = 8 * MiB;
constexpr size_t WS_ROUTE = 24 * MiB;
constexpr size_t WS_LSE = 25 * MiB;
constexpr size_t WS_W = 32 * MiB, W_LAYER = 276 * MiB;
constexpr size_t W_IN = 0, W_G = 34 * MiB, W_B = 66 * MiB, W_O = 74 * MiB, W_UP = 82 * MiB, W_DN = 210 * MiB, W_R = 274 * MiB, W_SG = 275 * MiB;
constexpr size_t WS_H = 584 * MiB;
constexpr size_t WS_Z = 712 * MiB;
constexpr size_t WS_HID = WS_Z;
constexpr size_t WS_Y0 = WS_Z + 80 * MiB, WS_Y1 = WS_Z + 208 * MiB;
constexpr size_t WS_Y = 1256 * MiB;
constexpr size_t WS_CO = 1384 * MiB;
constexpr size_t WS_H8 = 1480 * MiB;
constexpr size_t WS_XB = 1544 * MiB;
constexpr size_t WS_END = 1672 * MiB;
constexpr int CW_CNT = 64;
constexpr int CW_DIAG = 256;
constexpr int CW_BAR = 4096;

__device__ __forceinline__ unsigned cvt_pk_bf16(float lo, float hi) { unsigned r; asm("v_cvt_pk_bf16_f32 %0, %1, %2" : "=v"(r) : "v"(lo), "v"(hi)); return r; }
__device__ __forceinline__ float bf_lo(unsigned w) { return __uint_as_float(w << 16); }
__device__ __forceinline__ float bf_hi(unsigned w) { return __uint_as_float(w & 0xffff0000u); }
__device__ __forceinline__ float bf2f(bf16_t b) { return __uint_as_float(((unsigned)b) << 16); }
__device__ __forceinline__ float fast_exp(float x) { return __builtin_amdgcn_exp2f(x * 1.4426950408889634f); }
__device__ __forceinline__ float sigmoidf_(float x) { return __builtin_amdgcn_rcpf(1.0f + fast_exp(-x)); }
__device__ __forceinline__ float gelu_tanh(float x) { const float u = 0.7978845608028654f * (x + 0.044715f * x * x * x); return x * sigmoidf_(2.0f * u); }
__device__ __forceinline__ float wave_sum(float v) {
#pragma unroll
    for (int o = 1; o < 64; o <<= 1) v += __shfl_xor(v, o);
    return v;
}
#define LDS_WAIT() asm volatile("s_waitcnt lgkmcnt(0)" ::: "memory")
#define VM_WAIT() asm volatile("s_waitcnt vmcnt(0)" ::: "memory")
__device__ __forceinline__ int opaque_tid() { int t = threadIdx.x; asm volatile("" : "+v"(t)); return t; }

namespace gm {
constexpr int BM = 256, BK = 64, HALF = 128, HTB = HALF * BK * 2, STAGE_BYTES = 8 * HTB;
constexpr int NXCD = 8, WGM = 8;
constexpr int XCH_OFF = STAGE_BYTES;
constexpr int TAB_OFF = STAGE_BYTES + 8192;
__host__ __device__ __forceinline__ int lds_byte(int r, int c) { const int st = (r >> 4) * 2 + (c >> 5), rr = r & 15, cc = c & 31, ob = rr * 64 + cc * 2; return st * 1024 + (ob ^ (((ob >> 9) & 1) << 5)); }
__host__ __device__ __forceinline__ void stage_rc(int b, int& R, int& C) { const int st = b / 1024, sb = b % 1024, swz = sb ^ (((sb >> 9) & 1) << 5); R = (st >> 1) * 16 + swz / 64; C = (st & 1) * 32 + (swz % 64) / 2; }
__host__ __device__ __forceinline__ int perm32(int rho) { const int n = rho >> 4, i = rho & 15; return 8 * (i >> 2) + 4 * n + (i & 3); }

struct Unit { int pm, pn, aux; };
typedef int v8i32 __attribute__((ext_vector_type(8)));
__device__ __forceinline__ void mfma8(f32x4& acc, v8i32 a, v8i32 b, int sa, int sb) {
    asm volatile("v_mfma_scale_f32_16x16x128_f8f6f4 %0, %1, %2, %0, %3, %4 op_sel_hi:[0,0,0]" : "+v"(acc) : "v"(a), "v"(b), "v"(sa), "v"(sb)); }
__device__ __forceinline__ v8i32 cat8(bf16x8 lo, bf16x8 hi) { const u32x4 a = __builtin_bit_cast(u32x4, lo), b = __builtin_bit_cast(u32x4, hi); return (v8i32){(int)a.x, (int)a.y, (int)a.z, (int)a.w, (int)b.x, (int)b.y, (int)b.z, (int)b.w}; }
struct Desc { const void* A; const void* Bt; int lda, ldb, K; int sw = 121, sa = 127; int ka = 0; };

struct StaticOrder {
    static constexpr bool GATHER = false;
    int nM, nN, nwg, G, c, i0 = 0, iend = 1 << 30;
    __device__ void init(int M, int N, int G_, int c_) { nM = M / BM; nN = N / BM; nwg = nM * nN; G = G_; c = c_; }
    __device__ __forceinline__ bool next(int i, Unit& u) const {
        if (i + i0 >= iend) return false;
        const long L = (long)(i + i0) * G + c; if (L >= nwg) return false;
        int wgid = (int)L; { const int q = nwg / NXCD, r = nwg % NXCD, xcd = wgid % NXCD, off = wgid / NXCD; wgid = (xcd < r ? xcd * (q + 1) : r * (q + 1) + (xcd - r) * q) + off; }
        const int nig = WGM * nN, gid = wgid / nig, fm = gid * WGM, gsz = (nM - fm) < WGM ? (nM - fm) : WGM;
        u.pm = fm + ((wgid % nig) % gsz); u.pn = (wgid % nig) / gsz; u.aux = 0; return true;
    }
    __device__ __forceinline__ const char* a_base(const Desc& g, const Unit& u) const { return (const char*)g.A + (size_t)u.pm * BM * g.lda; }
    __device__ __forceinline__ const char* b_base(const Desc& g, const Unit& u) const { return (const char*)g.Bt + (size_t)u.pn * BM * g.ldb; }
    __device__ __forceinline__ void a_off(const Desc& g, const Unit&, const int (&R)[2], const int (&C)[2], unsigned (&v)[2][2]) const {
#pragma unroll
        for (int h = 0; h < 2; ++h)
#pragma unroll
            for (int i = 0; i < 2; ++i) v[h][i] = (unsigned)((R[i] + HALF * h) * g.lda + C[i] * 2);
    }
};
struct BranchOrder : StaticOrder {
    __device__ __forceinline__ const char* a_base(const Desc& g, const Unit& u) const { return (const char*)g.A + (size_t)u.pm * BM * g.lda + (size_t)(u.pn >> 3) * 512 * 2; }
};

struct TileAOrder : StaticOrder {
    __device__ __forceinline__ const char* a_base(const Desc& g, const Unit& u) const { return (const char*)g.A + (size_t)u.pm * 32 * 32768; }
    __device__ __forceinline__ void a_off(const Desc&, const Unit&, const int (&R)[2], const int (&C)[2], unsigned (&v)[2][2]) const {
#pragma unroll
        for (int h = 0; h < 2; ++h)
#pragma unroll
            for (int i = 0; i < 2; ++i) v[h][i] = (unsigned)(h * 16384 + ((R[i] >> 4) & 3) * 4096 + (R[i] >> 6) * 2048 + (C[i] >> 4) * 512 + (R[i] & 15) * 32 + ((C[i] >> 3) & 1) * 16);
    }
};
template <bool FP8 = false, class Epi, class Sched>
__device__ __forceinline__ void gemm_phase(LAS unsigned char* lds, const Desc g, const Sched& S, const Epi& E) {
    const int tid = opaque_tid(), wid = __builtin_amdgcn_readfirstlane(tid >> 6), lane = tid & 63, wr = wid >> 2, wc = wid & 3, fr = lane & 15, fq = lane >> 4;
    const int nt = g.K / (BK * 2);
    int Rr[2], Cc[2]; unsigned voffB[2];
#pragma unroll
    for (int i = 0; i < 2; ++i) { int R, C; stage_rc(tid * 16 + i * 8192, R, C); Rr[i] = R; Cc[i] = C; voffB[i] = (unsigned)(tid * 16 + i * 8192); }
    const size_t kstep = (size_t)(BK * 2);
    const size_t kstepA = g.ka ? (size_t)g.ka : kstep;
    const size_t hstepB = 16384, kstepB = 32768;
    const unsigned ldsw = (unsigned)wid * 1024u;
    const int aoff = lds_byte(wr * 64 + fr, fq * 8), boff = lds_byte(wc * 32 + fr, fq * 8);
    constexpr int KSTR = 1024;
#define GM_SA(b, h) (((b) * 2 + (h)) * HTB)
#define GM_SB(b, h) ((4 + (b) * 2 + (h)) * HTB)
#define GM_STAGE(bufoff, gbase, voff) do { _Pragma("unroll") for (int _i = 0; _i < 2; ++_i) \
        __builtin_amdgcn_global_load_lds((const unsigned*)((const char*)(gbase) + (voff)[_i]), (LAS unsigned*)(lds + (bufoff) + ldsw + _i * 8192), 16, 0, 0); } while (0)
#define GM_LDA(dst, b, h) do { _Pragma("unroll") for (int m = 0; m < 4; ++m) _Pragma("unroll") for (int k = 0; k < 2; ++k) dst[m][k] = *(const LAS bf16x8*)(lds + GM_SA(b, h) + aoff + m * 2048 + k * KSTR); } while (0)
#define GM_LDB(dst, b, h) do { _Pragma("unroll") for (int n = 0; n < 2; ++n) _Pragma("unroll") for (int k = 0; k < 2; ++k) dst[n][k] = *(const LAS bf16x8*)(lds + GM_SB(b, h) + boff + n * 2048 + k * KSTR); } while (0)
#define GM_MMA(ai, bj, At, Bt) do { __builtin_amdgcn_s_setprio(1); \
        if constexpr (FP8) { _Pragma("unroll") for (int m = 0; m < 4; ++m) _Pragma("unroll") for (int n = 0; n < 2; ++n) \
            mfma8(acc[ai][bj][m][n], cat8(Bt[n][0], Bt[n][1]), cat8(At[m][0], At[m][1]), sc_w, sc_1); } \
        else { _Pragma("unroll") for (int m = 0; m < 4; ++m) _Pragma("unroll") for (int n = 0; n < 2; ++n) _Pragma("unroll") for (int k = 0; k < 2; ++k) \
            acc[ai][bj][m][n] = __builtin_amdgcn_mfma_f32_16x16x32_bf16(Bt[n][k], At[m][k], acc[ai][bj][m][n], 0, 0, 0); } \
        __builtin_amdgcn_s_setprio(0); } while (0)
#define GM_WAIT_V(n) asm volatile("s_waitcnt vmcnt(" #n ")" ::: "memory")
#define GM_WAIT_L(n) asm volatile("s_waitcnt lgkmcnt(" #n ")" ::: "memory")
#define GM_BAR __builtin_amdgcn_s_barrier()
#define GM_SCHED __builtin_amdgcn_sched_barrier(0)
    Unit cur, nxt; int ui = 0;
    if (!S.next(0, cur)) return;
    int sc_w = g.sw, sc_1 = g.sa; asm volatile("" : "+v"(sc_w), "+v"(sc_1));
    f32x4 acc[2][2][4][2];
#pragma unroll
    for (int a = 0; a < 2; ++a)
#pragma unroll
        for (int b = 0; b < 2; ++b)
#pragma unroll
            for (int m = 0; m < 4; ++m)
#pragma unroll
                for (int n = 0; n < 2; ++n) acc[a][b][m][n] = (f32x4){0.f, 0.f, 0.f, 0.f};
    bf16x8 At[4][2], B0[2][2], B1[2][2];
    unsigned vc[2][2], vn[2][2];
    S.a_off(g, cur, Rr, Cc, vc);
    const char* cA = S.a_base(g, cur); const char* cB = S.b_base(g, cur);
    GM_STAGE(GM_SB(0, 0), cB, voffB); GM_STAGE(GM_SB(0, 1), cB + hstepB, voffB); GM_STAGE(GM_SA(0, 0), cA, vc[0]); GM_STAGE(GM_SA(0, 1), cA, vc[1]);
    if (wr == 1) GM_BAR;
    GM_WAIT_V(2); GM_BAR;
    GM_STAGE(GM_SB(1, 0), cB + kstepB, voffB); GM_STAGE(GM_SA(1, 0), cA + kstepA, vc[0]); GM_STAGE(GM_SB(1, 1), cB + hstepB + kstepB, voffB);
    GM_WAIT_V(6); GM_BAR;
    for (;;) {
        const bool has_next = S.next(ui + 1, nxt);
        const char* nA = cA; const char* nB = cB;
#pragma unroll
        for (int h = 0; h < 2; ++h)
#pragma unroll
            for (int i = 0; i < 2; ++i) vn[h][i] = vc[h][i];
        if (has_next) { nA = S.a_base(g, nxt); nB = S.b_base(g, nxt); if constexpr (Sched::GATHER) S.a_off(g, nxt, Rr, Cc, vn); }
        for (int t = 0; t < nt; t += 2) {
            const bool last = (t == nt - 2);
            const char* a1 = cA + (size_t)(t + 1) * kstepA;
            const char* a2 = last ? nA : cA + (size_t)(t + 2) * kstepA; const char* b2 = last ? nB : cB + (size_t)(t + 2) * kstepB;
            const char* a3 = a2 + kstepA; const char* b3 = b2 + kstepB;
            unsigned v2[2][2];
#pragma unroll
            for (int h = 0; h < 2; ++h)
#pragma unroll
                for (int i = 0; i < 2; ++i) v2[h][i] = (Sched::GATHER && last) ? vn[h][i] : vc[h][i];
            GM_LDB(B0, 0, 0); GM_LDB(B1, 0, 1); GM_SCHED; GM_LDA(At, 0, 0); GM_STAGE(GM_SA(1, 1), a1, vc[1]);
            GM_WAIT_V(8); GM_WAIT_L(0); GM_BAR; GM_MMA(0, 0, At, B0); GM_MMA(0, 1, At, B1); GM_BAR; GM_SCHED;
            GM_LDA(At, 0, 1); GM_STAGE(GM_SB(0, 0), b2, voffB); GM_STAGE(GM_SB(0, 1), b2 + hstepB, voffB); GM_STAGE(GM_SA(0, 0), a2, v2[0]);
            GM_WAIT_V(8); GM_WAIT_L(0); GM_BAR; GM_MMA(1, 0, At, B0); GM_MMA(1, 1, At, B1); GM_BAR; GM_SCHED;
            GM_LDB(B0, 1, 0); GM_LDB(B1, 1, 1); GM_SCHED; GM_LDA(At, 1, 0); GM_STAGE(GM_SA(0, 1), a2, v2[1]);
            GM_WAIT_V(8); GM_WAIT_L(0); GM_BAR; GM_MMA(0, 0, At, B0); GM_MMA(0, 1, At, B1); GM_BAR; GM_SCHED;
            GM_LDA(At, 1, 1); GM_STAGE(GM_SB(1, 0), b3, voffB); GM_STAGE(GM_SB(1, 1), b3 + hstepB, voffB); GM_STAGE(GM_SA(1, 0), a3, v2[0]);
            GM_WAIT_V(8); GM_WAIT_L(0); GM_BAR; GM_MMA(1, 0, At, B0); GM_MMA(1, 1, At, B1); GM_BAR; GM_SCHED;
        }
        if (wr == 0) GM_BAR;
        if constexpr (FP8) { asm volatile("s_nop 15\n\ts_nop 15\n\ts_nop 15" ::: "memory"); }
        { int fr_e = fr, fq_e = fq; asm volatile("" : "+v"(fr_e), "+v"(fq_e));
          E(acc, cur, lds, wr, wc, fr_e, fq_e); }
        if (!has_next) break;
#pragma unroll
        for (int a = 0; a < 2; ++a)
#pragma unroll
            for (int b = 0; b < 2; ++b)
#pragma unroll
                for (int m = 0; m < 4; ++m)
#pragma unroll
                    for (int n = 0; n < 2; ++n) acc[a][b][m][n] = (f32x4){0.f, 0.f, 0.f, 0.f};
        cur = nxt; cA = nA; cB = nB; ++ui;
#pragma unroll
        for (int h = 0; h < 2; ++h)
#pragma unroll
            for (int i = 0; i < 2; ++i) vc[h][i] = vn[h][i];
        if (wr == 1) GM_BAR;
    }
    GM_WAIT_V(0);
    GM_BAR;
#undef GM_SA
#undef GM_SB
#undef GM_STAGE
#undef GM_LDA
#undef GM_LDB
#undef GM_MMA
#undef GM_WAIT_V
#undef GM_WAIT_L
#undef GM_BAR
#undef GM_SCHED
}

struct EpiZ {
    bf16_t* Z; const float *qn_c, *kn_c, *qn_d, *kn_d; const float *cosC, *sinC, *cosD, *sinD;
    __device__ __forceinline__ void operator()(f32x4 (&acc)[2][2][4][2], const Unit& u, LAS unsigned char* lds, int wr, int wc, int fr, int fq) const {
        const int pn = u.pn; const int row0 = u.pm * BM + wr * 64 + fr;
        if (pn >= 10 && pn < 22) {
            LAS float* xch = (LAS float*)(lds + XCH_OFF);
            const int hh = 2 * (pn - 10) + (wc >> 1); const float* gn = (hh >= 12) ? kn_c : qn_c;
            const int i0 = 32 * (wc & 1) + 8 * fq;
#pragma unroll
            for (int ai = 0; ai < 2; ++ai)
#pragma unroll
                for (int m = 0; m < 4; ++m) { float ss = 0.f;
#pragma unroll
                    for (int bj = 0; bj < 2; ++bj)
#pragma unroll
                        for (int n = 0; n < 2; ++n) { const f32x4 x = acc[ai][bj][m][n]; ss += (x[0] * x[0] + x[1] * x[1]) + (x[2] * x[2] + x[3] * x[3]); }
                    ss += __shfl_xor(ss, 16); ss += __shfl_xor(ss, 32);
                    if (fq == 0) xch[(ai * HALF + wr * 64 + m * 16 + fr) * 4 + wc] = ss; }
            LDS_WAIT(); __builtin_amdgcn_s_barrier(); asm volatile("" ::: "memory");
            f32x4 ivr[2];
#pragma unroll
            for (int n = 0; n < 2; ++n) {
#pragma unroll
                for (int j = 0; j < 4; ++j) ivr[n][j] = __builtin_amdgcn_exp2f(-(float)(i0 + 4 * n + j) * (13.287712379549449f / 64.0f)) * 0.15915494309189535f; }
            f32x4 gq[2][2];
#pragma unroll
            for (int n = 0; n < 2; ++n) { gq[n][0] = *(const f32x4*)(gn + i0 + 4 * n); gq[n][1] = *(const f32x4*)(gn + 64 + i0 + 4 * n); }
#pragma unroll
            for (int ai = 0; ai < 2; ++ai)
#pragma unroll
                for (int m = 0; m < 4; ++m) { const int rl = ai * HALF + wr * 64 + m * 16 + fr; const int row = u.pm * BM + rl;
                    const float tot = xch[rl * 4 + wc] + xch[rl * 4 + (wc ^ 1)];
                    const float rstd = __builtin_amdgcn_rsqf(tot * (1.0f / 128.0f) + EPS);
                    const float posf = (float)(row & (SEQ - 1));
                    u32x4 w0, w1;
#pragma unroll
                    for (int n = 0; n < 2; ++n) { f32x4 cs, sn;
#pragma unroll
                        for (int j = 0; j < 4; ++j) { const float xr = __builtin_amdgcn_fractf(posf * ivr[n][j]); cs[j] = __builtin_amdgcn_cosf(xr); sn[j] = __builtin_amdgcn_sinf(xr); }
                        const f32x4 g0 = gq[n][0], g1 = gq[n][1];
                        const f32x4 x1 = acc[ai][0][m][n] * rstd * g0, x2 = acc[ai][1][m][n] * rstd * g1;
                        const f32x4 o1 = x1 * cs - x2 * sn, o2 = x2 * cs + x1 * sn;
                        w0[2 * n] = cvt_pk_bf16(o1[0], o1[1]); w0[2 * n + 1] = cvt_pk_bf16(o1[2], o1[3]);
                        w1[2 * n] = cvt_pk_bf16(o2[0], o2[1]); w1[2 * n + 1] = cvt_pk_bf16(o2[2], o2[3]); }
                    bf16_t* rp = Z + (size_t)row * WIN + ZC + hh * 128 + i0;
                    *(u32x4*)rp = w0; *(u32x4*)(rp + 64) = w1; }
        } else if (pn >= 28 && pn < 32) {
            const float* gn = (pn >= 30) ? kn_d : qn_d;
            const int i0 = 8 * fq;
            f32x4 ivr[2];
#pragma unroll
            for (int n = 0; n < 2; ++n) {
#pragma unroll
                for (int j = 0; j < 4; ++j) ivr[n][j] = __builtin_amdgcn_exp2f(-(float)(i0 + 4 * n + j) * (13.287712379549449f / 32.0f)) * 0.15915494309189535f; }
            f32x4 gq[2][2];
#pragma unroll
            for (int n = 0; n < 2; ++n) { gq[n][0] = *(const f32x4*)(gn + i0 + 4 * n); gq[n][1] = *(const f32x4*)(gn + 32 + i0 + 4 * n); }
#pragma unroll
            for (int ai = 0; ai < 2; ++ai)
#pragma unroll
                for (int m = 0; m < 4; ++m) { const int row = row0 + ai * HALF + m * 16; float ss = 0.f;
#pragma unroll
                    for (int bj = 0; bj < 2; ++bj)
#pragma unroll
                        for (int n = 0; n < 2; ++n) { const f32x4 x = acc[ai][bj][m][n]; ss += (x[0] * x[0] + x[1] * x[1]) + (x[2] * x[2] + x[3] * x[3]); }
                    ss += __shfl_xor(ss, 16); ss += __shfl_xor(ss, 32);
                    const float rstd = __builtin_amdgcn_rsqf(ss * (1.0f / 64.0f) + EPS);
                    const float posf = (float)(row & (SEQ - 1));
                    u32x4 w0, w1;
#pragma unroll
                    for (int n = 0; n < 2; ++n) { f32x4 cs, sn;
#pragma unroll
                        for (int j = 0; j < 4; ++j) { const float xr = __builtin_amdgcn_fractf(posf * ivr[n][j]); cs[j] = __builtin_amdgcn_cosf(xr); sn[j] = __builtin_amdgcn_sinf(xr); }
                        const f32x4 g0 = gq[n][0], g1 = gq[n][1];
                        const f32x4 x1 = acc[ai][0][m][n] * rstd * g0, x2 = acc[ai][1][m][n] * rstd * g1;
                        const f32x4 o1 = x1 * cs - x2 * sn, o2 = x2 * cs + x1 * sn;
                        w0[2 * n] = cvt_pk_bf16(o1[0], o1[1]); w0[2 * n + 1] = cvt_pk_bf16(o1[2], o1[3]);
                        w1[2 * n] = cvt_pk_bf16(o2[0], o2[1]); w1[2 * n + 1] = cvt_pk_bf16(o2[2], o2[3]); }
                    bf16_t* rp = Z + (size_t)row * WIN + ZD + (pn - 28) * 256 + wc * 64 + i0;
                    *(u32x4*)rp = w0; *(u32x4*)(rp + 32) = w1; }
        } else {
            const bool do_gelu = pn < 4;
#pragma unroll
            for (int ai = 0; ai < 2; ++ai)
#pragma unroll
                for (int m = 0; m < 4; ++m) { bf16_t* rp = Z + (size_t)(row0 + ai * HALF + m * 16) * WIN + pn * BM + wc * 32 + 8 * fq;
#pragma unroll
                    for (int bj = 0; bj < 2; ++bj) { f32x4 v0 = acc[ai][bj][m][0], v1 = acc[ai][bj][m][1];
                        if (do_gelu) {
#pragma unroll
                            for (int j = 0; j < 4; ++j) { v0[j] = gelu_tanh(v0[j]); v1[j] = gelu_tanh(v1[j]); } }
                        u32x4 w; w.x = cvt_pk_bf16(v0[0], v0[1]); w.y = cvt_pk_bf16(v0[2], v0[3]); w.z = cvt_pk_bf16(v1[0], v1[1]); w.w = cvt_pk_bf16(v1[2], v1[3]);
                        *(u32x4*)(rp + bj * HALF) = w; } }
        }
    }
};
struct EpiBf16 {
    bf16_t* O; int ldc;
    __device__ __forceinline__ void operator()(f32x4 (&acc)[2][2][4][2], const Unit& u, LAS unsigned char*, int wr, int wc, int fr, int fq) const {
        const int row0 = u.pm * BM + wr * 64 + fr;
#pragma unroll
        for (int ai = 0; ai < 2; ++ai)
#pragma unroll
            for (int m = 0; m < 4; ++m) { bf16_t* rp = O + (size_t)(row0 + ai * HALF + m * 16) * ldc + u.pn * BM + wc * 32 + 8 * fq;
#pragma unroll
                for (int bj = 0; bj < 2; ++bj) { const f32x4 v0 = acc[ai][bj][m][0], v1 = acc[ai][bj][m][1];
                    u32x4 w; w.x = cvt_pk_bf16(v0[0], v0[1]); w.y = cvt_pk_bf16(v0[2], v0[3]); w.z = cvt_pk_bf16(v1[0], v1[1]); w.w = cvt_pk_bf16(v1[2], v1[3]);
                    __builtin_nontemporal_store(w, (u32x4*)(rp + bj * HALF)); } }
    }
};
struct EpiPTile {
    unsigned char* O;
    __device__ __forceinline__ void operator()(f32x4 (&acc)[2][2][4][2], const Unit& u, LAS unsigned char*, int wr, int wc, int fr, int fq) const {
        const int kP = u.pn >> 3, wcg = 2 * (wc & 1) + (fq >> 1);
        unsigned char* lane_base = O + (size_t)u.pm * 32 * 131072 + (size_t)(kP * 4096 + wr * 2048 + wcg * 512 + fr * 32 + (fq & 1) * 16);
#pragma unroll
        for (int bj = 0; bj < 2; ++bj) { unsigned char* tb = lane_base + (size_t)((u.pn & 7) * 4 + 2 * bj + (wc >> 1)) * 131072;
#pragma unroll
            for (int ai = 0; ai < 2; ++ai)
#pragma unroll
                for (int m = 0; m < 4; ++m) { const f32x4 v0 = acc[ai][bj][m][0], v1 = acc[ai][bj][m][1];
                    u32x4 w; w.x = cvt_pk_bf16(v0[0], v0[1]); w.y = cvt_pk_bf16(v0[2], v0[3]); w.z = cvt_pk_bf16(v1[0], v1[1]); w.w = cvt_pk_bf16(v1[2], v1[3]);
                    __builtin_nontemporal_store(w, (u32x4*)(tb + ai * 65536 + m * 16384)); } }
    }
};
template <bool OUT8> struct EpiGateT {
    void* Mg; const bf16_t* P; const float* bg;
    __device__ __forceinline__ void operator()(f32x4 (&acc)[2][2][4][2], const Unit& u, LAS unsigned char*, int wr, int wc, int fr, int fq) const {
        const int row0 = u.pm * BM + wr * 64 + fr; const int c = 64 * u.pn + 16 * wc + 4 * fq;
        constexpr float NL2E = -1.4426950408889634f;
        f32x4 bl[4];
#pragma unroll
        for (int k = 0; k < 4; ++k) bl[k] = *(const f32x4*)(bg + k * D + c) * NL2E;
#pragma unroll
        for (int ai = 0; ai < 2; ++ai) {
            u32x2 pw[4][4];
#pragma unroll
            for (int m = 0; m < 4; ++m) {
#if MK_PTILE
                const unsigned char* pr = (const unsigned char*)P + (size_t)(u.pm * 32 + u.pn) * 131072 + (size_t)(ai * 65536 + m * 16384 + wr * 2048 + wc * 512 + fr * 32 + fq * 8);
#pragma unroll
                for (int k = 0; k < 4; ++k) pw[m][k] = *(const u32x2*)(pr + k * 4096);
#else
                const bf16_t* pr = P + (size_t)(row0 + ai * HALF + m * 16) * 8192 + c;
#pragma unroll
                for (int k = 0; k < 4; ++k) pw[m][k] = *(const u32x2*)(pr + k * D);
#endif
            }
            asm volatile("" ::: "memory");
#pragma unroll
            for (int m = 0; m < 4; ++m) { const size_t row = (size_t)(row0 + ai * HALF + m * 16);
                f32x4 t[4], pv[4];
#pragma unroll
                for (int k = 0; k < 4; ++k) { const f32x4 e = acc[ai][k >> 1][m][k & 1] * NL2E + bl[k]; const u32x2 p = pw[m][k];
#pragma unroll
                    for (int i = 0; i < 4; ++i) t[k][i] = __builtin_amdgcn_exp2f(__builtin_fminf(e[i], 30.f));
                    t[k] = t[k] + 1.0f;
                    pv[k] = (f32x4){bf_lo(p.x), bf_hi(p.x), bf_lo(p.y), bf_hi(p.y)}; }
                const f32x4 t01 = t[0] * t[1], t23 = t[2] * t[3];
                const f32x4 n01 = pv[0] * t[1] + pv[1] * t[0], n23 = pv[2] * t[3] + pv[3] * t[2];
                const f32x4 num = n01 * t23 + n23 * t01, den = t01 * t23;
                f32x4 s;
#pragma unroll
                for (int i = 0; i < 4; ++i) s[i] = num[i] * __builtin_amdgcn_rcpf(den[i]);
                if constexpr (OUT8) { int p = __builtin_amdgcn_cvt_pk_fp8_f32(s[0], s[1], 0, false); p = __builtin_amdgcn_cvt_pk_fp8_f32(s[2], s[3], p, true); *(unsigned*)((unsigned char*)Mg + row * D + c) = (unsigned)p; }
                else { u32x2 w; w.x = cvt_pk_bf16(s[0], s[1]); w.y = cvt_pk_bf16(s[2], s[3]);
#if MK_PTILE
                    *(u32x2*)((unsigned char*)Mg + (size_t)(u.pm * 32 + u.pn) * 32768 + (size_t)(ai * 16384 + m * 4096 + wr * 2048 + wc * 512 + fr * 32 + fq * 8)) = w; (void)row;
#else
                    *(u32x2*)((bf16_t*)Mg + row * D + c) = w;
#endif
                } }
        }
    }
};
struct EpiResid {
    const float* XF; bf16_t* XB;
    __device__ __forceinline__ void operator()(f32x4 (&acc)[2][2][4][2], const Unit& u, LAS unsigned char*, int wr, int wc, int fr, int fq) const {
        const int row0 = u.pm * BM + wr * 64 + fr;
#pragma unroll
        for (int am = 0; am < 4; ++am) { const int ai = am >> 1, mb = 2 * (am & 1);
            u32x4 rb[4][2]; f32x4 rf[4][2][2];
#pragma unroll
            for (int m = mb; m < mb + 2; ++m) { const size_t off = (size_t)(row0 + ai * HALF + m * 16) * D + u.pn * BM + wc * 32 + 8 * fq;
#pragma unroll
                for (int bj = 0; bj < 2; ++bj) {
                    if (XF) { rf[m][bj][0] = *(const f32x4*)(XF + off + bj * HALF); rf[m][bj][1] = *(const f32x4*)(XF + off + bj * HALF + 4); }
                    else rb[m][bj] = *(const u32x4*)(XB + off + bj * HALF); } }
            asm volatile("" ::: "memory");
#pragma unroll
            for (int m = mb; m < mb + 2; ++m) { const size_t off = (size_t)(row0 + ai * HALF + m * 16) * D + u.pn * BM + wc * 32 + 8 * fq;
#pragma unroll
                for (int bj = 0; bj < 2; ++bj) { f32x4 x0, x1;
                    if (XF) { x0 = rf[m][bj][0]; x1 = rf[m][bj][1]; }
                    else { const u32x4 r = rb[m][bj]; x0 = (f32x4){bf_lo(r.x), bf_hi(r.x), bf_lo(r.y), bf_hi(r.y)}; x1 = (f32x4){bf_lo(r.z), bf_hi(r.z), bf_lo(r.w), bf_hi(r.w)}; }
                    x0 += acc[ai][bj][m][0]; x1 += acc[ai][bj][m][1];
                    u32x4 w; w.x = cvt_pk_bf16(x0[0], x0[1]); w.y = cvt_pk_bf16(x0[2], x0[3]); w.z = cvt_pk_bf16(x1[0], x1[1]); w.w = cvt_pk_bf16(x1[2], x1[3]);
                    *(u32x4*)(XB + off + bj * HALF) = w; } }
        }
    }
};
struct MoeOrder {
    static constexpr bool GATHER = false;
    int nN, G, c; LAS const int* tab; const u32x4* list; int nexp_rows;
    __device__ __forceinline__ bool next(int i, Unit& u) const {
        const int L = i * G + c; const int TT = tab[32]; const int rt = L / nN;
        if (rt >= TT) return false;
        int e = 0;
        if (i < 16) e = tab[80 + i];
        else {
#pragma unroll 1
            for (int k = 1; k < 32; ++k) e = (tab[k] <= rt) ? k : e; }
        u.pm = rt; u.pn = L - rt * nN; u.aux = e; return true;
    }
    __device__ __forceinline__ const char* b_base(const Desc& g, const Unit& u) const { return (const char*)g.Bt + ((size_t)u.aux * nexp_rows + (size_t)u.pn * BM) * g.ldb; }
};
struct MoeUpOrder : MoeOrder {
    static constexpr bool GATHER = true;
    __device__ __forceinline__ const char* a_base(const Desc& g, const Unit&) const { return (const char*)g.A; }
    __device__ __forceinline__ void a_off(const Desc& g, const Unit& u, const int (&R)[2], const int (&C)[2], unsigned (&v)[2][2]) const {
        const int e = u.aux, base = (u.pm - tab[e]) * BM, cnt = tab[40 + e];
#pragma unroll
        for (int h = 0; h < 2; ++h)
#pragma unroll
            for (int i = 0; i < 2; ++i) { const int idx = base + R[i] + HALF * h; int tok = 0; if (idx < cnt) tok = (int)(list[(size_t)e * T + idx].x & 0x7fffu);
                v[h][i] = (unsigned)(tok * g.lda + C[i] * 2); }
    }
};
struct MoeDownOrder : MoeOrder {
    __device__ __forceinline__ const char* a_base(const Desc& g, const Unit& u) const { return (const char*)g.A + (size_t)u.pm * BM * g.lda; }
    __device__ __forceinline__ void a_off(const Desc& g, const Unit&, const int (&R)[2], const int (&C)[2], unsigned (&v)[2][2]) const {
#pragma unroll
        for (int h = 0; h < 2; ++h)
#pragma unroll
            for (int i = 0; i < 2; ++i) v[h][i] = g.ka ? (unsigned)(h * 16384 + ((R[i] >> 4) & 3) * 4096 + (R[i] >> 6) * 2048 + (C[i] >> 4) * 512 + (R[i] & 15) * 32 + ((C[i] >> 3) & 1) * 16)
                                                      : (unsigned)((R[i] + HALF * h) * g.lda + C[i] * 2);
    }
};
template <bool OUT8> struct EpiUpT {
    void* Hid; const u32x4* list;
    __device__ __forceinline__ void operator()(f32x4 (&acc)[2][2][4][2], const Unit& u, LAS unsigned char* lds, int wr, int wc, int fr, int fq) const {
        LAS const int* tab = (LAS const int*)(lds + TAB_OFF);
        const int e = u.aux, base = (u.pm - tab[e]) * BM, cnt = tab[40 + e];
        const int row0 = u.pm * BM + wr * 64 + fr;
        float rs[2][4];
#pragma unroll
        for (int ai = 0; ai < 2; ++ai)
#pragma unroll
            for (int m = 0; m < 4; ++m) { const int idx = base + ai * HALF + wr * 64 + m * 16 + fr; rs[ai][m] = (idx < cnt) ? __uint_as_float(list[(size_t)e * T + idx].z) : 0.f; }
#pragma unroll
        for (int ai = 0; ai < 2; ++ai)
#pragma unroll
            for (int m = 0; m < 4; ++m) { const size_t eo = (size_t)(row0 + ai * HALF + m * 16) * 512 + u.pn * 128 + wc * 32 + 8 * fq; f32x4 o[2]; const float r = rs[ai][m];
#pragma unroll
                for (int n = 0; n < 2; ++n)
#pragma unroll
                    for (int j = 0; j < 4; ++j) { const float a = acc[ai][0][m][n][j] * r; o[n][j] = a * sigmoidf_(a) * (acc[ai][1][m][n][j] * r); }
                if constexpr (OUT8) { u32x2 w; int p = __builtin_amdgcn_cvt_pk_fp8_f32(o[0][0] * 16.f, o[0][1] * 16.f, 0, false); p = __builtin_amdgcn_cvt_pk_fp8_f32(o[0][2] * 16.f, o[0][3] * 16.f, p, true); w.x = (unsigned)p;
                    p = __builtin_amdgcn_cvt_pk_fp8_f32(o[1][0] * 16.f, o[1][1] * 16.f, 0, false); p = __builtin_amdgcn_cvt_pk_fp8_f32(o[1][2] * 16.f, o[1][3] * 16.f, p, true); w.y = (unsigned)p;
                    *(u32x2*)((unsigned char*)Hid + (size_t)(u.pm * 4 + u.pn) * 32768 + (size_t)(ai * 16384 + m * 4096 + wr * 2048 + wc * 512 + fr * 32 + fq * 8)) = w; (void)eo; }
                else { u32x4 w; w.x = cvt_pk_bf16(o[0][0], o[0][1]); w.y = cvt_pk_bf16(o[0][2], o[0][3]); w.z = cvt_pk_bf16(o[1][0], o[1][1]); w.w = cvt_pk_bf16(o[1][2], o[1][3]);
                    *(u32x4*)((bf16_t*)Hid + eo) = w; } }
    }
};
template <bool OUT8> struct EpiDownT {
    void *Y0, *Y1; const u32x4* list;
    __device__ __forceinline__ void operator()(f32x4 (&acc)[2][2][4][2], const Unit& u, LAS unsigned char* lds, int wr, int wc, int fr, int fq) const {
        LAS const int* tab = (LAS const int*)(lds + TAB_OFF);
        const int e = u.aux, base = (u.pm - tab[e]) * BM, cnt = tab[40 + e];
        u32x2 ent[2][4];
#pragma unroll
        for (int ai = 0; ai < 2; ++ai)
#pragma unroll
            for (int m = 0; m < 4; ++m) { const int idx = base + ai * HALF + wr * 64 + m * 16 + fr; ent[ai][m] = (u32x2){0u, 0u}; if (idx < cnt) ent[ai][m] = *(const u32x2*)(list + (size_t)e * T + idx); }
#pragma unroll
        for (int ai = 0; ai < 2; ++ai)
#pragma unroll
            for (int m = 0; m < 4; ++m) { const int idx = base + ai * HALF + wr * 64 + m * 16 + fr;
                if (idx < cnt) { const u32x2 en = ent[ai][m]; const int tok = (int)(en.x & 0x7fffu); const float w = __uint_as_float(en.y);
                    const size_t eo = (size_t)tok * D + u.pn * BM + wc * 32 + 8 * fq; void* yb = (en.x >> 16) ? Y1 : Y0;
#pragma unroll
                    for (int bj = 0; bj < 2; ++bj) { const f32x4 v0 = acc[ai][bj][m][0] * w, v1 = acc[ai][bj][m][1] * w;
                        if constexpr (OUT8) { int p0 = __builtin_amdgcn_cvt_pk_fp8_f32(v0[0] * 16.f, v0[1] * 16.f, 0, false); p0 = __builtin_amdgcn_cvt_pk_fp8_f32(v0[2] * 16.f, v0[3] * 16.f, p0, true);
                            int p1 = __builtin_amdgcn_cvt_pk_fp8_f32(v1[0] * 16.f, v1[1] * 16.f, 0, false); p1 = __builtin_amdgcn_cvt_pk_fp8_f32(v1[2] * 16.f, v1[3] * 16.f, p1, true);
                            *(u32x2*)((unsigned char*)yb + eo + bj * HALF) = (u32x2){(unsigned)p0, (unsigned)p1}; }
                        else { u32x4 ww; ww.x = cvt_pk_bf16(v0[0], v0[1]); ww.y = cvt_pk_bf16(v0[2], v0[3]); ww.z = cvt_pk_bf16(v1[0], v1[1]); ww.w = cvt_pk_bf16(v1[2], v1[3]);
                            *(u32x4*)((bf16_t*)yb + eo + bj * HALF) = ww; } } } }
    }
};
struct EpiProbe {
    float* dummy;
    __device__ __forceinline__ void operator()(f32x4 (&acc)[2][2][4][2], const Unit& u, LAS unsigned char*, int wr, int wc, int fr, int fq) const {
        f32x4 s = (f32x4){0.f, 0.f, 0.f, 0.f};
#pragma unroll
        for (int ai = 0; ai < 2; ++ai)
#pragma unroll
            for (int bj = 0; bj < 2; ++bj)
#pragma unroll
                for (int m = 0; m < 4; ++m)
#pragma unroll
                    for (int n = 0; n < 2; ++n) s += acc[ai][bj][m][n];
        if (s[0] + s[1] + s[2] + s[3] == 12345.678f) dummy[u.pm * 64 + fr] = s[0];
    }
};
}

namespace at {
#define SBAR() __builtin_amdgcn_sched_barrier(0)
__device__ __forceinline__ int crow(int r, int hi) { return (r & 3) + 8 * (r >> 2) + 4 * hi; }
template <int DQK> __device__ __forceinline__ int kswz(int row, int colB) { if (DQK == 128) return row * 256 + (colB ^ ((row & 15) << 4));     else return row * 128 + (colB ^ (((row >> 1) & 7) << 4)); }
constexpr int SHM_V = 64 * 128 * 2;
constexpr int LDS_WS = 131072;
__device__ __forceinline__ int v_st(int k, int c) { const int kk = (k & ~0xC) | ((k & 4) << 1) | ((k & 8) >> 1); return ((kk >> 3) * 4 + (c >> 5)) * 512 + ((kk & 7) * 32 + (c & 31)) * 2; }
__device__ __forceinline__ int v_rd_base(int lane) { return ((lane & 3) << 3) | (((lane >> 2) & 3) << 6) | (((lane >> 4) & 1) << 5) | (((lane >> 5) & 1) << 8); }
constexpr int v_rd_off(int d0, int ks, int half) { return d0 * 512 + ks * 4096 + half * 2048; }
template <int OFF> __device__ __forceinline__ s16x4 tr_read(unsigned vb) { s16x4 r; asm volatile("ds_read_b64_tr_b16 %0, %1 offset:%2" : "=&v"(r) : "v"(vb), "i"(OFF) : "memory"); return r; }
template <int D0> __device__ __forceinline__ void v_read8(s16x4 (&v)[8], unsigned vb) {
    v[0] = tr_read<v_rd_off(D0, 0, 0)>(vb); v[1] = tr_read<v_rd_off(D0, 0, 1)>(vb); v[2] = tr_read<v_rd_off(D0, 1, 0)>(vb); v[3] = tr_read<v_rd_off(D0, 1, 1)>(vb);
    v[4] = tr_read<v_rd_off(D0, 2, 0)>(vb); v[5] = tr_read<v_rd_off(D0, 2, 1)>(vb); v[6] = tr_read<v_rd_off(D0, 3, 0)>(vb); v[7] = tr_read<v_rd_off(D0, 3, 1)>(vb);
}
__device__ __forceinline__ void pv_mma4(f32x16& od, const s16x4 (&v)[8], bf16x8 pa0, bf16x8 pa1, bf16x8 pa2, bf16x8 pa3) {
#define AT_PK(L, H) (bf16x8){L[0], L[1], L[2], L[3], H[0], H[1], H[2], H[3]}
    od = __builtin_amdgcn_mfma_f32_32x32x16_bf16(pa0, AT_PK(v[0], v[1]), od, 0, 0, 0);
    od = __builtin_amdgcn_mfma_f32_32x32x16_bf16(pa1, AT_PK(v[2], v[3]), od, 0, 0, 0);
    od = __builtin_amdgcn_mfma_f32_32x32x16_bf16(pa2, AT_PK(v[4], v[5]), od, 0, 0, 0);
    od = __builtin_amdgcn_mfma_f32_32x32x16_bf16(pa3, AT_PK(v[6], v[7]), od, 0, 0, 0);
#undef AT_PK
}
__device__ __forceinline__ void pv_d0(f32x16* o, unsigned vb, bf16x8 pa0, bf16x8 pa1, bf16x8 pa2, bf16x8 pa3) {
    s16x4 va[8], vb8[8];
    v_read8<0>(va, vb);
    v_read8<1>(vb8, vb); asm volatile("s_waitcnt lgkmcnt(8)" ::: "memory"); SBAR(); pv_mma4(o[0], va, pa0, pa1, pa2, pa3);
    v_read8<2>(va, vb);  asm volatile("s_waitcnt lgkmcnt(8)" ::: "memory"); SBAR(); pv_mma4(o[1], vb8, pa0, pa1, pa2, pa3);
    v_read8<3>(vb8, vb); asm volatile("s_waitcnt lgkmcnt(8)" ::: "memory"); SBAR(); pv_mma4(o[2], va, pa0, pa1, pa2, pa3);
    asm volatile("s_waitcnt lgkmcnt(0)" ::: "memory"); SBAR(); pv_mma4(o[3], vb8, pa0, pa1, pa2, pa3);
}
template <int DQK> struct SmC { static constexpr float SCALE = (DQK == 128) ? 0.08838834764831845f : 0.125f; static constexpr float MNAT = (DQK == 128) ? 16.f : 12.f; };
template <int DQK> __device__ __forceinline__ void softmax_tile(f32x16& p0, f32x16& p1, float& l_reg, bf16x8& pa0, bf16x8& pa1, bf16x8& pa2, bf16x8& pa3) {
    constexpr float C = SmC<DQK>::SCALE * 1.4426950408889634f, MC = -SmC<DQK>::MNAT * 1.4426950408889634f;
#pragma unroll
    for (int r = 0; r < 16; ++r) p0[r] = __builtin_amdgcn_exp2f(fmaf(p0[r], C, MC));
#pragma unroll
    for (int r = 0; r < 16; ++r) p1[r] = __builtin_amdgcn_exp2f(fmaf(p1[r], C, MC));
    float ps = 0;
#pragma unroll
    for (int r = 0; r < 16; ++r) ps += p0[r];
#pragma unroll
    for (int r = 0; r < 16; ++r) ps += p1[r];
    { auto rr = __builtin_amdgcn_permlane32_swap(__float_as_uint(ps), __float_as_uint(ps), false, false);
      ps = __uint_as_float(rr[0]) + __uint_as_float(rr[1]); }
    l_reg += ps;
#define AT_PK4(P, BASE, OUT) do { unsigned a0 = cvt_pk_bf16(P[BASE + 0], P[BASE + 1]), a1 = cvt_pk_bf16(P[BASE + 2], P[BASE + 3]);   \
    unsigned b0 = cvt_pk_bf16(P[BASE + 4], P[BASE + 5]), b1 = cvt_pk_bf16(P[BASE + 6], P[BASE + 7]);                              \
    auto r0 = __builtin_amdgcn_permlane32_swap(a0, b0, false, false); auto r1 = __builtin_amdgcn_permlane32_swap(a1, b1, false, false); \
    u32x4 w = {r0[0], r1[0], r0[1], r1[1]}; OUT = __builtin_bit_cast(bf16x8, w); } while (0)
    AT_PK4(p0, 0, pa0); AT_PK4(p0, 8, pa1); AT_PK4(p1, 0, pa2); AT_PK4(p1, 8, pa3);
#undef AT_PK4
}
template <int DQK> __device__ __forceinline__ void qkt(f32x16& p0, f32x16& p1, LAS const unsigned char* Ks, const bf16x8* qr, int r32, int hi) {
#pragma unroll
    for (int r = 0; r < 16; ++r) { p0[r] = 0.f; p1[r] = 0.f; }
#pragma unroll
    for (int d0 = 0; d0 < DQK / 16; ++d0) { const int cb = (d0 * 16 + hi * 8) * 2;
        const bf16x8 b0 = *(LAS const bf16x8*)(Ks + kswz<DQK>(r32, cb));
        const bf16x8 b1 = *(LAS const bf16x8*)(Ks + kswz<DQK>(32 + r32, cb));
        p0 = __builtin_amdgcn_mfma_f32_32x32x16_bf16(b0, qr[d0], p0, 0, 0, 0);
        p1 = __builtin_amdgcn_mfma_f32_32x32x16_bf16(b1, qr[d0], p1, 0, 0, 0); }
}
struct AttnP {
    const bf16_t *zq, *zk, *zv;
    int tokbase, stride;
    int q0;
    int kstart;
    int NT;
    int W;
};
__device__ __forceinline__ void mask_tile(f32x16& p0, f32x16& p1, int qm, int kb, int W, int hi, int qw0) {
    const bool full = (qw0 - (kb + 63) >= 0) && (qw0 + 31 - kb <= W) && (kb >= 0);
    if (full) return;
    const float ninf = -__builtin_inff();
#pragma unroll
    for (int r = 0; r < 16; ++r) { const int km = kb + crow(r, hi); const int d0 = qm - km, d1 = d0 - 32;
        p0[r] = (d0 >= 0 && d0 <= W && km >= 0) ? p0[r] : ninf;
        p1[r] = (d1 >= 0 && d1 <= W && km + 32 >= 0) ? p1[r] : ninf; }
}
template <int DQK>
__device__ __forceinline__ void attn_run(const AttnP& P, LAS unsigned char* lds, f32x16 (&o)[4], float& l_reg, float& m_reg) {
    const int tid = opaque_tid(), wid = __builtin_amdgcn_readfirstlane(tid >> 6), lane = tid & 63, r32 = lane & 31, hi = lane >> 5;
    constexpr int KSUB = 64 * DQK * 2, KBUF = 2 * KSUB, VSUB = 16384, VBUF = 2 * VSUB;
    LAS unsigned char* K_lds = lds; LAS unsigned char* V_lds = lds + 2 * KBUF;
    m_reg = SmC<DQK>::MNAT / SmC<DQK>::SCALE; l_reg = 0.f;
#pragma unroll
    for (int d = 0; d < 4; ++d)
#pragma unroll
        for (int r = 0; r < 16; ++r) o[d][r] = 0.f;
    const int qw0 = P.q0 + wid * 32, qm = qw0 + r32;
    bf16x8 qr[DQK / 16];
    { const bf16_t* Qw = P.zq + (size_t)(P.tokbase + qm * P.stride) * WIN + hi * 8;
#pragma unroll
      for (int d0 = 0; d0 < DQK / 16; ++d0) qr[d0] = *(const bf16x8*)(Qw + d0 * 16); }
    int vkey[2], vcol[2], kkey[2], kcol[2];
#pragma unroll
    for (int i = 0; i < 2; ++i) { const int off = (tid + 512 * i) * 16; const int sub = off >> 9, within = off & 511, kk = (sub >> 2) * 8 + (within >> 6);
        vkey[i] = (kk & ~0xC) | ((kk & 4) << 1) | ((kk & 8) >> 1); vcol[i] = (sub & 3) * 32 + ((within & 63) >> 1);
        if (DQK == 128) { const int row = off >> 8, cs = off & 255; kkey[i] = row; kcol[i] = (cs ^ ((row & 15) << 4)) >> 1; }
        else { const int row = off >> 7, cs = off & 127; kkey[i] = row; kcol[i] = (cs ^ (((row >> 1) & 7) << 4)) >> 1; } }
    const unsigned vb0 = (unsigned)(size_t)V_lds + v_rd_base(lane);
#define AT_ROW(km) ((size_t)(P.tokbase + ((km) < 0 ? 0 : (km)) * P.stride) * WIN)
#define AT_DMA(jp, b) do { _Pragma("unroll") for (int s_ = 0; s_ < 2; ++s_) { const int k0_ = P.kstart + (2 * (jp) + s_) * 64; \
        _Pragma("unroll") for (int i_ = 0; i_ < 2; ++i_) __builtin_amdgcn_global_load_lds((const unsigned*)(P.zv + AT_ROW(k0_ + vkey[i_]) + vcol[i_]), (LAS unsigned*)(V_lds + (b) * VBUF + s_ * VSUB + wid * 1024 + i_ * 8192), 16, 0, 0); \
        _Pragma("unroll") for (int i_ = 0; i_ < (DQK == 128 ? 2 : 1); ++i_) __builtin_amdgcn_global_load_lds((const unsigned*)(P.zk + AT_ROW(k0_ + kkey[i_]) + kcol[i_]), (LAS unsigned*)(K_lds + (b) * KBUF + s_ * KSUB + wid * 1024 + i_ * 8192), 16, 0, 0); } } while (0)
    f32x16 pA0, pA1, pB0, pB1; bf16x8 pa0, pa1, pa2, pa3; const int NT2 = P.NT >> 1;
    AT_DMA(0, 0); VM_WAIT(); __syncthreads();
#pragma unroll 1
    for (int jp = 0; jp < NT2; ++jp) {
        const int b = jp & 1;
        if (jp + 1 < NT2) AT_DMA(jp + 1, b ^ 1);
        SBAR();
        const int kbA = P.kstart + jp * 128, kbB = kbA + 64;
        const bool noneA = (qw0 + 31 - kbA < 0) || (qw0 - (kbA + 63) > P.W) || (kbA + 63 < 0);
        const bool noneB = (qw0 + 31 - kbB < 0) || (qw0 - (kbB + 63) > P.W) || (kbB + 63 < 0);
        if (!noneA) qkt<DQK>(pA0, pA1, K_lds + b * KBUF, qr, r32, hi);
        if (!noneB) qkt<DQK>(pB0, pB1, K_lds + b * KBUF + KSUB, qr, r32, hi);
        SBAR();
        if (!noneA) { mask_tile(pA0, pA1, qm, kbA, P.W, hi, qw0); softmax_tile<DQK>(pA0, pA1, l_reg, pa0, pa1, pa2, pa3); SBAR(); pv_d0(o, vb0 + b * VBUF, pa0, pa1, pa2, pa3); }
        if (!noneB) { mask_tile(pB0, pB1, qm, kbB, P.W, hi, qw0); softmax_tile<DQK>(pB0, pB1, l_reg, pa0, pa1, pa2, pa3); SBAR(); pv_d0(o, vb0 + b * VBUF + VSUB, pa0, pa1, pa2, pa3); }
        VM_WAIT(); __syncthreads();
    }
#undef AT_ROW
#undef AT_DMA
}
__device__ __forceinline__ void attn_normalise(LAS unsigned char* lds, f32x16 (&o)[4], float l_reg) {
    const int tid = opaque_tid(), wid = tid >> 6, lane = tid & 63, r32 = lane & 31, hi = lane >> 5;
    LAS float* li_l = (LAS float*)(lds + LDS_WS) + wid * 64;
    if (hi == 0) li_l[r32] = l_reg; asm volatile("s_waitcnt lgkmcnt(0)" ::: "memory");
#pragma unroll
    for (int r = 0; r < 16; ++r) { const float rl = __builtin_amdgcn_rcpf(li_l[crow(r, hi)]);
#pragma unroll
        for (int d = 0; d < 4; ++d) o[d][r] *= rl; }
    asm volatile("s_waitcnt lgkmcnt(0)" ::: "memory");
}
}

#define XB_TMO      128
#define XB_XCNT(j)  (256  + 64 * (j))
#define XB_XSUB(j)  (1280 + 64 * (j))
#define XB_XGEN(j)  (2304 + 64 * (j))
#define XB_TOP      3328
#define XB_TOPGEN   3392
#define XCD_BAR_WORDS 3456
#define XB_SPIN_CAP (1u << 18)

__device__ __forceinline__ unsigned xb_ld(unsigned* p)              { return __hip_atomic_load(p, __ATOMIC_RELAXED, __HIP_MEMORY_SCOPE_AGENT); }
__device__ __forceinline__ unsigned xb_add(unsigned* p, unsigned v) { return __hip_atomic_fetch_add(p, v, __ATOMIC_RELAXED, __HIP_MEMORY_SCOPE_AGENT); }
__device__ __forceinline__ unsigned xb_xcc_id() { return (unsigned)__builtin_amdgcn_s_getreg((3 << 11) | 20) & 0xFu; }
#define XB_SPIN(cond, bar) do { unsigned _sp = 0; while (cond) { __builtin_amdgcn_s_sleep(1); \
    if ((++_sp & 255u) == 0u) { if (xb_ld(&(bar)[XB_TMO])) break; if (_sp > XB_SPIN_CAP) { atomicAdd(&(bar)[XB_TMO], 1u); break; } } } } while (0)

struct XcdBarrier {
    unsigned* bar; unsigned x;
    volatile LAS unsigned* st;
};

__device__ __forceinline__ XcdBarrier xcd_barrier_post(unsigned* bar, volatile LAS unsigned* st) {
    XcdBarrier b; b.bar = bar; b.x = xb_xcc_id(); b.st = st;
    if (threadIdx.x == 0) (void)xb_add(&bar[XB_XCNT(b.x)], 1u);
    return b;
}
__device__ __forceinline__ void xcd_barrier_complete(unsigned* bar, unsigned x, unsigned& nloc, unsigned& nx) {
    const unsigned G = gridDim.x * gridDim.y * gridDim.z;
    unsigned sum, cnt, mine, sp = 0u;
    for (;;) {
        sum = 0u; cnt = 0u; mine = 0u;
#pragma unroll
        for (unsigned j = 0; j < 16; ++j) { const unsigned c = xb_ld(&bar[XB_XCNT(j)]); sum += c; cnt += (c > 0u) ? 1u : 0u; mine = (j == x) ? c : mine; }
        if (sum == G) break;
        __builtin_amdgcn_s_sleep(1);
        if ((++sp & 255u) == 0u) { if (xb_ld(&bar[XB_TMO])) break; if (sp > XB_SPIN_CAP) { atomicAdd(&bar[XB_TMO], 1u); break; } }
    }
    nloc = mine > 0u ? mine : 1u; nx = cnt > 0u ? cnt : 1u;
}

__device__ __forceinline__ void xcd_barrier(const XcdBarrier& b) {
    asm volatile("s_waitcnt vmcnt(0)" ::: "memory");
    __syncthreads();
    if (threadIdx.x == 0) {
        unsigned* bar = b.bar;
        __builtin_amdgcn_s_waitcnt(0);
        unsigned nloc = b.st[0], nx = b.st[1];
        if (nloc == 0u) { xcd_barrier_complete(bar, b.x, nloc, nx); b.st[0] = nloc; b.st[1] = nx; }
        const unsigned old = xb_add(&bar[XB_XSUB(b.x)], 1u);
        const unsigned gen = old / nloc;
        if (old + 1u == (gen + 1u) * nloc) {
            __builtin_amdgcn_fence(__ATOMIC_RELEASE, "agent");
            asm volatile("s_waitcnt vmcnt(0)" ::: "memory");
            const unsigned og = xb_add(&bar[XB_TOP], 1u);
            const unsigned tg = og / nx;
            if (og + 1u == (tg + 1u) * nx) xb_add(&bar[XB_TOPGEN], 1u);
            else XB_SPIN(xb_ld(&bar[XB_TOPGEN]) == tg, bar);
            __builtin_amdgcn_fence(__ATOMIC_ACQUIRE, "agent");
            xb_add(&bar[XB_XGEN(b.x)], 1u);
            asm volatile("s_waitcnt vmcnt(0)" ::: "memory");
        } else {
            XB_SPIN(xb_ld(&bar[XB_XGEN(b.x)]) == gen, bar);
            __builtin_amdgcn_fence(__ATOMIC_ACQUIRE, "agent");
            asm volatile("s_waitcnt vmcnt(0)" ::: "memory");
        }
    }
    __syncthreads();
}

struct Args { const float* in[27]; float* out; unsigned char* ws; int ph_lo, ph_hi, mix_mask, pad; };
enum { I_X = 0, I_NORM_MIX, I_W_IN, I_SG_NORM, I_SG_W, I_SG_B, I_CONV_W, I_QN_C, I_KN_C, I_QN_D, I_KN_D, I_LQ1, I_LK1, I_LQ2, I_LK2, I_SUBLN, I_W_GATE, I_B_GATE, I_W_BRANCH, I_W_OUT,
       I_NORM_FFN, I_W_RG, I_B_RG, I_W_RE, I_B_RE, I_W_UP, I_W_DOWN };

__device__ __forceinline__ int perm_in(int n) {
    const int pn = n >> 8, tc = n & 255, bj = tc >> 7, wc = (tc >> 5) & 3, x = tc & 31;
    if (pn >= 10 && pn < 22) return ZC + (2 * (pn - 10) + (wc >> 1)) * 128 + 64 * bj + 32 * (wc & 1) + x;
    if (pn >= 28 && pn < 32) return ZD + (pn - 28) * 256 + wc * 64 + 32 * bj + x;
    return n;
}
__device__ __forceinline__ void tr_item(const float* colp, size_t ld, bf16_t* WT, int ldk, int n0, int k0, LAS float* scr, int lane) {
#pragma unroll 8
    for (int i = 0; i < 32; ++i) { const int kk = 2 * i + (lane >> 5); scr[kk * 33 + (lane & 31)] = colp[(size_t)(k0 + kk) * ld]; }
    LDS_WAIT(); asm volatile("" ::: "memory");
    const int c = lane & 7;
#pragma unroll
    for (int j = 0; j < 4; ++j) { const int n = (lane >> 3) + 8 * j; const LAS float* s = scr + (8 * c) * 33 + n;
        u32x4 o; o.x = cvt_pk_bf16(s[0 * 33], s[1 * 33]); o.y = cvt_pk_bf16(s[2 * 33], s[3 * 33]); o.z = cvt_pk_bf16(s[4 * 33], s[5 * 33]); o.w = cvt_pk_bf16(s[6 * 33], s[7 * 33]);
        *(u32x4*)(WT + (size_t)(n0 + n) * ldk + k0 + 8 * c) = o; }
    LDS_WAIT(); asm volatile("" ::: "memory");
}
__device__ __forceinline__ void tr_item_fp8(const float* colp, size_t ld, unsigned char* WT, int ldk, int n0, int k0, LAS float* scr, int lane, float scale) {
#pragma unroll 8
    for (int i = 0; i < 32; ++i) { const int kk = 2 * i + (lane >> 5); scr[kk * 33 + (lane & 31)] = colp[(size_t)(k0 + kk) * ld]; }
    LDS_WAIT(); asm volatile("" ::: "memory");
    const int n = lane >> 1, kh = (lane & 1) * 32; const LAS float* s = scr + kh * 33 + n;
    u32x4 o[2];
#pragma unroll
    for (int q = 0; q < 8; ++q) { int p = __builtin_amdgcn_cvt_pk_fp8_f32(s[(4 * q) * 33] * scale, s[(4 * q + 1) * 33] * scale, 0, false); p = __builtin_amdgcn_cvt_pk_fp8_f32(s[(4 * q + 2) * 33] * scale, s[(4 * q + 3) * 33] * scale, p, true); o[q >> 2][q & 3] = (unsigned)p; }
    *(u32x4*)(WT + (size_t)(n0 + n) * ldk + k0 + kh) = o[0]; *(u32x4*)(WT + (size_t)(n0 + n) * ldk + k0 + kh + 16) = o[1];
    LDS_WAIT(); asm volatile("" ::: "memory");
}
struct TrItem { const float* ub; unsigned vo; unsigned char* dst; };
__device__ __forceinline__ unsigned char* wt_tile_addr(unsigned char* wt0, const int ldk, const size_t off  ) {
    const int sh = 31 - __builtin_clz(ldk); const int n = (int)(off >> sh), kb = (int)(off & (size_t)(ldk - 1));
    const int rb = n & 127, x = rb & 31, R = (rb & ~31) + 16 * ((x >> 2) & 1) + 4 * (x >> 3) + (x & 3), C = (kb & 127) >> 1;
    return wt0 + (size_t)(n >> 8) * 256 * ldk + (size_t)((kb >> 7) * 2 + ((n >> 7) & 1)) * 16384 + gm::lds_byte(R, C);
}
template <bool F8>
__device__ __forceinline__ void tr_finish(unsigned char* wt0, unsigned char* dst, const int ldk, LAS float* scr, const int lane) {
    LDS_WAIT(); asm volatile("" ::: "memory");
    if constexpr (F8) {
        const int nn = lane >> 1, k32 = (lane & 1) * 32; const LAS float* s = scr + k32 * 33 + nn;
        u32x4 o[2];
#pragma unroll
        for (int q = 0; q < 8; ++q) { int p = __builtin_amdgcn_cvt_pk_fp8_f32(s[(4 * q) * 33] * 64.f, s[(4 * q + 1) * 33] * 64.f, 0, false); p = __builtin_amdgcn_cvt_pk_fp8_f32(s[(4 * q + 2) * 33] * 64.f, s[(4 * q + 3) * 33] * 64.f, p, true); o[q >> 2][q & 3] = (unsigned)p; }
        const size_t off = (size_t)(dst - wt0) + (size_t)nn * ldk + k32;
        *(u32x4*)wt_tile_addr(wt0, ldk, off) = o[0]; *(u32x4*)wt_tile_addr(wt0, ldk, off + 16) = o[1];
    } else {
        const int c = lane & 7;
#pragma unroll
        for (int j = 0; j < 4; ++j) { const int nn = (lane >> 3) + 8 * j; const LAS float* s = scr + (8 * c) * 33 + nn;
            u32x4 o; o.x = cvt_pk_bf16(s[0 * 33], s[1 * 33]); o.y = cvt_pk_bf16(s[2 * 33], s[3 * 33]); o.z = cvt_pk_bf16(s[4 * 33], s[5 * 33]); o.w = cvt_pk_bf16(s[6 * 33], s[7 * 33]);
            *(u32x4*)wt_tile_addr(wt0, ldk, (size_t)(dst - wt0) + (size_t)nn * ldk + 16 * c) = o; }
    }
    LDS_WAIT(); asm volatile("" ::: "memory");
}
#define TR_LOAD(v, t) do { _Pragma("unroll") for (int i = 0; i < 32; ++i) v[i] = __builtin_nontemporal_load((const float*)((const char*)((t).ub + (size_t)(2 * i) * ld) + ((t).vo + khb))); } while (0)
#define TR_PUT(v) do { _Pragma("unroll") for (int i = 0; i < 32; ++i) scr[(2 * i + kh) * 33 + l32] = v[i]; } while (0)
template <bool F8, class F>
__device__ __forceinline__ void tr_loop(const int n, const int gw, const int NGW, const size_t ld, const int ldk  , unsigned char* wt0, LAS float* scr, const int lane, F f) {
    int itA = __builtin_amdgcn_readfirstlane(gw); if (itA >= n) return;
    int itB = itA + NGW; bool hB = itB < n;
    const int kh = lane >> 5, l32 = lane & 31; const unsigned khb = (unsigned)(kh * ld * 4);
    TrItem A = f(itA), B = f(hB ? itB : itA);
    float va[32], vb[32];
    TR_LOAD(va, A);
    if (hB) TR_LOAD(vb, B);
    for (;;) {
        TR_PUT(va); const int nA = itA + 2 * NGW; const bool hnA = nA < n; unsigned char* dA = A.dst; if (hnA) { A = f(nA); TR_LOAD(va, A); }
        tr_finish<F8>(wt0, dA, ldk, scr, lane); itA = nA;
        if (!hB) break;
        TR_PUT(vb); const int nB = itB + 2 * NGW; const bool hnB = nB < n; unsigned char* dB = B.dst; if (hnB) { B = f(nB); TR_LOAD(vb, B); }
        tr_finish<F8>(wt0, dB, ldk, scr, lane); itB = nB;
        if (!hnA) break;
        hB = hnB;
    }
}
__device__ __forceinline__ void phase_prologue(const Args& a, LAS unsigned char* lds, const int part) {
    const int tid = opaque_tid(), wave = tid >> 6, lane = tid & 63, gw = blockIdx.x * NWAVES + wave, NGW = gridDim.x * NWAVES;
    LAS float* scr = (LAS float*)(lds + wave * 8704);
    const int l32 = lane & 31;
    for (int l = 0; l < 2; ++l) {
        unsigned char* wb = a.ws + WS_W + (size_t)l * W_LAYER;
        if ((l == 0) == (part == 0)) {
            const float* W = a.in[I_W_IN] + (size_t)l * D * WIN; unsigned char* WT = wb + W_IN; const int nblk = WIN / 32;
            if ((MK_Z8 >> l) & 1) tr_loop<true>((D / 64) * nblk, gw, NGW, WIN, D, WT, scr, lane, [=](int it) { const int kb = it / nblk, nb = it % nblk;
                return TrItem{W + (size_t)kb * 64 * WIN, (unsigned)perm_in(nb * 32 + l32) * 4u, WT + (size_t)nb * 32 * D + kb * 64}; });
            else tr_loop<false>((D / 64) * nblk, gw, NGW, WIN, 2 * D, WT, scr, lane, [=](int it) { const int kb = it / nblk, nb = it % nblk;
                return TrItem{W + (size_t)kb * 64 * WIN, (unsigned)perm_in(nb * 32 + l32) * 4u, WT + ((size_t)nb * 32 * D + kb * 64) * 2}; }); }
        if (part == 1) {
            const float* W = a.in[I_W_GATE] + (size_t)l * 4 * D * D; unsigned char* WT = wb + W_G; const int nblk = 8192 / 32;
            tr_loop<true>((D / 64) * nblk, gw, NGW, D, D, WT, scr, lane, [=](int it) { const int kb = it / nblk, nb = it % nblk; const int n = nb * 32 + l32, pn = n >> 8, tc = n & 255;
                const int bj = tc >> 7, wc = (tc >> 5) & 3, fq = (tc >> 3) & 3, nn = (tc >> 2) & 1, j = tc & 3, k = 2 * bj + nn, c = 64 * pn + 16 * wc + 4 * fq + j;
                return TrItem{W + (size_t)kb * 64 * D, (unsigned)(k * D * D + c) * 4u, WT + (size_t)nb * 32 * D + kb * 64}; }); }
        if (part == 1) {
            const float* W = a.in[I_W_BRANCH] + (size_t)l * 4 * 512 * D; unsigned char* WT = wb + W_B; const int nblk = D / 32, per = (512 / 64) * nblk;
            tr_loop<false>(4 * per, gw, NGW, D, 1024, WT, scr, lane, [=](int it) { const int k = it / per, r = it % per, kb = r / nblk, nb = r % nblk;
                return TrItem{W + (size_t)k * 512 * D + nb * 32 + (size_t)kb * 64 * D, (unsigned)l32 * 4u, WT + ((size_t)k * D * 512 + (size_t)nb * 32 * 512 + kb * 64) * 2}; }); }
        if (part == 1) {
            const float* W = a.in[I_W_OUT] + (size_t)l * D * D; unsigned char* WT = wb + W_O; const int nblk = D / 32;
            if (((MK_WO8 >> l) & 1) && !MK_DEBUG) tr_loop<true>((D / 64) * nblk, gw, NGW, D, D, WT, scr, lane, [=](int it) { const int kb = it / nblk, nb = it % nblk;
                return TrItem{W + nb * 32 + (size_t)kb * 64 * D, (unsigned)l32 * 4u, WT + (size_t)nb * 32 * D + kb * 64}; });
            else tr_loop<false>((D / 64) * nblk, gw, NGW, D, 2 * D, WT, scr, lane, [=](int it) { const int kb = it / nblk, nb = it % nblk;
                return TrItem{W + nb * 32 + (size_t)kb * 64 * D, (unsigned)l32 * 4u, WT + ((size_t)nb * 32 * D + kb * 64) * 2}; }); }
        if (part == 1) {
            const float* W = a.in[I_W_UP] + (size_t)l * NEXP * D * 1024; unsigned char* WT = wb + W_UP; const int nblk = 1024 / 32, per = (D / 64) * nblk;
            if (MK_MOE8 && l >= 0) tr_loop<true>(NEXP * per, gw, NGW, 1024, D, WT, scr, lane, [=](int it) { const int e = it / per, r = it % per, kb = r / nblk, nb = r % nblk; const int n = nb * 32 + l32, pn = n >> 8, tc = n & 255;
                const int sc = (tc >> 7) * 512 + 128 * pn + (tc & 127);
                return TrItem{W + (size_t)e * D * 1024 + (size_t)kb * 64 * 1024, (unsigned)sc * 4u, WT + (size_t)e * 1024 * D + (size_t)nb * 32 * D + kb * 64}; });
            else tr_loop<false>(NEXP * per, gw, NGW, 1024, 2 * D, WT, scr, lane, [=](int it) { const int e = it / per, r = it % per, kb = r / nblk, nb = r % nblk; const int n = nb * 32 + l32, pn = n >> 8, tc = n & 255;
                const int sc = (tc >> 7) * 512 + 128 * pn + (tc & 127);
                return TrItem{W + (size_t)e * D * 1024 + (size_t)kb * 64 * 1024, (unsigned)sc * 4u, WT + ((size_t)e * 1024 * D + (size_t)nb * 32 * D + kb * 64) * 2}; }); }
        if (part == 1) {
            const float* W = a.in[I_W_DOWN] + (size_t)l * NEXP * 512 * D; unsigned char* WT = wb + W_DN; const int nblk = D / 32, per = (512 / 64) * nblk;
            if (MK_MOE8 && l >= 0) tr_loop<true>(NEXP * per, gw, NGW, D, 512, WT, scr, lane, [=](int it) { const int e = it / per, r = it % per, kb = r / nblk, nb = r % nblk;
                return TrItem{W + (size_t)e * 512 * D + nb * 32 + (size_t)kb * 64 * D, (unsigned)l32 * 4u, WT + (size_t)e * D * 512 + (size_t)nb * 32 * 512 + kb * 64}; });
            else tr_loop<false>(NEXP * per, gw, NGW, D, 1024, WT, scr, lane, [=](int it) { const int e = it / per, r = it % per, kb = r / nblk, nb = r % nblk;
                return TrItem{W + (size_t)e * 512 * D + nb * 32 + (size_t)kb * 64 * D, (unsigned)l32 * 4u, WT + ((size_t)e * D * 512 + (size_t)nb * 32 * 512 + kb * 64) * 2}; }); }
        if (part == 0) {
            bf16_t* WT = (bf16_t*)(wb + W_R); const float* wrg = a.in[I_W_RG] + (size_t)l * D * 4; const float* wre = a.in[I_W_RE] + (size_t)l * D * 32;
            for (int i = blockIdx.x * NTHR + tid; i < 48 * D; i += gridDim.x * NTHR) { const int n = i / D, k = i % D; float v = 0.f;
                if (n < 4) v = wrg[k * 4 + n]; else if (n < 36) v = wre[k * 32 + (n - 4)];
                WT[i] = (bf16_t)(cvt_pk_bf16(v, 0.f) & 0xffffu); } }
        if (part == 0) {
            u32x4* WS = (u32x4*)(wb + W_SG); const float* Wsg = a.in[I_SG_W] + (size_t)l * 4 * 128 * 128;
            for (int s = blockIdx.x * NTHR + tid; s < 4 * 4 * 2 * 4 * 64; s += gridDim.x * NTHR) { const int ln = s & 63, ks = (s >> 6) & 3, jt = (s >> 8) & 1, ib = (s >> 9) & 3, g = s >> 11;
                const int i = 32 * ib + (ln & 31), j0 = 64 * jt + 16 * ks + 8 * (ln >> 5); const float* wr_ = Wsg + ((size_t)g * 128 + i) * 128 + j0; float w[8];
#pragma unroll
                for (int q = 0; q < 8; ++q) w[q] = (j0 + q <= i) ? wr_[q] : 0.f;
                u32x4 pk; pk.x = cvt_pk_bf16(w[0], w[1]); pk.y = cvt_pk_bf16(w[2], w[3]); pk.z = cvt_pk_bf16(w[4], w[5]); pk.w = cvt_pk_bf16(w[6], w[7]); WS[s] = pk; } }
    }
}
__device__ __forceinline__ void phase_norm(const float* xf, const bf16_t* xb, const bf16_t* y0, const bf16_t* y1, bf16_t* xb_out, float* xf_out, const float* gain, bf16_t* h, unsigned* h8, const bool y8 = false) {
    const int tid = opaque_tid(), wave = tid >> 6, lane = tid & 63, gw = blockIdx.x * NWAVES + wave, NGW = gridDim.x * NWAVES;
    f32x4 gv[8];
#pragma unroll
    for (int j = 0; j < 8; ++j) gv[j] = gain ? ((const f32x4*)gain)[lane + 64 * j] : (f32x4){0.f, 0.f, 0.f, 0.f};
    for (int m0 = gw; m0 < T; m0 += 2 * NGW) {
        f32x4 v[2][8];
#pragma unroll
        for (int r = 0; r < 2; ++r) { const int m = m0 + r * NGW; if (m < T) {
            if (xf) { const f32x4* xr = (const f32x4*)(xf + (size_t)m * D) + lane;
#pragma unroll
                for (int j = 0; j < 8; ++j) v[r][j] = __builtin_nontemporal_load(xr + 64 * j); }
            else { const u32x2* xr = (const u32x2*)(xb + (size_t)m * D) + lane;
#pragma unroll
                for (int j = 0; j < 8; ++j) { const u32x2 p = xr[64 * j]; v[r][j] = (f32x4){bf_lo(p.x), bf_hi(p.x), bf_lo(p.y), bf_hi(p.y)}; } } } }
        if (y0) {
#pragma unroll
            for (int r = 0; r < 2; ++r) { const int m = m0 + r * NGW; if (m < T) {
                if (y8) { const unsigned* a0 = (const unsigned*)((const unsigned char*)y0 + (size_t)m * D) + lane; const unsigned* a1 = (const unsigned*)((const unsigned char*)y1 + (size_t)m * D) + lane;
#pragma unroll
                    for (int j = 0; j < 8; ++j) { const int p = (int)__builtin_nontemporal_load(a0 + 64 * j), q = (int)__builtin_nontemporal_load(a1 + 64 * j);
                        v[r][j][0] += (__builtin_amdgcn_cvt_f32_fp8(p, 0) + __builtin_amdgcn_cvt_f32_fp8(q, 0)) * 0.0625f; v[r][j][1] += (__builtin_amdgcn_cvt_f32_fp8(p, 1) + __builtin_amdgcn_cvt_f32_fp8(q, 1)) * 0.0625f;
                        v[r][j][2] += (__builtin_amdgcn_cvt_f32_fp8(p, 2) + __builtin_amdgcn_cvt_f32_fp8(q, 2)) * 0.0625f; v[r][j][3] += (__builtin_amdgcn_cvt_f32_fp8(p, 3) + __builtin_amdgcn_cvt_f32_fp8(q, 3)) * 0.0625f; } }
                else {
                const u32x2* a0 = (const u32x2*)(y0 + (size_t)m * D) + lane; const u32x2* a1 = (const u32x2*)(y1 + (size_t)m * D) + lane;
#pragma unroll
                for (int j = 0; j < 8; ++j) { const u32x2 p = __builtin_nontemporal_load(a0 + 64 * j), q = __builtin_nontemporal_load(a1 + 64 * j);
                    v[r][j][0] += bf_lo(p.x) + bf_lo(q.x); v[r][j][1] += bf_hi(p.x) + bf_hi(q.x); v[r][j][2] += bf_lo(p.y) + bf_lo(q.y); v[r][j][3] += bf_hi(p.y) + bf_hi(q.y); } } } }
        }
        if (xb_out) {
#pragma unroll
            for (int r = 0; r < 2; ++r) { const int m = m0 + r * NGW; if (m < T) { u32x2* xo = (u32x2*)(xb_out + (size_t)m * D) + lane;
#pragma unroll
                for (int j = 0; j < 8; ++j) { u32x2 w; w.x = cvt_pk_bf16(v[r][j][0], v[r][j][1]); w.y = cvt_pk_bf16(v[r][j][2], v[r][j][3]); xo[64 * j] = w; } } }
        }
        if (xf_out) {
#pragma unroll
            for (int r = 0; r < 2; ++r) { const int m = m0 + r * NGW; if (m < T) { f32x4* xo = (f32x4*)(xf_out + (size_t)m * D) + lane;
#pragma unroll
                for (int j = 0; j < 8; ++j) xo[64 * j] = v[r][j]; } }
        }
        if (h || h8) {
#pragma unroll
            for (int r = 0; r < 2; ++r) { const int m = m0 + r * NGW; if (m < T) { float ss = 0.f;
#pragma unroll
                for (int j = 0; j < 8; ++j) ss += (v[r][j][0] * v[r][j][0] + v[r][j][1] * v[r][j][1]) + (v[r][j][2] * v[r][j][2] + v[r][j][3] * v[r][j][3]);
                const float rstd = 1.0f / sqrtf(wave_sum(ss) * (1.0f / D) + EPS);
                u32x2* ho = (u32x2*)(h + (size_t)m * D) + lane;
#pragma unroll
                for (int j = 0; j < 8; ++j) { const f32x4 g = gv[j]; const float h0 = v[r][j][0] * rstd * g[0], h1 = v[r][j][1] * rstd * g[1], h2 = v[r][j][2] * rstd * g[2], h3 = v[r][j][3] * rstd * g[3];
                    if (h) { u32x2 w; w.x = cvt_pk_bf16(h0, h1); w.y = cvt_pk_bf16(h2, h3); ho[64 * j] = w; }
                    if (h8) { int p = __builtin_amdgcn_cvt_pk_fp8_f32(h0, h1, 0, false); p = __builtin_amdgcn_cvt_pk_fp8_f32(h2, h3, p, true); h8[(size_t)m * (D / 4) + lane + 64 * j] = (unsigned)p; } } } }
        }
    }
}
__device__ __forceinline__ void mixer_a_unit(const Args& a, int l, int chunk, LAS unsigned char* lds) {
    const int tid = opaque_tid(), wid = tid >> 6, lane = tid & 63, r32 = lane & 31, hi = lane >> 5;
    const bf16_t* Z = (const bf16_t*)(a.ws + WS_Z); bf16_t* Y = (bf16_t*)(a.ws + WS_Y);
    const int t0 = chunk * 128;
    {
        const int c8 = lane * 8, g = lane >> 4, cg = (lane & 15) * 8; const float* gn = a.in[I_SG_NORM] + l * 512 + c8;
        const f32x4 g0 = *(const f32x4*)gn, g1 = *(const f32x4*)(gn + 4);
        u32x4 raw[16]; float ss[16];
#pragma unroll
        for (int rr = 0; rr < 16; ++rr) raw[rr] = *(const u32x4*)(Z + (size_t)(t0 + wid * 16 + rr) * WIN + 512 + c8);
#pragma unroll
        for (int rr = 0; rr < 16; ++rr) { float s = 0.f;
#pragma unroll
            for (int q = 0; q < 4; ++q) { const float x0 = bf_lo(raw[rr][q]), x1 = bf_hi(raw[rr][q]); s += x0 * x0 + x1 * x1; }
            ss[rr] = s; }
#pragma unroll
        for (int rr = 0; rr < 16; ++rr) ss[rr] = wave_sum(ss[rr]);
#pragma unroll
        for (int rr = 0; rr < 16; ++rr) { const int j = wid * 16 + rr; const float rstd = __builtin_amdgcn_rsqf(ss[rr] * (1.0f / 512.0f) + EPS); u32x4 w;
            w.x = cvt_pk_bf16(bf_lo(raw[rr].x) * rstd * g0[0], bf_hi(raw[rr].x) * rstd * g0[1]); w.y = cvt_pk_bf16(bf_lo(raw[rr].y) * rstd * g0[2], bf_hi(raw[rr].y) * rstd * g0[3]);
            w.z = cvt_pk_bf16(bf_lo(raw[rr].z) * rstd * g1[0], bf_hi(raw[rr].z) * rstd * g1[1]); w.w = cvt_pk_bf16(bf_lo(raw[rr].w) * rstd * g1[2], bf_hi(raw[rr].w) * rstd * g1[3]);
            *(LAS u32x4*)(lds + g * 32768 + (j >> 6) * 16384 + at::v_st(j & 63, cg)) = w; }
    }
    __syncthreads();
    f32x16 o2[2][4];
    const int g = wid >> 1;
    { const bf16x8* WS = (const bf16x8*)(a.ws + WS_W + (size_t)l * W_LAYER + W_SG) + (size_t)g * (4 * 2 * 4 * 64);
#pragma unroll
      for (int ibs = 0; ibs < 2; ++ibs) { const int ib = 2 * (wid & 1) + ibs;
#pragma unroll
        for (int d = 0; d < 4; ++d)
#pragma unroll
            for (int r = 0; r < 16; ++r) o2[ibs][d][r] = 0.f;
        for (int jt = 0; jt < 2; ++jt) {
            if (64 * jt > 32 * ib + 31) continue;
            bf16x8 pa[4];
#pragma unroll
            for (int ks = 0; ks < 4; ++ks) pa[ks] = WS[((ib * 2 + jt) * 4 + ks) * 64 + lane];
            const unsigned vb = (unsigned)(size_t)(lds + g * 32768 + jt * 16384) + at::v_rd_base(lane);
            at::pv_d0(o2[ibs], vb, pa[0], pa[1], pa[2], pa[3]);
        }
      } }
    __syncthreads();
    { const float* bs = a.in[I_SG_B] + (l * 4 + g) * 128;
#pragma unroll
      for (int ibs = 0; ibs < 2; ++ibs) { const int ib = 2 * (wid & 1) + ibs;
#pragma unroll
        for (int r = 0; r < 16; ++r) { const int ii = 32 * ib + at::crow(r, hi); const float b = bs[ii];
#pragma unroll
            for (int d = 0; d < 4; ++d) *(LAS bf16_t*)(lds + g * 32768 + ii * 256 + (32 * d + r32) * 2) = (bf16_t)(cvt_pk_bf16(o2[ibs][d][r] + b, 0.f) & 0xffffu); } } }
    __syncthreads();
#pragma unroll
    for (int kb = 0; kb < 16; kb += 8) {
        u32x4 uq[8];
#pragma unroll
        for (int k = 0; k < 8; ++k) { const int chunk = tid + 512 * (kb + k), i = chunk >> 6, c8 = (chunk & 63) * 8; uq[k] = *(const u32x4*)(Z + (size_t)(t0 + i) * WIN + c8); }
        asm volatile("" ::: "memory");
#pragma unroll
        for (int k = 0; k < 8; ++k) { const int chunk = tid + 512 * (kb + k), i = chunk >> 6, c8 = (chunk & 63) * 8;
            const u32x4 mx = *(const LAS u32x4*)(lds + (c8 >> 7) * 32768 + i * 256 + (c8 & 127) * 2); const u32x4 uu = uq[k]; u32x4 y;
#pragma unroll
            for (int q = 0; q < 4; ++q) y[q] = cvt_pk_bf16(bf_lo(uu[q]) * bf_lo(mx[q]), bf_hi(uu[q]) * bf_hi(mx[q]));
            *(u32x4*)(Y + (size_t)(t0 + i) * D + c8) = y; } }
    __syncthreads();
}
__device__ __forceinline__ void mixer_b(const Args& a, int l) {
    const int tid = opaque_tid(), wave = tid >> 6, lane = tid & 63, gw = blockIdx.x * NWAVES + wave, NGW = gridDim.x * NWAVES;
    const bf16_t* Z = (const bf16_t*)(a.ws + WS_Z); bf16_t* Y = (bf16_t*)(a.ws + WS_Y); const float* cw = a.in[I_CONV_W] + l * 3 * 512; const int c = lane * 8;
    float kw[3][8];
#pragma unroll
    for (int w = 0; w < 3; ++w) { const f32x4 k0 = *(const f32x4*)(cw + w * 512 + c), k1 = *(const f32x4*)(cw + w * 512 + c + 4);
        kw[w][0] = k0[0]; kw[w][1] = k0[1]; kw[w][2] = k0[2]; kw[w][3] = k0[3]; kw[w][4] = k1[0]; kw[w][5] = k1[1]; kw[w][6] = k1[2]; kw[w][7] = k1[3]; }
    for (int blk = gw; blk < T / 8; blk += NGW) { const int t0 = blk * 8; const bool first = (t0 & (SEQ - 1)) == 0;
        const bf16_t* zr = Z + (size_t)t0 * WIN + ZB + c;
        u32x4 cg[10], hb[10], bg[8];
#pragma unroll
        for (int i = 0; i < 10; ++i) { if (i < 2 && first) { cg[i] = (u32x4){0u, 0u, 0u, 0u}; hb[i] = cg[i]; } else { const bf16_t* zz = zr + (ptrdiff_t)(i - 2) * WIN; cg[i] = *(const u32x4*)(zz + 512); hb[i] = *(const u32x4*)(zz + 1024); } }
#pragma unroll
        for (int i = 0; i < 8; ++i) bg[i] = *(const u32x4*)(zr + (size_t)i * WIN);
        float p2[8], p1[8];
#pragma unroll
        for (int q = 0; q < 4; ++q) { p2[2 * q] = bf_lo(cg[0][q]) * bf_lo(hb[0][q]); p2[2 * q + 1] = bf_hi(cg[0][q]) * bf_hi(hb[0][q]); p1[2 * q] = bf_lo(cg[1][q]) * bf_lo(hb[1][q]); p1[2 * q + 1] = bf_hi(cg[1][q]) * bf_hi(hb[1][q]); }
#pragma unroll
        for (int i = 0; i < 8; ++i) { float p0[8]; u32x4 o;
#pragma unroll
            for (int q = 0; q < 4; ++q) { p0[2 * q] = bf_lo(cg[i + 2][q]) * bf_lo(hb[i + 2][q]); p0[2 * q + 1] = bf_hi(cg[i + 2][q]) * bf_hi(hb[i + 2][q]); }
#pragma unroll
            for (int q = 0; q < 4; ++q) { const float y0 = kw[0][2 * q] * p2[2 * q] + kw[1][2 * q] * p1[2 * q] + kw[2][2 * q] * p0[2 * q], y1 = kw[0][2 * q + 1] * p2[2 * q + 1] + kw[1][2 * q + 1] * p1[2 * q + 1] + kw[2][2 * q + 1] * p0[2 * q + 1];
                o[q] = cvt_pk_bf16(bf_lo(bg[i][q]) * y0, bf_hi(bg[i][q]) * y1); }
            *(u32x4*)(Y + (size_t)(t0 + i) * D + 512 + c) = o;
#pragma unroll
            for (int q = 0; q < 8; ++q) { p2[q] = p1[q]; p1[q] = p0[q]; } }
    }
}
__device__ __forceinline__ void mixer_c_unit(const Args& a, int unit, LAS unsigned char* lds) {
    const int tid = opaque_tid(), wid = tid >> 6, lane = tid & 63, r32 = lane & 31, hi = lane >> 5;
    const int sub = unit & 15, h = (unit >> 4) & 3, g = (unit >> 6) % 3, b = unit / 192;
    const int dil = (g == 0) ? 1 : (g == 1 ? 4 : 16); const int r = (g == 0) ? 0 : (g == 1 ? (sub & 3) : sub); const int n2 = (g == 0) ? sub : (g == 1 ? (sub >> 2) : 0);
    const bf16_t* Z = (const bf16_t*)(a.ws + WS_Z);
    at::AttnP P; P.zq = Z + ZC + ((0 * 3 + g) * 4 + h) * 128; P.zk = Z + ZC + ((1 * 3 + g) * 4 + h) * 128; P.zv = Z + ZC + ((2 * 3 + g) * 4 + h) * 128;
    P.tokbase = b * SEQ + r; P.stride = dil; P.q0 = 256 * n2; P.kstart = 256 * n2 - 128; P.NT = 6; P.W = 128;
    f32x16 o[4]; float l_reg, m_reg;
    at::attn_run<128>(P, lds, o, l_reg, m_reg);
    at::attn_normalise(lds, o, l_reg);
    bf16_t* CO = (bf16_t*)(a.ws + WS_CO) + (size_t)g * T * 512; float* LSE = (float*)(a.ws + WS_LSE) + (size_t)g * T * 4;
    const int qw0 = P.q0 + wid * 32;
    if (hi == 0) { const int tok = P.tokbase + (qw0 + r32) * dil; LSE[(size_t)tok * 4 + h] = m_reg * 0.08838834764831845f + __logf(l_reg); }
#pragma unroll
    for (int rr = 0; rr < 16; ++rr) { const size_t tok = (size_t)(P.tokbase + (qw0 + at::crow(rr, hi)) * dil);
#pragma unroll
        for (int d = 0; d < 4; ++d) CO[tok * 512 + h * 128 + 32 * d + r32] = (bf16_t)(cvt_pk_bf16(o[d][rr], 0.f) & 0xffffu); }
    __syncthreads();
}
__device__ __forceinline__ void mixer_c_merge(const Args& a) {
    const bf16_t* CO = (const bf16_t*)(a.ws + WS_CO); const float* LSE = (const float*)(a.ws + WS_LSE); bf16_t* Y = (bf16_t*)(a.ws + WS_Y);
    for (int it = blockIdx.x * NTHR + opaque_tid(); it < T * 64; it += gridDim.x * NTHR) { const int t = it >> 6, c = (it & 63) * 8, h = c >> 7;
        const float l0 = LSE[(size_t)t * 4 + h], l1 = LSE[(size_t)(T + t) * 4 + h], l2 = LSE[(size_t)(2 * T + t) * 4 + h]; const float mx = fmaxf(l0, fmaxf(l1, l2));
        float e0 = __expf(l0 - mx), e1 = __expf(l1 - mx), e2 = __expf(l2 - mx); const float inv = 1.0f / (e0 + e1 + e2); e0 *= inv; e1 *= inv; e2 *= inv;
        const u32x4 a0 = *(const u32x4*)(CO + (size_t)t * 512 + c), a1 = *(const u32x4*)(CO + ((size_t)T + t) * 512 + c), a2 = *(const u32x4*)(CO + ((size_t)2 * T + t) * 512 + c); u32x4 o;
#pragma unroll
        for (int q = 0; q < 4; ++q) o[q] = cvt_pk_bf16(e0 * bf_lo(a0[q]) + e1 * bf_lo(a1[q]) + e2 * bf_lo(a2[q]), e0 * bf_hi(a0[q]) + e1 * bf_hi(a1[q]) + e2 * bf_hi(a2[q]));
        *(u32x4*)(Y + (size_t)t * D + 1024 + c) = o; }
}
__device__ __forceinline__ float diff_lambda(const Args& a, int l, float lam_init) {
    const int lane = opaque_tid() & 63;
    const float s1 = wave_sum(a.in[I_LQ1][l * 64 + lane] * a.in[I_LK1][l * 64 + lane]), s2 = wave_sum(a.in[I_LQ2][l * 64 + lane] * a.in[I_LK2][l * 64 + lane]);
    return expf(s1) - expf(s2) + lam_init;
}
__device__ __forceinline__ void mixer_d_unit(const Args& a, int l, int unit, LAS unsigned char* lds) {
    const int tid = opaque_tid(), wid = tid >> 6, lane = tid & 63, r32 = lane & 31, hi = lane >> 5;
    const int pr = unit & 7, h = (unit >> 3) & 3, b = unit >> 5;
    const float lam_init = (l == 0) ? 0.2f : 0.35550906759096926f;
    const bf16_t* Z = (const bf16_t*)(a.ws + WS_Z); bf16_t* Y = (bf16_t*)(a.ws + WS_Y);
#pragma unroll 1
    for (int it = 0; it < 4; ++it) { const int qb = (it >> 1) ? 15 - pr : pr, map = it & 1;
        at::AttnP P; P.zq = Z + ZD + (h * 2 + map) * 64; P.zk = Z + ZD + 512 + (h * 2 + map) * 64; P.zv = Z + ZD + 1024 + h * 128;
        P.tokbase = b * SEQ; P.stride = 1; P.q0 = 256 * qb; P.kstart = 0; P.NT = 4 * (qb + 1); P.W = 1 << 29;
        f32x16 o[4]; float l_reg, m_reg;
        at::attn_run<64>(P, lds, o, l_reg, m_reg);
        at::attn_normalise(lds, o, l_reg);
        const int qw0 = P.q0 + wid * 32;
        if (map == 0) {
#pragma unroll
            for (int rr = 0; rr < 16; ++rr) { const size_t tok = (size_t)(P.tokbase + qw0 + at::crow(rr, hi));
#pragma unroll
                for (int d = 0; d < 4; ++d) Y[tok * D + 1536 + h * 128 + 32 * d + r32] = (bf16_t)(cvt_pk_bf16(o[d][rr], 0.f) & 0xffffu); }
            VM_WAIT();
        } else {
            const float lam = diff_lambda(a, l, lam_init); const float* sub = a.in[I_SUBLN] + l * 128;
            float sg[4];
#pragma unroll
            for (int d = 0; d < 4; ++d) sg[d] = sub[32 * d + r32] * (1.0f - lam_init);
            bf16_t o1v[16][4];
#pragma unroll
            for (int rr = 0; rr < 16; ++rr) { const size_t tok = (size_t)(P.tokbase + qw0 + at::crow(rr, hi));
#pragma unroll
                for (int d = 0; d < 4; ++d) o1v[rr][d] = Y[tok * D + 1536 + h * 128 + 32 * d + r32]; }
            asm volatile("" ::: "memory");
#pragma unroll
            for (int rr = 0; rr < 16; ++rr) { const size_t tok = (size_t)(P.tokbase + qw0 + at::crow(rr, hi)); float ss = 0.f; float v[4];
#pragma unroll
                for (int d = 0; d < 4; ++d) { const float o1 = bf2f(o1v[rr][d]); v[d] = o1 - lam * o[d][rr]; ss += v[d] * v[d]; }
                ss += __shfl_xor(ss, 1); ss += __shfl_xor(ss, 2); ss += __shfl_xor(ss, 4); ss += __shfl_xor(ss, 8); ss += __shfl_xor(ss, 16);
                const float rstd = __builtin_amdgcn_rsqf(ss * (1.0f / 128.0f) + EPS);
#pragma unroll
                for (int d = 0; d < 4; ++d) Y[tok * D + 1536 + h * 128 + 32 * d + r32] = (bf16_t)(cvt_pk_bf16(v[d] * rstd * sg[d], 0.f) & 0xffffu); }
        }
    }
}
__device__ __forceinline__ void phase_route(const Args& a, int l, LAS unsigned char* lds) {
    const int tid = opaque_tid(), wave = tid >> 6, lane = tid & 63, gw = blockIdx.x * NWAVES + wave, NGW = gridDim.x * NWAVES;
    const bf16_t* X = (const bf16_t*)(a.ws + WS_XB); bf16_t* H = (bf16_t*)(a.ws + WS_H); const bf16_t* WR = (const bf16_t*)(a.ws + WS_W + (size_t)l * W_LAYER + W_R);
    const float* gain = a.in[I_NORM_FFN] + l * D; const float* brg = a.in[I_B_RG] + l * 4; const float* bre = a.in[I_B_RE] + l * 32;
    unsigned* cnt = (unsigned*)(a.ws + WS_CTL) + CW_CNT + l * 32; u32x4* list = (u32x4*)(a.ws + WS_LIST); u32x4* route = (u32x4*)(a.ws + WS_ROUTE);
    LAS float* lg = (LAS float*)(lds + wave * 6144);
    LAS float* gl_lds = (LAS float*)(lds + 65536);
    ((LAS f32x4*)gl_lds)[tid] = ((const f32x4*)gain)[tid];
    __syncthreads();
    const int rw = lane & 15, kg = lane >> 4;
    for (int grp = wave * (int)gridDim.x + (int)blockIdx.x; grp < T / 32; grp += NGW) { const int rowA = grp * 32 + rw;
        const bf16_t* xr2 = X + (size_t)rowA * D + 16 * kg; bf16_t* hr2 = H + (size_t)rowA * D + 16 * kg; unsigned char* h8r2 = a.ws + WS_H8 + (size_t)rowA * D + 16 * kg;
        f32x4 acc[2][3];
#pragma unroll
        for (int s = 0; s < 2; ++s)
#pragma unroll
            for (int nb = 0; nb < 3; ++nb) acc[s][nb] = (f32x4){0.f, 0.f, 0.f, 0.f};
        float ss[2] = {0.f, 0.f};
#pragma unroll 2
        for (int k0 = 0; k0 < D; k0 += 64) { const LAS float* gp = gl_lds + k0 + 16 * kg;
            u32x4 xq[2][2];
#pragma unroll
            for (int s = 0; s < 2; ++s) { xq[s][0] = *(const u32x4*)(xr2 + (size_t)s * 16 * D + k0); xq[s][1] = *(const u32x4*)(xr2 + (size_t)s * 16 * D + k0 + 8); }
            u32x4 pk[2][2]; unsigned f8[2][4];
#pragma unroll
            for (int hf = 0; hf < 2; ++hf) { const f32x4 g0 = *(const LAS f32x4*)(gp + 8 * hf), g1 = *(const LAS f32x4*)(gp + 8 * hf + 4);
#pragma unroll
                for (int s = 0; s < 2; ++s) { const u32x4 xr4 = xq[s][hf]; const f32x4 x0 = (f32x4){bf_lo(xr4.x), bf_hi(xr4.x), bf_lo(xr4.y), bf_hi(xr4.y)}, x1 = (f32x4){bf_lo(xr4.z), bf_hi(xr4.z), bf_lo(xr4.w), bf_hi(xr4.w)};
                    ss[s] += (x0[0] * x0[0] + x0[1] * x0[1]) + (x0[2] * x0[2] + x0[3] * x0[3]) + (x1[0] * x1[0] + x1[1] * x1[1]) + (x1[2] * x1[2] + x1[3] * x1[3]);
                    pk[s][hf].x = cvt_pk_bf16(x0[0] * g0[0], x0[1] * g0[1]); pk[s][hf].y = cvt_pk_bf16(x0[2] * g0[2], x0[3] * g0[3]); pk[s][hf].z = cvt_pk_bf16(x1[0] * g1[0], x1[1] * g1[1]); pk[s][hf].w = cvt_pk_bf16(x1[2] * g1[2], x1[3] * g1[3]);
                    if (MK_MOE8 && l >= 0) { int p0 = __builtin_amdgcn_cvt_pk_fp8_f32(x0[0] * g0[0], x0[1] * g0[1], 0, false); p0 = __builtin_amdgcn_cvt_pk_fp8_f32(x0[2] * g0[2], x0[3] * g0[3], p0, true);
                        int p1 = __builtin_amdgcn_cvt_pk_fp8_f32(x1[0] * g1[0], x1[1] * g1[1], 0, false); p1 = __builtin_amdgcn_cvt_pk_fp8_f32(x1[2] * g1[2], x1[3] * g1[3], p1, true);
                        f8[s][2 * hf] = (unsigned)p0; f8[s][2 * hf + 1] = (unsigned)p1; } } }
            if (MK_MOE8 && l >= 0) {
#pragma unroll
                for (int s = 0; s < 2; ++s) *(u32x4*)(h8r2 + (size_t)s * 16 * D + k0) = (u32x4){f8[s][0], f8[s][1], f8[s][2], f8[s][3]}; }
            else {
#pragma unroll
                for (int s = 0; s < 2; ++s) { *(u32x4*)(hr2 + (size_t)s * 16 * D + k0) = pk[s][0]; *(u32x4*)(hr2 + (size_t)s * 16 * D + k0 + 8) = pk[s][1]; } }
#pragma unroll
            for (int nb = 0; nb < 3; ++nb) { const bf16_t* wp = WR + (size_t)(16 * nb + rw) * D + k0 + 16 * kg; const bf16x8 b0 = *(const bf16x8*)wp, b1 = *(const bf16x8*)(wp + 8);
#pragma unroll
                for (int s = 0; s < 2; ++s) { acc[s][nb] = __builtin_amdgcn_mfma_f32_16x16x32_bf16(__builtin_bit_cast(bf16x8, pk[s][0]), b0, acc[s][nb], 0, 0, 0);
                    acc[s][nb] = __builtin_amdgcn_mfma_f32_16x16x32_bf16(__builtin_bit_cast(bf16x8, pk[s][1]), b1, acc[s][nb], 0, 0, 0); } } }
        float rstd2[2];
#pragma unroll
        for (int s = 0; s < 2; ++s) { float t = ss[s]; t += __shfl_xor(t, 16); t += __shfl_xor(t, 32); rstd2[s] = 1.0f / sqrtf(t * (1.0f / D) + EPS); }
#pragma unroll
        for (int s = 0; s < 2; ++s)
#pragma unroll
            for (int nb = 0; nb < 3; ++nb)
#pragma unroll
                for (int rg = 0; rg < 4; ++rg) lg[(16 * s + 4 * kg + rg) * 48 + 16 * nb + rw] = acc[s][nb][rg];
        LDS_WAIT();
        if (lane < 32) { const LAS float* lr = lg + lane * 48; const int row = grp * 32 + lane; const float rstd = (lane >> 4) ? rstd2[1] : rstd2[0];
            float gl[4]; int gi = 0; float gmx = -1e30f;
#pragma unroll
            for (int i = 0; i < 4; ++i) { gl[i] = lr[i] * rstd + brg[i]; if (gl[i] > gmx) { gmx = gl[i]; gi = i; } }
            float gs = 0.f;
#pragma unroll
            for (int i = 0; i < 4; ++i) gs += __expf(gl[i] - gmx);
            const float gp = 1.0f / gs;
            float v1 = -1e30f, v2 = -1e30f; int i1 = 0, i2 = 0;
            for (int i = 0; i < 8; ++i) { const float v = lr[4 + 8 * gi + i] * rstd + bre[8 * gi + i];
                if (v > v1) { v2 = v1; i2 = i1; v1 = v; i1 = i; } else if (v > v2) { v2 = v; i2 = i; } }
            const float ex = __expf(v2 - v1); const float w1 = gp / (1.0f + ex), w2 = gp * ex / (1.0f + ex);
            const int e1 = gi * 8 + i1, e2 = gi * 8 + i2;
            if (!(a.mix_mask & 16)) {
            const unsigned p1 = atomicAdd(cnt + e1, 1u), p2 = atomicAdd(cnt + e2, 1u);
            list[(size_t)e1 * T + p1] = (u32x4){(unsigned)row, __float_as_uint(w1), __float_as_uint(rstd), 0u};
            list[(size_t)e2 * T + p2] = (u32x4){(unsigned)row | 0x10000u, __float_as_uint(w2), __float_as_uint(rstd), 0u}; }
            route[row] = (u32x4){(unsigned)e1, (unsigned)e2, __float_as_uint(w1), __float_as_uint(w2)};
        }
        LDS_WAIT();
    }
}
__device__ __forceinline__ void moe_tables(const Args& a, int l, LAS unsigned char* lds, const int nN) {
    LAS int* tab = (LAS int*)(lds + gm::TAB_OFF); const unsigned* cnt = (const unsigned*)(a.ws + WS_CTL) + CW_CNT + l * 32;
    if (threadIdx.x < 32) { const int lane = threadIdx.x; const int c = (int)__hip_atomic_load(cnt + lane, __ATOMIC_RELAXED, __HIP_MEMORY_SCOPE_AGENT); const int tiles = (c + 255) >> 8; int incl = tiles;
#pragma unroll
        for (int d = 1; d < 32; d <<= 1) { const int t = __shfl_up(incl, d); if (lane >= d) incl += t; }
        tab[lane] = incl - tiles; tab[40 + lane] = c; if (lane == 31) tab[32] = incl; }
    __syncthreads();
    if (threadIdx.x < 16) { const int rt = ((int)threadIdx.x * (int)gridDim.x + (int)blockIdx.x) / nN; int e = 0; for (int k = 1; k < 32; ++k) e += (tab[k] <= rt) ? 1 : 0; tab[80 + threadIdx.x] = e; }
    __syncthreads();
}
__device__ __forceinline__ void phase_final(const Args& a) { phase_norm(nullptr, (const bf16_t*)(a.ws + WS_XB), (const bf16_t*)(a.ws + WS_Y0), (const bf16_t*)(a.ws + WS_Y1), nullptr, a.out, nullptr, nullptr, nullptr, MK_Y8 && !MK_DEBUG); }

constexpr int PH_PER_LAYER = 10, N_PHASES = 2 + 2 * PH_PER_LAYER;
template <int l> __device__ __forceinline__ void layer_phases(const Args& a, LAS unsigned char* lds, const int lo, const int hi, const XcdBarrier& bar) {
#define IN(k) (lo <= (k) && (k) < hi)
#define SEAM(k) do { if (IN(k) && IN((k) + 1)) xcd_barrier(bar); } while (0)
    {
        const int pb = 1 + l * PH_PER_LAYER;
        unsigned char* wb = a.ws + WS_W + (size_t)l * W_LAYER;
        bf16_t* H = (bf16_t*)(a.ws + WS_H); bf16_t* Z = (bf16_t*)(a.ws + WS_Z); bf16_t* Y = (bf16_t*)(a.ws + WS_Y);
        if (IN(pb + 0)) {
            if (l == 0) phase_norm(a.in[I_X], nullptr, nullptr, nullptr, nullptr, nullptr, a.in[I_NORM_MIX], H, (unsigned*)(a.ws + WS_H8));
            else phase_norm(nullptr, (const bf16_t*)(a.ws + WS_XB), (const bf16_t*)(a.ws + WS_Y0), (const bf16_t*)(a.ws + WS_Y1), (bf16_t*)(a.ws + WS_XB), nullptr, a.in[I_NORM_MIX] + D, ((MK_Z8 >> 1) & 1) && !MK_DEBUG ? nullptr : H, (unsigned*)(a.ws + WS_H8));
        }
        SEAM(pb + 0);
        if (IN(pb + 1)) {
            gm::Desc g{H, wb + W_IN, 2 * D, 2 * D, 2 * D}; if ((MK_Z8 >> l) & 1) g = gm::Desc{a.ws + WS_H8, wb + W_IN, D, D, D, 121, 127}; gm::StaticOrder S; S.init(T, WIN, gridDim.x, blockIdx.x);
            gm::EpiZ E{Z, a.in[I_QN_C] + l * 128, a.in[I_KN_C] + l * 128, a.in[I_QN_D] + l * 64, a.in[I_KN_D] + l * 64,
                       (const float*)(a.ws + WS_COSC), (const float*)(a.ws + WS_SINC), (const float*)(a.ws + WS_COSD), (const float*)(a.ws + WS_SIND)};
            if constexpr (l == 0) {
                const int split = (int)((blockIdx.x * 17u) >> 8);
#pragma unroll 1
                for (int seg = 0; seg < 2; ++seg) {
                    S.i0 = seg ? split : 0; S.iend = seg ? (1 << 30) : split;
                    if constexpr ((MK_Z8 >> l) & 1) gm::gemm_phase<true>(lds, g, S, E); else gm::gemm_phase(lds, g, S, E);
                    if (seg == 0) { __syncthreads(); phase_prologue(a, lds, 1); __syncthreads(); }
                }
            } else {
                if constexpr ((MK_Z8 >> l) & 1) gm::gemm_phase<true>(lds, g, S, E); else gm::gemm_phase(lds, g, S, E);
            }
        }
        SEAM(pb + 1);
        if (IN(pb + 2)) {
            const int vbx = (gridDim.x == 256) ? (int)((blockIdx.x & 7) * 32 + (blockIdx.x >> 3)) : (int)blockIdx.x;
            if (a.mix_mask & 1) for (int u = vbx; u < 256; u += gridDim.x) mixer_d_unit(a, l, u, lds);
            if (a.mix_mask & 2) for (int u = vbx; u < 1536; u += gridDim.x) mixer_c_unit(a, u, lds);
            if (a.mix_mask & 4) for (int u = blockIdx.x; u < T / 128; u += gridDim.x) mixer_a_unit(a, l, u, lds);
            if (a.mix_mask & 8) mixer_b(a, l);
        }
        SEAM(pb + 2);
        if (IN(pb + 3)) mixer_c_merge(a);
        SEAM(pb + 3);
        if (IN(pb + 4)) {
            gm::Desc g{Y, wb + W_B, 2 * D, 1024, 1024}; gm::BranchOrder S; S.init(T, 8192, gridDim.x, blockIdx.x);
#if MK_PTILE
            gm::EpiPTile E{(unsigned char*)Z};
#else
            gm::EpiBf16 E{Z, 8192};
#endif
            gm::gemm_phase(lds, g, S, E);
        }
        SEAM(pb + 4);
        if (IN(pb + 5)) {
            gm::Desc g{a.ws + WS_H8, wb + W_G, D, D, D};     gm::StaticOrder S; S.init(T, 8192, gridDim.x, blockIdx.x);
            gm::EpiGateT<((MK_WO8 >> l) & 1) && !MK_DEBUG> E{Y, Z, a.in[I_B_GATE] + (size_t)l * 4 * D};
            gm::gemm_phase<true>(lds, g, S, E);
        }
        SEAM(pb + 5);
        if (IN(pb + 6)) {
            gm::Desc g{Y, wb + W_O, 2 * D, 2 * D, 2 * D}; if (((MK_WO8 >> l) & 1) && !MK_DEBUG) g = gm::Desc{Y, wb + W_O, D, D, D, 121, 127};
#if MK_PTILE
            g.ka = 32768; gm::TileAOrder S;
#else
            gm::StaticOrder S;
#endif
            S.init(T, D, gridDim.x, blockIdx.x);
            gm::EpiResid E{l == 0 ? a.in[I_X] : nullptr, (bf16_t*)(a.ws + WS_XB)};
            if constexpr (((MK_WO8 >> l) & 1) && !MK_DEBUG) gm::gemm_phase<true>(lds, g, S, E); else gm::gemm_phase(lds, g, S, E);
        }
        SEAM(pb + 6);
        if (IN(pb + 7)) phase_route(a, l, lds);
        SEAM(pb + 7);
        if (IN(pb + 8)) {
            moe_tables(a, l, lds, 4);
            gm::Desc g{H, wb + W_UP, 2 * D, 2 * D, 2 * D}; if (MK_MOE8 && l >= 0) g = gm::Desc{a.ws + WS_H8, wb + W_UP, D, D, D, 121, 127}; gm::MoeUpOrder S; S.nN = 4; S.G = gridDim.x; S.c = blockIdx.x; S.tab = (LAS const int*)(lds + gm::TAB_OFF); S.list = (const u32x4*)(a.ws + WS_LIST); S.nexp_rows = 1024;
            if constexpr (MK_MOE8 && l >= 0) { gm::EpiUpT<true> E{a.ws + WS_HID, (const u32x4*)(a.ws + WS_LIST)}; gm::gemm_phase<true>(lds, g, S, E); }
            else { gm::EpiUpT<false> E{a.ws + WS_HID, (const u32x4*)(a.ws + WS_LIST)}; gm::gemm_phase(lds, g, S, E); }
        }
        SEAM(pb + 8);
        if (IN(pb + 9)) {
            moe_tables(a, l, lds, 8);
            gm::Desc g{a.ws + WS_HID, wb + W_DN, 1024, 1024, 1024}; if (MK_MOE8 && l >= 0) { g = gm::Desc{a.ws + WS_HID, wb + W_DN, 512, 512, 512, 121, 123}; g.ka = 32768; } gm::MoeDownOrder S; S.nN = 8; S.G = gridDim.x; S.c = blockIdx.x; S.tab = (LAS const int*)(lds + gm::TAB_OFF); S.list = (const u32x4*)(a.ws + WS_LIST); S.nexp_rows = 2048;
            gm::EpiDownT<(MK_Y8 && l == 1 && !MK_DEBUG)> E{a.ws + WS_Y0, a.ws + WS_Y1, (const u32x4*)(a.ws + WS_LIST)};
            if constexpr (MK_MOE8 && l >= 0) gm::gemm_phase<true>(lds, g, S, E); else gm::gemm_phase(lds, g, S, E);
        }
        SEAM(pb + 9);
    }
#undef SEAM
#undef IN
}
constexpr int MISC_OFF = 143360;
__global__ void __launch_bounds__(NTHR, 2) mk_fwd(Args a) {
    extern __shared__ __attribute__((aligned(16))) unsigned char lds_raw[];
    LAS unsigned char* lds = (LAS unsigned char*)lds_raw;
    const int lo = a.ph_lo, hi = a.ph_hi;
    volatile LAS unsigned* misc = (volatile LAS unsigned*)(lds + MISC_OFF);
    if (threadIdx.x < 4) misc[threadIdx.x] = 0u;
    __syncthreads();
    XcdBarrier bar; bar.bar = (unsigned*)(a.ws + WS_CTL) + CW_BAR; bar.x = 0; bar.st = misc;
    if (hi - lo > 1) bar = xcd_barrier_post((unsigned*)(a.ws + WS_CTL) + CW_BAR, misc);
    if (lo <= 0 && 0 < hi) phase_prologue(a, lds, 0);
    layer_phases<0>(a, lds, lo, hi, bar);
    layer_phases<1>(a, lds, lo, hi, bar);
    if (lo <= N_PHASES - 1 && N_PHASES - 1 < hi) phase_final(a);
#if MK_XPROBE
    if (lo <= 50 && 50 < hi) {
        unsigned char* wb = a.ws + WS_W;
        gm::Desc g{a.ws + WS_H, wb + MK_XPROBE_W, 2 * D, 2 * MK_XPROBE_K, 2 * MK_XPROBE_K}; gm::StaticOrder S; S.init(T, MK_XPROBE_N, gridDim.x, blockIdx.x);
        gm::EpiProbe E{(float*)(a.ws + WS_CO)};
        gm::gemm_phase(lds, g, S, E);
    }
#endif
}

#if MK_DEBUG
__device__ __forceinline__ void diag_put(unsigned char* ws, int stage, float err, float ref, float rel, float absf) {
    float ratio = fabsf(err) / (rel * fabsf(ref) + absf); if (!(ratio == ratio) || !(fabsf(err) < 1e30f)) ratio = 1e9f;
    atomicMax((unsigned*)(ws + WS_CTL) + CW_DIAG + stage, __float_as_uint(ratio));
}
__device__ __forceinline__ unsigned hash_u(unsigned x) { x ^= x >> 16; x *= 0x7feb352du; x ^= x >> 15; x *= 0x846ca68bu; x ^= x >> 16; return x; }
__global__ void ck_h(Args a, int l, int stage) {
    const int row = hash_u(blockIdx.x * 7 + 1) % T; const float* g = a.in[I_NORM_MIX] + l * D; const bf16_t* h = (const bf16_t*)(a.ws + WS_H) + (size_t)row * D;
#define CKX(c) (l == 0 ? a.in[I_X][(size_t)row * D + (c)] : bf2f(((const bf16_t*)(a.ws + WS_XB))[(size_t)row * D + (c)]))
    float ss = 0.f; for (int c = threadIdx.x; c < D; c += 64) ss += CKX(c) * CKX(c); ss = wave_sum(ss); const float rstd = 1.0f / sqrtf(ss / D + EPS);
    for (int c = threadIdx.x; c < D; c += 64) { const float ref = CKX(c) * rstd * g[c]; diag_put(a.ws, stage, bf2f(h[c]) - ref, ref, 0.01f, 0.01f); }
#undef CKX
}
__device__ float dot_hw(const bf16_t* hrow, const float* W, size_t ld, int K) { float s = 0.f; for (int k = 0; k < K; ++k) s += bf2f(hrow[k]) * W[(size_t)k * ld]; return s; }
__global__ void ck_z_ident(Args a, int l, int stage) {
    const unsigned hsh = hash_u(blockIdx.x * 64 + threadIdx.x + 77); const int row = hsh % T; int col; { const unsigned q = hash_u(hsh + 5) % 4096; col = q < 2560 ? q : (q < 3328 ? ZC + 3072 + (q - 2560) * 2 : ZD + 1024 + (q - 3328) % 512); }
    const bf16_t* h = (const bf16_t*)(a.ws + WS_H) + (size_t)row * D; float ref = dot_hw(h, a.in[I_W_IN] + (size_t)l * D * WIN + col, WIN, D);
    if (col < 1024) { const float u = 0.7978845608028654f * (ref + 0.044715f * ref * ref * ref); ref = 0.5f * ref * (1.0f + tanhf(u)); }
    diag_put(a.ws, stage, bf2f(((const bf16_t*)(a.ws + WS_Z))[(size_t)row * WIN + col]) - ref, ref, 0.02f, 0.02f);
}
__global__ void ck_z_qk(Args a, int l, int stage, int isD) {
    __shared__ float v[128]; __shared__ float ssum;
    const unsigned hsh = hash_u(blockIdx.x + 1234 + isD * 999); const int row = hsh % T; const int nd = isD ? 64 : 128; const int grp = hash_u(hsh + 3) % (isD ? 16 : 24);
    const int d = threadIdx.x; const int colbase = isD ? ZD + grp * 64 : ZC + grp * 128;
    const bf16_t* h = (const bf16_t*)(a.ws + WS_H) + (size_t)row * D;
    if (d < nd) v[d] = dot_hw(h, a.in[I_W_IN] + (size_t)l * D * WIN + colbase + d, WIN, D);
    __syncthreads();
    if (d == 0) { float s = 0.f; for (int i = 0; i < nd; ++i) s += v[i] * v[i]; ssum = s; }
    __syncthreads();
    if (d < nd) { const float rstd = 1.0f / sqrtf(ssum / nd + EPS); const float* gn = isD ? ((grp >= 8 ? a.in[I_KN_D] : a.in[I_QN_D]) + l * 64) : ((grp >= 12 ? a.in[I_KN_C] : a.in[I_QN_C]) + l * 128);
        const int half = nd / 2, i = d % half; const float inv = powf(10000.0f, -(float)i / (float)half); const float ang = (float)(row % SEQ) * inv; const float cs = cosf(ang), sn = sinf(ang);
        const float x1 = v[i] * rstd * gn[i], x2 = v[i + half] * rstd * gn[i + half]; const float ref = (d < half) ? (x1 * cs - x2 * sn) : (x2 * cs + x1 * sn);
        diag_put(a.ws, stage, bf2f(((const bf16_t*)(a.ws + WS_Z))[(size_t)row * WIN + colbase + d]) - ref, ref, 0.02f, 0.03f); }
}
__global__ void ck_ya(Args a, int l, int stage) {
    __shared__ float rstd[128];
    const unsigned hsh = hash_u(blockIdx.x + 4321); const int chunk = hsh % (T / 128), i = (blockIdx.x < 4) ? (blockIdx.x * 42 + 1) % 128 : hash_u(hsh + 1) % 128, g = hash_u(hsh + 2) % 4; const int c = threadIdx.x; const int t0 = chunk * 128;
    const bf16_t* Z = (const bf16_t*)(a.ws + WS_Z);
    { float s = 0.f; const bf16_t* vr = Z + (size_t)(t0 + c) * WIN + 512; for (int k = 0; k < 512; ++k) s += bf2f(vr[k]) * bf2f(vr[k]); rstd[c] = 1.0f / sqrtf(s / 512.f + EPS); }
    __syncthreads();
    const float gn = a.in[I_SG_NORM][l * 512 + g * 128 + c]; const float* W = a.in[I_SG_W] + ((size_t)(l * 4 + g) * 128 + i) * 128; float mix = 0.f;
    for (int j = 0; j <= i; ++j) mix += W[j] * bf2f(Z[(size_t)(t0 + j) * WIN + 512 + g * 128 + c]) * rstd[j] * gn;
    mix += a.in[I_SG_B][(l * 4 + g) * 128 + i];
    const float ref = bf2f(Z[(size_t)(t0 + i) * WIN + g * 128 + c]) * mix;
    diag_put(a.ws, stage, bf2f(((const bf16_t*)(a.ws + WS_Y))[(size_t)(t0 + i) * D + g * 128 + c]) - ref, ref, 0.03f, 0.03f);
}
__global__ void ck_yb(Args a, int l, int stage) {
    const unsigned hsh = hash_u(blockIdx.x * 64 + threadIdx.x + 99); int t = hsh % T; if (threadIdx.x < 4) t = (t & ~(SEQ - 1)) + threadIdx.x; const int c = hash_u(hsh + 1) % 512, s = t % SEQ; const bf16_t* Z = (const bf16_t*)(a.ws + WS_Z);
    float acc = 0.f; for (int w = 0; w < 3; ++w) { const int back = 2 - w; if (s - back < 0) continue; const bf16_t* zr = Z + (size_t)(t - back) * WIN + ZB; acc += a.in[I_CONV_W][l * 1536 + w * 512 + c] * bf2f(zr[512 + c]) * bf2f(zr[1024 + c]); }
    const float ref = bf2f(Z[(size_t)t * WIN + ZB + c]) * acc;
    diag_put(a.ws, stage, bf2f(((const bf16_t*)(a.ws + WS_Y))[(size_t)t * D + 512 + c]) - ref, ref, 0.02f, 0.02f);
}
__global__ void ck_yc(Args a, int l, int stage) {
    __shared__ float sc[132]; __shared__ float red[2]; __shared__ float og[3][128]; __shared__ float lse[3];
    const unsigned hsh = hash_u(blockIdx.x + 555); int t = hsh % T; if (blockIdx.x < 6) t = (t & ~(SEQ - 1)) + blockIdx.x * 37; const int j = hash_u(hsh + 1) % 4; const int s = t % SEQ, d = threadIdx.x; const bf16_t* Z = (const bf16_t*)(a.ws + WS_Z);
    for (int g = 0; g < 3; ++g) { const int dil = g == 0 ? 1 : (g == 1 ? 4 : 16);
        const bf16_t* q = Z + (size_t)t * WIN + ZC + ((0 * 3 + g) * 4 + j) * 128;
        for (int kk = d; kk < 129; kk += 128) { const int sk = s - kk * dil; float v = -1e30f; if (sk >= 0) { const bf16_t* kp = Z + (size_t)(t - kk * dil) * WIN + ZC + ((1 * 3 + g) * 4 + j) * 128; float dd = 0.f; for (int e = 0; e < 128; ++e) dd += bf2f(q[e]) * bf2f(kp[e]); v = dd * 0.08838834764831845f; } sc[kk] = v; }
        __syncthreads();
        if (d == 0) { float mx = -1e30f; for (int kk = 0; kk < 129; ++kk) mx = fmaxf(mx, sc[kk]); float sm = 0.f; for (int kk = 0; kk < 129; ++kk) sm += (sc[kk] > -1e29f) ? expf(sc[kk] - mx) : 0.f; red[0] = mx; red[1] = sm; lse[g] = mx + logf(sm); }
        __syncthreads();
        float o = 0.f; for (int kk = 0; kk < 129; ++kk) { if (sc[kk] > -1e29f) o += expf(sc[kk] - red[0]) / red[1] * bf2f(Z[(size_t)(t - kk * dil) * WIN + ZC + ((2 * 3 + g) * 4 + j) * 128 + d]); }
        og[g][d] = o; __syncthreads(); }
    const float mx = fmaxf(lse[0], fmaxf(lse[1], lse[2])); const float e0 = expf(lse[0] - mx), e1 = expf(lse[1] - mx), e2 = expf(lse[2] - mx); const float ref = (e0 * og[0][d] + e1 * og[1][d] + e2 * og[2][d]) / (e0 + e1 + e2);
    diag_put(a.ws, stage, bf2f(((const bf16_t*)(a.ws + WS_Y))[(size_t)t * D + 1024 + j * 128 + d]) - ref, ref, 0.03f, 0.02f);
}
__global__ void ck_yd(Args a, int l, int stage) {
    __shared__ float sc[SEQ]; __shared__ float red[256]; __shared__ float o1s[128];
    const unsigned hsh = hash_u(blockIdx.x + 888); const int b = hsh % NB, h = hash_u(hsh + 1) % 4; int s = hash_u(hsh + 2) % SEQ; if (blockIdx.x < 8) { const int sp[8] = {0, 1, 31, 255, 256, 2047, 2048, 4095}; s = sp[blockIdx.x]; }
    const int d = threadIdx.x, t = b * SEQ + s; const bf16_t* Z = (const bf16_t*)(a.ws + WS_Z);
    const float lam_init = (l == 0) ? 0.2f : 0.35550906759096926f; float s1 = 0.f, s2 = 0.f; for (int i = 0; i < 64; ++i) { s1 += a.in[I_LQ1][l * 64 + i] * a.in[I_LK1][l * 64 + i]; s2 += a.in[I_LQ2][l * 64 + i] * a.in[I_LK2][l * 64 + i]; }
    const float lam = expf(s1) - expf(s2) + lam_init; float outv = 0.f;
    for (int map = 0; map < 2; ++map) { const bf16_t* q = Z + (size_t)t * WIN + ZD + (h * 2 + map) * 64;
        for (int k = d; k <= s; k += 128) { const bf16_t* kp = Z + (size_t)(b * SEQ + k) * WIN + ZD + 512 + (h * 2 + map) * 64; float dd = 0.f; for (int e = 0; e < 64; ++e) dd += bf2f(q[e]) * bf2f(kp[e]); sc[k] = dd * 0.125f; }
        __syncthreads();
        float mx = -1e30f; for (int k = d; k <= s; k += 128) mx = fmaxf(mx, sc[k]); red[d] = mx; __syncthreads(); if (d == 0) { float m = -1e30f; for (int i = 0; i < 128; ++i) m = fmaxf(m, red[i]); red[128] = m; } __syncthreads(); mx = red[128];
        float sm = 0.f; for (int k = d; k <= s; k += 128) sm += expf(sc[k] - mx); __syncthreads(); red[d] = sm; __syncthreads(); if (d == 0) { float m = 0.f; for (int i = 0; i < 128; ++i) m += red[i]; red[129] = m; } __syncthreads(); sm = red[129];
        float o = 0.f; for (int k = 0; k <= s; ++k) o += expf(sc[k] - mx) / sm * bf2f(Z[(size_t)(b * SEQ + k) * WIN + ZD + 1024 + h * 128 + d]);
        if (map == 0) outv = o; else outv -= lam * o; __syncthreads(); }
    o1s[d] = outv * outv; __syncthreads(); if (d == 0) { float m = 0.f; for (int i = 0; i < 128; ++i) m += o1s[i]; red[130] = m; } __syncthreads();
    const float ref = outv / sqrtf(red[130] / 128.f + EPS) * a.in[I_SUBLN][l * 128 + d] * (1.0f - lam_init);
    diag_put(a.ws, stage, bf2f(((const bf16_t*)(a.ws + WS_Y))[(size_t)t * D + 1536 + h * 128 + d]) - ref, ref, 0.04f, 0.04f);
}
__global__ void ck_p(Args a, int l, int stage) {
    const unsigned hsh = hash_u(blockIdx.x * 64 + threadIdx.x + 31337); const int t = hsh % T, k = hash_u(hsh + 1) % 4, c = hash_u(hsh + 2) % D; const bf16_t* y = (const bf16_t*)(a.ws + WS_Y) + (size_t)t * D + 512 * k;
    const float ref = dot_hw(y, a.in[I_W_BRANCH] + ((size_t)(l * 4 + k) * 512) * D + c, D, 512);
    diag_put(a.ws, stage, bf2f(((const bf16_t*)(a.ws + WS_Z))[(size_t)t * 8192 + k * D + c]) - ref, ref, 0.02f, 0.02f);
}
__global__ void ck_merged(Args a, int l, int stage) {
    const unsigned hsh = hash_u(blockIdx.x * 64 + threadIdx.x + 4242); const int t = hsh % T, c = hash_u(hsh + 2) % D; const bf16_t* h = (const bf16_t*)(a.ws + WS_H) + (size_t)t * D; float ref = 0.f;
    for (int k = 0; k < 4; ++k) { const float gl = dot_hw(h, a.in[I_W_GATE] + ((size_t)(l * 4 + k) * D) * D + c, D, D) + a.in[I_B_GATE][(l * 4 + k) * D + c]; ref += 1.0f / (1.0f + expf(-gl)) * bf2f(((const bf16_t*)(a.ws + WS_Z))[(size_t)t * 8192 + k * D + c]); }
    diag_put(a.ws, stage, bf2f(((const bf16_t*)(a.ws + WS_Y))[(size_t)t * D + c]) - ref, ref, 0.05f, 0.12f);
}
__global__ void ck_x1(Args a, int l, int stage) {
    const unsigned hsh = hash_u(blockIdx.x * 64 + threadIdx.x + 777); const int t = hsh % T, c = hash_u(hsh + 2) % D; const bf16_t* mg = (const bf16_t*)(a.ws + WS_Y) + (size_t)t * D;
    const float ref = a.in[I_X][(size_t)t * D + c] + dot_hw(mg, a.in[I_W_OUT] + (size_t)l * D * D + c, D, D);
    diag_put(a.ws, stage, bf2f(((const bf16_t*)(a.ws + WS_XB))[(size_t)t * D + c]) - ref, ref, 0.01f, 0.02f);
}
__global__ void ck_route(Args a, int l, int stage) {
    __shared__ float lg[36];
    const int t = hash_u(blockIdx.x + 9091) % T, lane = threadIdx.x; const bf16_t* xb_ = (const bf16_t*)(a.ws + WS_XB) + (size_t)t * D; const float* g = a.in[I_NORM_FFN] + l * D;
#define x(c) bf2f(xb_[c])
    float ss = 0.f; for (int c = lane; c < D; c += 64) ss += x(c) * x(c); ss = wave_sum(ss); const float rstd = 1.0f / sqrtf(ss / D + EPS);
    const bf16_t* h2 = (const bf16_t*)(a.ws + WS_H) + (size_t)t * D;
    if (!(MK_MOE8 && l >= 0)) for (int c = lane; c < D; c += 64) { const float ref = x(c) * g[c]; diag_put(a.ws, stage, bf2f(h2[c]) - ref, ref, 0.01f, 0.01f); }
    for (int n = 0; n < 36; ++n) { float s = 0.f; for (int c = lane; c < D; c += 64) { const float hv = x(c) * rstd * g[c]; s += hv * (n < 4 ? a.in[I_W_RG][(size_t)l * D * 4 + c * 4 + n] : a.in[I_W_RE][(size_t)l * D * 32 + c * 32 + (n - 4)]); } s = wave_sum(s); if (lane == 0) lg[n] = s + (n < 4 ? a.in[I_B_RG][l * 4 + n] : a.in[I_B_RE][l * 32 + n - 4]); }
    __syncthreads();
    if (lane == 0) { int gi = 0; for (int i = 1; i < 4; ++i) if (lg[i] > lg[gi]) gi = i; float gs = 0.f; for (int i = 0; i < 4; ++i) gs += expf(lg[i] - lg[gi]); const float gp = 1.0f / gs;
        int i1 = 0; for (int i = 1; i < 8; ++i) if (lg[4 + 8 * gi + i] > lg[4 + 8 * gi + i1]) i1 = i; int i2 = (i1 == 0) ? 1 : 0; for (int i = 0; i < 8; ++i) if (i != i1 && lg[4 + 8 * gi + i] > lg[4 + 8 * gi + i2]) i2 = i;
        const float v1 = lg[4 + 8 * gi + i1], v2 = lg[4 + 8 * gi + i2]; const float ex = expf(v2 - v1); const float w1 = gp / (1.f + ex), w2 = gp * ex / (1.f + ex);
        const u32x4 r = ((const u32x4*)(a.ws + WS_ROUTE))[t]; const int e1 = gi * 8 + i1, e2 = gi * 8 + i2;
        if ((int)r.x == e1 && (int)r.y == e2) { diag_put(a.ws, stage, __uint_as_float(r.z) - w1, w1, 0.03f, 0.003f); diag_put(a.ws, stage, __uint_as_float(r.w) - w2, w2, 0.03f, 0.003f); }
        else {
            float gap = 1e9f; const int me1 = (int)r.x, me2 = (int)r.y;
            if (me1 / 8 != gi) gap = lg[gi] - lg[me1 / 8]; else { const float a1 = lg[4 + me1], a2 = lg[4 + me2]; gap = fmaxf(fabsf(fminf(v1, v2) - fminf(a1, a2)), fabsf(fmaxf(v1, v2) - fmaxf(a1, a2))); }
            diag_put(a.ws, stage, gap, 0.f, 0.f, 0.02f); } }
}
#undef x
__global__ void ck_moe(Args a, int l, int stage) {
    __shared__ float hid[512]; __shared__ float hx[D];
    const unsigned hsh = hash_u(blockIdx.x + 6006); const int t = hsh % T, k = blockIdx.x & 1; const u32x4 r = ((const u32x4*)(a.ws + WS_ROUTE))[t]; const int e = k ? (int)r.y : (int)r.x; const float w = __uint_as_float(k ? r.w : r.z);
    const bf16_t* xb = (const bf16_t*)(a.ws + WS_XB) + (size_t)t * D; const float* g = a.in[I_NORM_FFN] + l * D; const float* Wu = a.in[I_W_UP] + ((size_t)(l * NEXP + e) * D) * 1024;
    for (int c = threadIdx.x; c < D; c += 256) hx[c] = bf2f(xb[c]) * g[c];
    __syncthreads();
    float rs_; { float s_ = 0.f; for (int c = 0; c < D; ++c) { const float xv = bf2f(xb[c]); s_ += xv * xv; } rs_ = 1.0f / sqrtf(s_ / D + EPS); }
    for (int j = threadIdx.x; j < 512; j += 256) { float av = 0.f, cv = 0.f; for (int c = 0; c < D; ++c) { av += hx[c] * Wu[(size_t)c * 1024 + j]; cv += hx[c] * Wu[(size_t)c * 1024 + 512 + j]; } av *= rs_; cv *= rs_; hid[j] = av / (1.0f + expf(-av)) * cv; }
    __syncthreads();
    const int c = (threadIdx.x * 8 + 3) % D; const float* Wd = a.in[I_W_DOWN] + ((size_t)(l * NEXP + e) * 512) * D + c; float s = 0.f; for (int j = 0; j < 512; ++j) s += hid[j] * Wd[(size_t)j * D];
    const float ref = w * s; const bf16_t* ys = (const bf16_t*)(a.ws + (k ? WS_Y1 : WS_Y0));
    if (MK_MOE8 && l >= 0) diag_put(a.ws, stage, bf2f(ys[(size_t)t * D + c]) - ref, ref, 0.10f, 0.15f); else diag_put(a.ws, stage, bf2f(ys[(size_t)t * D + c]) - ref, ref, 0.03f, 0.02f);
}
__global__ void ck_report(Args a) {
    const float* dg = (const float*)(a.ws + WS_CTL) + CW_DIAG; int bad = 0; for (int s = 1; s < 64; ++s) if (dg[s] > 1.0f) { bad = s; break; }
    if (!bad) return;
    const float v = powf(10.0f, 2.0f + 0.5f * (float)bad) * (dg[bad] > 30.f ? 2.0f : 1.0f);
    for (size_t i = (size_t)blockIdx.x * blockDim.x + threadIdx.x; i < (size_t)T * D; i += (size_t)gridDim.x * blockDim.x) a.out[i] = v;
}
#endif

extern "C" void kernel_launch(void* const* d_in, const int* in_sizes, int n_in, void* d_out, int out_size, void* d_ws, size_t ws_size, hipStream_t stream) {
    static int grid = 0;
    if (grid == 0) {
        if (n_in != 27 || out_size != T * D || ws_size < WS_END) { fprintf(stderr, "kernel_launch: unexpected shapes (n_in %d out %d ws %zu)\n", n_in, out_size, ws_size); grid = -1; return; }
        (void)hipFuncSetAttribute((const void*)mk_fwd, hipFuncAttributeMaxDynamicSharedMemorySize, LDS_BYTES);
        int dev = 0, cus = 0; (void)hipGetDevice(&dev); (void)hipDeviceGetAttribute(&cus, hipDeviceAttributeMultiprocessorCount, dev);
        grid = cus > 0 ? cus : 256;
    }
    if (grid < 0) return;
    (void)hipMemsetAsync((char*)d_ws + WS_CTL, 0, 32768, stream);
    Args a{};
    for (int i = 0; i < 27; ++i) a.in[i] = (const float*)d_in[i];
    a.out = (float*)d_out; a.ws = (unsigned char*)d_ws; a.mix_mask = 15;
#if MK_DEBUG
#define CK(kern, nblk, nthr, ...) hipLaunchKernelGGL(kern, dim3(nblk), dim3(nthr), 0, stream, a, __VA_ARGS__)
#endif
#if MK_FUSED && !MK_DEBUG
    if (MK_PROBE_LO < 0) {
        a.ph_lo = 0; a.ph_hi = N_PHASES;
        hipLaunchKernelGGL(mk_fwd, dim3(grid), dim3(NTHR), LDS_BYTES, stream, a);
#if MK_XPROBE
        a.ph_lo = 50; a.ph_hi = 51; hipLaunchKernelGGL(mk_fwd, dim3(grid), dim3(NTHR), LDS_BYTES, stream, a);
#endif
    } else {
        const int cuts[4] = {0, MK_PROBE_HI, MK_PROBE_LO, N_PHASES};
        const int los[3] = {0, MK_PROBE_LO, MK_PROBE_HI}, his[3] = {MK_PROBE_HI, MK_PROBE_HI, N_PHASES}; (void)cuts;
        for (int i = 0; i < 3; ++i) { if (los[i] >= his[i]) continue;
            if (i) (void)hipMemsetAsync((char*)d_ws + WS_CTL + CW_BAR * 4, 0, XCD_BAR_WORDS * 4, stream);
            a.ph_lo = los[i]; a.ph_hi = his[i]; a.mix_mask = (i == 1) ? MK_PROBE_MIX : 15;
            hipLaunchKernelGGL(mk_fwd, dim3(grid), dim3(NTHR), LDS_BYTES, stream, a); }
    }
    return;
#endif
    for (int ph = 0; ph < N_PHASES; ++ph) {
        a.ph_lo = ph; a.ph_hi = ph + 1;
        hipLaunchKernelGGL(mk_fwd, dim3(grid), dim3(NTHR), LDS_BYTES, stream, a);
#if MK_DEBUG
        if (ph >= 1 && ph < N_PHASES - 1) { const int l = (ph - 1) / PH_PER_LAYER, p = (ph - 1) % PH_PER_LAYER, sb = l * 13;
            if (p == 0) CK(ck_h, 64, 64, l, sb + 1);
            if (p == 1) { CK(ck_z_ident, 16, 64, l, sb + 2); CK(ck_z_qk, 128, 128, l, sb + 3, 0); CK(ck_z_qk, 128, 128, l, sb + 4, 1); }
            if (p == 2) { CK(ck_ya, 64, 128, l, sb + 5); CK(ck_yb, 16, 64, l, sb + 6); CK(ck_yd, 40, 128, l, sb + 8); }
            if (p == 3) CK(ck_yc, 64, 128, l, sb + 7);
            if (p == 4) CK(ck_p, 16, 64, l, sb + 9);
            if (p == 5) CK(ck_merged, 8, 64, l, sb + 10);
            if (p == 6 && l == 0) CK(ck_x1, 16, 64, l, sb + 11);
            if (p == 7) CK(ck_route, 128, 64, l, sb + 12);
            if (p == 9) CK(ck_moe, 32, 256, l, sb + 13);
        }
#endif
    }
#if MK_DEBUG
    hipLaunchKernelGGL(ck_report, dim3(1024), dim3(256), 0, stream, a);
#endif
}
```
